# Optimizing an MI355X kernel written in HIP

```python
import math
import jax, jax.numpy as jnp
from jax import lax
import numpy as np

D_MODEL = 1024
BATCH = 2
SEQ = 8192
DEPTH = 2

NORM_EPS = 1e-6
MASK_VALUE = -1e30
D_FF = 2816
N_BRANCHES = 4
BRANCH_WIDTH = 512

HG_HEADS = 4
HG_KDIM = 128
HG_VDIM = BRANCH_WIDTH // HG_HEADS
HG_CHUNK = 64

S5_GROUP = 16
S5_GROUPS = BRANCH_WIDTH // S5_GROUP
S5_STATE = 64
S5_DT_MIN = 1e-3
S5_DT_MAX = 1e-1

CONV_CH = BRANCH_WIDTH
CONV_WIDTH = 31

ATT_HEAD_DIM = 128
ATT_CONFIGS = ((128, 1), (512, 4), (2048, 16))
ATT_GROUPS = len(ATT_CONFIGS)
ATT_HEADS_PER_GROUP = BRANCH_WIDTH // ATT_HEAD_DIM
ATT_HEADS = ATT_GROUPS * ATT_HEADS_PER_GROUP
ATT_QBLOCK = 128
ROPE_THETA = 500000.0
ROPE_DIM = ATT_HEAD_DIM // 4

IN_SPLITS = (HG_HEADS * HG_KDIM, HG_HEADS * HG_KDIM, HG_HEADS * HG_VDIM, HG_HEADS * HG_VDIM,
             BRANCH_WIDTH, 2 * CONV_CH, 3 * ATT_HEADS * ATT_HEAD_DIM, N_BRANCHES * D_MODEL)
IN_WIDTH = int(sum(IN_SPLITS))
IN_SPLIT_POINTS = tuple(int(v) for v in np.cumsum(IN_SPLITS)[:-1])

kernel_name = 'hybrid_gated_parallel_mixers'


def _rmsnorm(x, gain):
    xf = x.astype(jnp.float32)
    y = xf * lax.rsqrt(jnp.mean(xf * xf, axis=-1, keepdims=True) + NORM_EPS)
    return (y * gain.astype(jnp.float32)).astype(x.dtype)


def _layernorm(x, gain, bias):
    xf = x.astype(jnp.float32)
    xc = xf - jnp.mean(xf, axis=-1, keepdims=True)
    var = jnp.mean(xc * xc, axis=-1, keepdims=True)
    y = xc * lax.rsqrt(var + NORM_EPS) * gain.astype(jnp.float32) + bias.astype(jnp.float32)
    return y.astype(x.dtype)


def _swiglu(x, w_gate, w_up, w_down):
    return (jax.nn.silu(x @ w_gate) * (x @ w_up)) @ w_down


def _hgrn2(q, f, i, g, lb, gnorm):
    f32 = jnp.float32
    Bsz, L, _ = q.shape
    n_chunks = L // HG_CHUNK
    f = f.astype(f32)
    lb = lb.astype(f32)
    qf = jax.nn.silu(q.astype(f32)) * (HG_KDIM ** -0.5)
    kf = (1.0 - lb) * jax.nn.sigmoid(-f)
    logf = jnp.log(lb + (1.0 - lb) * jax.nn.sigmoid(f))

    def heads(t, d):
        return t.reshape(Bsz, n_chunks, HG_CHUNK, HG_HEADS, d).transpose(1, 0, 3, 2, 4)

    qs, ks, gs = heads(qf, HG_KDIM), heads(kf, HG_KDIM), heads(logf, HG_KDIM)
    vs = heads(i.astype(f32), HG_VDIM)
    causal = jnp.tril(jnp.ones((HG_CHUNK, HG_CHUNK), dtype=bool))[:, :, None]

    def chunk_step(state, inp):
        qc, kc, vc, gc = inp
        b = jnp.cumsum(gc, axis=2)
        o_inter = jnp.einsum('bhck,bhkv->bhcv', qc * jnp.exp(b), state)
        rel = b[:, :, :, None, :] - b[:, :, None, :, :]
        decay = jnp.where(causal, jnp.exp(jnp.minimum(rel, 0.0)), 0.0)
        att = jnp.einsum('bhtk,bhsk,bhtsk->bhts', qc, kc, decay)
        o_intra = jnp.einsum('bhts,bhsv->bhtv', att, vc)
        b_last = b[:, :, -1:, :]
        new_state = jnp.exp(b_last[:, :, 0, :])[..., None] * state + jnp.einsum(
            'bhsk,bhsv->bhkv', kc * jnp.exp(b_last - b), vc)
        return new_state, o_inter + o_intra

    s0 = jnp.zeros((Bsz, HG_HEADS, HG_KDIM, HG_VDIM), f32)
    _, o = lax.scan(chunk_step, s0, (qs, ks, vs, gs))
    o = o.transpose(1, 0, 3, 2, 4).reshape(Bsz, L, HG_HEADS, HG_VDIM)
    o = o * lax.rsqrt(jnp.mean(o * o, axis=-1, keepdims=True) + NORM_EPS)
    o = o * gnorm.astype(f32).reshape(HG_HEADS, HG_VDIM)
    o = o.reshape(Bsz, L, HG_HEADS * HG_VDIM) * jax.nn.silu(g.astype(f32))
    return o.astype(q.dtype)


def _s5(u, a_re, a_im, log_dt, b_re, b_im, c_re, c_im, d_skip, w_glu):
    f32 = jnp.float32
    Bsz, L, _ = u.shape
    uf = u.astype(f32)
    a_re = a_re.astype(f32)
    a_im = a_im.astype(f32)
    b_re, b_im, c_re, c_im = (t.astype(f32) for t in (b_re, b_im, c_re, c_im))
    dt = jnp.exp(log_dt.astype(f32))[:, None]
    mag = jnp.exp(a_re * dt)
    ab_re = mag * jnp.cos(a_im * dt)
    ab_im = mag * jnp.sin(a_im * dt)
    den = a_re * a_re + a_im * a_im
    zr = ((ab_re - 1.0) * a_re + ab_im * a_im) / den
    zi = (ab_im * a_re - (ab_re - 1.0) * a_im) / den
    bb_re = zr[..., None] * b_re - zi[..., None] * b_im
    bb_im = zr[..., None] * b_im + zi[..., None] * b_re
    ug = uf.reshape(Bsz, L, S5_GROUPS, S5_GROUP)
    bu_re = jnp.einsum('blgc,gpc->blgp', ug, bb_re)
    bu_im = jnp.einsum('blgc,gpc->blgp', ug, bb_im)
    abar_re = jnp.broadcast_to(ab_re, bu_re.shape)
    abar_im = jnp.broadcast_to(ab_im, bu_im.shape)

    def combine(e1, e2):
        a1r, a1i, b1r, b1i = e1
        a2r, a2i, b2r, b2i = e2
        return (a2r * a1r - a2i * a1i, a2r * a1i + a2i * a1r,
                a2r * b1r - a2i * b1i + b2r, a2r * b1i + a2i * b1r + b2i)

    _, _, xr, xi = lax.associative_scan(combine, (abar_re, abar_im, bu_re, bu_im), axis=1)
    y = jnp.einsum('blgp,gcp->blgc', xr, c_re) - jnp.einsum('blgp,gcp->blgc', xi, c_im)
    y = y.reshape(Bsz, L, BRANCH_WIDTH) + d_skip.astype(f32) * uf
    z = jax.nn.gelu(y)
    za, zg = jnp.split(z @ w_glu.astype(f32), 2, axis=-1)
    return (za * jax.nn.sigmoid(zg)).astype(u.dtype)


def _conformer_conv(u, conv_w, conv_b, ln_g, ln_b):
    a, b = jnp.split(u, 2, axis=-1)
    z = a * jax.nn.sigmoid(b)
    z = lax.conv_general_dilated(
        z, conv_w[:, None, :].astype(z.dtype), window_strides=(1,),
        padding=((CONV_WIDTH - 1, 0),), dimension_numbers=('NWC', 'WIO', 'NWC'),
        feature_group_count=CONV_CH) + conv_b
    z = _layernorm(z, ln_g, ln_b)
    return jax.nn.silu(z)


def _partial_rope(x, positions):
    half = ROPE_DIM // 2
    inv_freq = ROPE_THETA ** (-jnp.arange(half, dtype=jnp.float32) / half)
    ang = positions.astype(jnp.float32)[..., None] * inv_freq
    cos = jnp.cos(ang)[:, :, None, :]
    sin = jnp.sin(ang)[:, :, None, :]
    xr = x[..., :ROPE_DIM].astype(jnp.float32)
    x1, x2 = xr[..., :half], xr[..., half:]
    rot = jnp.concatenate([x1 * cos - x2 * sin, x2 * cos + x1 * sin], axis=-1)
    return jnp.concatenate([rot.astype(x.dtype), x[..., ROPE_DIM:]], axis=-1)


def _strided_window_attention(q, k, v, window, dilation):
    f32 = jnp.float32
    Bsz, L, H, Dh = q.shape
    span = window // dilation
    n_sub = L // dilation
    nb = -(-n_sub // ATT_QBLOCK)
    pad = nb * ATT_QBLOCK - n_sub

    def gather(t):
        t = t.reshape(Bsz, n_sub, dilation, H, Dh).transpose(0, 2, 3, 1, 4)
        t = jnp.pad(t, ((0, 0), (0, 0), (0, 0), (0, pad), (0, 0)))
        return t.reshape(Bsz, dilation, H, nb, ATT_QBLOCK, Dh)

    def with_prev(t):
        prev = jnp.pad(t, ((0, 0), (0, 0), (0, 0), (1, 0), (0, 0), (0, 0)))[:, :, :, :-1]
        return jnp.concatenate([prev, t], axis=4)

    qb = gather(q)
    kk = with_prev(gather(k))
    vv = with_prev(gather(v))
    s = jnp.einsum('brhnqe,brhnke->brhnqk', qb, kk,
                   preferred_element_type=f32) * (Dh ** -0.5)
    qi = jnp.arange(ATT_QBLOCK)[:, None]
    kj = jnp.arange(2 * ATT_QBLOCK)[None, :]
    rel = ATT_QBLOCK + qi - kj
    band = (rel >= 0) & (rel <= span)
    not_first = jnp.arange(nb)[:, None, None] > 0
    valid = band[None] & (not_first | (kj[None] >= ATT_QBLOCK))
    s = jnp.where(valid, s, MASK_VALUE)
    lse = jax.nn.logsumexp(s, axis=-1)
    p = jnp.where(valid, jnp.exp(s - lse[..., None]), 0.0)
    o = jnp.einsum('brhnqk,brhnke->brhnqe', p, vv.astype(f32))
    o = o.reshape(Bsz, dilation, H, nb * ATT_QBLOCK, Dh)[:, :, :, :n_sub]
    o = o.transpose(0, 3, 1, 2, 4).reshape(Bsz, L, H, Dh)
    lse = lse.reshape(Bsz, dilation, H, nb * ATT_QBLOCK)[:, :, :, :n_sub]
    lse = lse.transpose(0, 3, 1, 2).reshape(Bsz, L, H)
    return o, lse


def _dilated_attention(qkv, positions):
    Bsz, L, _ = qkv.shape
    qkv = qkv.reshape(Bsz, L, 3, ATT_HEADS, ATT_HEAD_DIM)
    q = _partial_rope(qkv[:, :, 0], positions)
    k = _partial_rope(qkv[:, :, 1], positions)
    v = qkv[:, :, 2]
    outs, lses = [], []
    for gi, (window, dilation) in enumerate(ATT_CONFIGS):
        sl = slice(gi * ATT_HEADS_PER_GROUP, (gi + 1) * ATT_HEADS_PER_GROUP)
        o, lse = _strided_window_attention(q[:, :, sl], k[:, :, sl], v[:, :, sl], window, dilation)
        outs.append(o)
        lses.append(lse)
    w = jax.nn.softmax(jnp.stack(lses, axis=0), axis=0)
    out = jnp.sum(w[..., None] * jnp.stack(outs, axis=0), axis=0)
    return out.reshape(Bsz, L, ATT_HEADS_PER_GROUP * ATT_HEAD_DIM).astype(qkv.dtype)


def setup_inputs(seed: int = 0) -> dict:
    key = jax.random.key(seed)
    ks = iter(jax.random.split(key, 48))
    f32 = jnp.float32

    def nrm(shape, scale):
        return scale * jax.random.normal(next(ks), shape, f32)

    def gain(shape):
        return 1.0 + nrm(shape, 0.01)

    x = jax.random.normal(next(ks), (BATCH, SEQ, D_MODEL), f32)
    offsets = jax.random.randint(next(ks), (BATCH, 1), 0, 4096)
    positions = (offsets + jnp.arange(SEQ)[None, :]).astype(jnp.int32)
    a_im_base = jnp.pi * jnp.arange(S5_STATE, dtype=f32)
    return {
        'x': x,
        'positions': positions,
        'ffn1_norm': gain((DEPTH, D_MODEL)),
        'ffn1_w_gate': nrm((DEPTH, D_MODEL, D_FF), D_MODEL ** -0.5),
        'ffn1_w_up': nrm((DEPTH, D_MODEL, D_FF), D_MODEL ** -0.5),
        'ffn1_w_down': nrm((DEPTH, D_FF, D_MODEL), D_FF ** -0.5),
        'mix_norm': gain((DEPTH, D_MODEL)),
        'w_in': nrm((DEPTH, D_MODEL, IN_WIDTH), D_MODEL ** -0.5),
        'hg_lb_logits': nrm((DEPTH, HG_HEADS * HG_KDIM), 0.1),
        'hg_gnorm': gain((DEPTH, HG_HEADS * HG_VDIM)),
        's5_a_re': -0.5 + nrm((DEPTH, S5_GROUPS, S5_STATE), 0.01),
        's5_a_im': a_im_base + nrm((DEPTH, S5_GROUPS, S5_STATE), 0.01),
        's5_log_dt': jax.random.uniform(next(ks), (DEPTH, S5_GROUPS), f32,
                                        math.log(S5_DT_MIN), math.log(S5_DT_MAX)),
        's5_b_re': nrm((DEPTH, S5_GROUPS, S5_STATE, S5_GROUP), (2 * S5_GROUP) ** -0.5),
        's5_b_im': nrm((DEPTH, S5_GROUPS, S5_STATE, S5_GROUP), (2 * S5_GROUP) ** -0.5),
        's5_c_re': nrm((DEPTH, S5_GROUPS, S5_GROUP, S5_STATE), (2 * S5_STATE) ** -0.5),
        's5_c_im': nrm((DEPTH, S5_GROUPS, S5_GROUP, S5_STATE), (2 * S5_STATE) ** -0.5),
        's5_d': nrm((DEPTH, BRANCH_WIDTH), 1.0),
        's5_w_glu': nrm((DEPTH, BRANCH_WIDTH, 2 * BRANCH_WIDTH), BRANCH_WIDTH ** -0.5),
        'conv_w': nrm((DEPTH, CONV_WIDTH, CONV_CH), CONV_WIDTH ** -0.5),
        'conv_b': nrm((DEPTH, CONV_CH), 0.01),
        'conv_ln_g': gain((DEPTH, CONV_CH)),
        'conv_ln_b': nrm((DEPTH, CONV_CH), 0.01),
        'w_branch': nrm((DEPTH, N_BRANCHES, BRANCH_WIDTH, D_MODEL), BRANCH_WIDTH ** -0.5),
        'w_out': nrm((DEPTH, D_MODEL, D_MODEL), D_MODEL ** -0.5),
        'ffn2_norm': gain((DEPTH, D_MODEL)),
        'ffn2_w_gate': nrm((DEPTH, D_MODEL, D_FF), D_MODEL ** -0.5),
        'ffn2_w_up': nrm((DEPTH, D_MODEL, D_FF), D_MODEL ** -0.5),
        'ffn2_w_down': nrm((DEPTH, D_FF, D_MODEL), D_FF ** -0.5),
        'final_norm': gain((D_MODEL,)),
    }


def reference(x, positions, ffn1_norm, ffn1_w_gate, ffn1_w_up, ffn1_w_down, mix_norm, w_in,
              hg_lb_logits, hg_gnorm, s5_a_re, s5_a_im, s5_log_dt, s5_b_re, s5_b_im,
              s5_c_re, s5_c_im, s5_d, s5_w_glu, conv_w, conv_b, conv_ln_g, conv_ln_b,
              w_branch, w_out, ffn2_norm, ffn2_w_gate, ffn2_w_up, ffn2_w_down, final_norm):
    Bsz, L, _ = x.shape
    lb_soft = jax.nn.softmax(hg_lb_logits.astype(jnp.float32), axis=0)
    lb_all = jnp.cumsum(lb_soft, axis=0) - lb_soft[0]
    for l in range(DEPTH):
        h = _rmsnorm(x, ffn1_norm[l])
        x = x + 0.5 * _swiglu(h, ffn1_w_gate[l], ffn1_w_up[l], ffn1_w_down[l])

        h = _rmsnorm(x, mix_norm[l])
        hq, hf, hi, hg, s5_in, conv_in, att_in, gate_in = jnp.split(
            h @ w_in[l], IN_SPLIT_POINTS, axis=-1)
        y_a = _hgrn2(hq, hf, hi, hg, lb_all[l], hg_gnorm[l])
        y_b = _s5(s5_in, s5_a_re[l], s5_a_im[l], s5_log_dt[l], s5_b_re[l], s5_b_im[l],
                  s5_c_re[l], s5_c_im[l], s5_d[l], s5_w_glu[l])
        y_c = _conformer_conv(conv_in, conv_w[l], conv_b[l], conv_ln_g[l], conv_ln_b[l])
        y_d = _dilated_attention(att_in, positions)
        gates = jax.nn.sigmoid(gate_in).reshape(Bsz, L, N_BRANCHES, D_MODEL)
        merged = gates[:, :, 0] * (y_a @ w_branch[l, 0])
        merged = merged + gates[:, :, 1] * (y_b @ w_branch[l, 1])
        merged = merged + gates[:, :, 2] * (y_c @ w_branch[l, 2])
        merged = merged + gates[:, :, 3] * (y_d @ w_branch[l, 3])
        x = x + merged @ w_out[l]

        h = _rmsnorm(x, ffn2_norm[l])
        x = x + 0.5 * _swiglu(h, ffn2_w_gate[l], ffn2_w_up[l], ffn2_w_down[l])
    return _rmsnorm(x, final_norm)
```

```cpp
#include <hip/hip_runtime.h>
#include <hip/hip_cooperative_groups.h>
#include <cstdio>
#include <cstdint>
namespace cg = cooperative_groups;

#define LAS __attribute__((address_space(3)))
typedef unsigned short bf16_t;
typedef short bf16x8 __attribute__((ext_vector_type(8)));
typedef float f32x4 __attribute__((ext_vector_type(4)));
typedef float f32x2 __attribute__((ext_vector_type(2)));
typedef unsigned u32x4 __attribute__((ext_vector_type(4)));
typedef unsigned u32x2 __attribute__((ext_vector_type(2)));

constexpr int BATCH = 2, SEQ = 8192, TOK = BATCH * SEQ, DM = 1024, DFF = 2816, NLAYER = 2, INW = 12288;
constexpr float NORM_EPS = 1e-6f;

__device__ __forceinline__ unsigned f2bf(float f) { unsigned u = __builtin_bit_cast(unsigned, f); return (u + 0x7fffu + ((u >> 16) & 1u)) >> 16; }
__device__ __forceinline__ float bf2f(unsigned b) { return __builtin_bit_cast(float, b << 16); }
__device__ __forceinline__ unsigned pk2(float lo, float hi) { return f2bf(lo) | (f2bf(hi) << 16); }
__device__ __forceinline__ float bflo(unsigned w) { return __builtin_bit_cast(float, w << 16); }
__device__ __forceinline__ float bfhi(unsigned w) { return __builtin_bit_cast(float, w & 0xffff0000u); }
__device__ __forceinline__ float sigm(float x) { return 1.f / (1.f + __expf(-x)); }
__device__ __forceinline__ float siluf(float x) { return x / (1.f + __expf(-x)); }
__device__ __forceinline__ float gelu_tanh(float x) { const float y = 0.7978845608028654f * (x + 0.044715f * x * x * x); const float t = 1.f - 2.f / (1.f + __expf(2.f * y)); return 0.5f * x * (1.f + t); }
__device__ __forceinline__ float wave_sum(float v) {
#pragma unroll
    for (int o = 1; o < 64; o <<= 1) v += __shfl_xor(v, o);
    return v;
}
#define LDS_WAIT() asm volatile("s_waitcnt lgkmcnt(0)" ::: "memory")

namespace pg8 {
#define PG8_LAS __attribute__((address_space(3)))
constexpr int BM = 256, BK = 64, HALF = 128, HTB = HALF * BK * 2  , STAGE_BYTES = 8 * HTB, NXCD = 8, WGM = 8;

__host__ __device__ __forceinline__ int lds_byte(int r, int c) { const int st = (r >> 4) * 2 + (c >> 5), rr = r & 15, cc = c & 31, ob = rr * 64 + cc * 2; return st * 1024 + (ob ^ (((ob >> 9) & 1) << 5)); }
__host__ __device__ __forceinline__ void stage_rc(int b, int& R, int& C) { const int st = b / 1024, sb = b % 1024, swz = sb ^ (((sb >> 9) & 1) << 5); R = (st >> 1) * 16 + swz / 64; C = (st & 1) * 32 + (swz % 64) / 2; }
__host__ __device__ __forceinline__ int perm32(int rho) { const int n = rho >> 4, i = rho & 15; return 8 * (i >> 2) + 4 * n + (i & 3); }

struct Unit { int pm, pn, grp; size_t aoff, boff; };
struct Gemm { const bf16_t* A; const bf16_t* Bt; int lda, ldb, K; };

struct StaticOrder {
    int nM, nN, nwg, G, c, lda, ldb;
    __device__ __forceinline__ void init(int M, int N, int G_, int c_, int lda_, int ldb_) { nM = M / BM; nN = N / BM; nwg = nM * nN; G = G_; c = c_; lda = lda_; ldb = ldb_; }
    __device__ __forceinline__ bool next(int i, Unit& u) const {
        const long L = (long)i * G + c; if (L >= nwg) return false;
        int wgid = (int)L; { const int q = nwg / NXCD, r = nwg % NXCD, xcd = wgid % NXCD, off = wgid / NXCD; wgid = (xcd < r ? xcd * (q + 1) : r * (q + 1) + (xcd - r) * q) + off; }
        const int nig = WGM * nN, gid = wgid / nig, fm = gid * WGM, gsz = (nM - fm) < WGM ? (nM - fm) : WGM;
        u.pm = fm + ((wgid % nig) % gsz); u.pn = (wgid % nig) / gsz; u.grp = 0;
        u.aoff = (size_t)u.pm * 256 * lda * 2; u.boff = (size_t)u.pn * 256 * ldb * 2; return true;
    }
    __device__ __forceinline__ void a_ready(const Unit&) const {}
    __device__ __forceinline__ void done(const Unit&) const {}
};
struct BranchOrder {
    StaticOrder so;
    __device__ __forceinline__ void init(int G_, int c_) { so.init(TOK, 1024, G_, c_, 512, 512); }
    __device__ __forceinline__ bool next(int i, Unit& u) const {
        const long L = (long)i * so.G + so.c; if (L >= 1024) return false;
        const int k = (int)(L >> 8); StaticOrder s2 = so; s2.G = 256; s2.c = (int)(L & 255);
        if (!s2.next(0, u)) return false;
        u.grp = k; u.aoff += (size_t)k * TOK * 512 * 2; u.boff += (size_t)k * 1024 * 512 * 2; return true;
    }
    __device__ __forceinline__ void a_ready(const Unit&) const {}
    __device__ __forceinline__ void done(const Unit&) const {}
};
struct S5eOrder {
    int G, c;
    __device__ __forceinline__ bool next(int i, Unit& u) const {
        const long L = (long)i * G + c; if (L >= 64) return false;
        const int g = (int)L >> 1, pm = (int)L & 1; u.pm = pm; u.pn = 0; u.grp = g;
        u.aoff = ((size_t)(g * 512 + pm * 256) * 640 + 128) * 2; u.boff = (size_t)g * 256 * 512 * 2; return true;
    }
    __device__ __forceinline__ void a_ready(const Unit&) const {}
    __device__ __forceinline__ void done(const Unit&) const {}
};
struct S5mOrder {
    int G, c;
    __device__ __forceinline__ bool next(int i, Unit& u) const {
        const long L = (long)i * G + c; if (L >= 128) return false;
        const int g = (int)L >> 2, pm = ((int)L >> 1) & 1, pn = (int)L & 1; u.pm = pm; u.pn = pn; u.grp = g;
        u.aoff = (size_t)(g * 512 + pm * 256) * 640 * 2; u.boff = (size_t)(g * 512 + pn * 256) * 640 * 2; return true;
    }
    __device__ __forceinline__ void a_ready(const Unit&) const {}
    __device__ __forceinline__ void done(const Unit&) const {}
};

__device__ __forceinline__ unsigned cvt_pk_bf16(float lo, float hi) { unsigned r; asm volatile("v_cvt_pk_bf16_f32 %0, %1, %2" : "=v"(r) : "v"(lo), "v"(hi)); return r; }
__device__ __forceinline__ u32x4 pack8(const f32x4& v0, const f32x4& v1) { u32x4 w; w.x = cvt_pk_bf16(v0[0], v0[1]); w.y = cvt_pk_bf16(v0[2], v0[3]); w.z = cvt_pk_bf16(v1[0], v1[1]); w.w = cvt_pk_bf16(v1[2], v1[3]); return w; }

template <int MODE> struct EpiGated {
    static constexpr bool PERM = true, AFTER_DRAIN = false;
    bf16_t* O; int ldo;
    __device__ __forceinline__ void operator()(const f32x4 (&acc)[2][2][4][2], const Unit& u, int wr, int wc, int fr, int fq) const {
        const int row0 = u.pm * BM + wr * 64 + fr, col0 = u.pn * 128 + wc * 32 + 8 * fq;
#pragma unroll
        for (int ai = 0; ai < 2; ++ai)
#pragma unroll
            for (int m = 0; m < 4; ++m) { bf16_t* rowp = O + (size_t)(row0 + ai * HALF + m * 16) * ldo + col0;
                f32x4 v[2];
#pragma unroll
                for (int n = 0; n < 2; ++n)
#pragma unroll
                    for (int j = 0; j < 4; ++j) { const float a = acc[ai][0][m][n][j], b = acc[ai][1][m][n][j]; v[n][j] = (MODE == 0) ? siluf(a) * b : a * sigm(b); }
                *(u32x4*)rowp = pack8(v[0], v[1]); asm volatile("" ::: "memory"); }
    }
};
struct EpiResid {
    static constexpr bool PERM = false, AFTER_DRAIN = false;
    const float* base; float* out; float scale;
    __device__ __forceinline__ void operator()(const f32x4 (&acc)[2][2][4][2], const Unit& u, int wr, int wc, int fr, int fq) const {
        const int row0 = u.pm * BM + wr * 64 + fr, col0 = u.pn * BM + wc * 32 + 4 * fq;
#pragma unroll
        for (int ai = 0; ai < 2; ++ai)
#pragma unroll
            for (int m = 0; m < 4; ++m) { const size_t off = (size_t)(row0 + ai * HALF + m * 16) * DM + col0;
#pragma unroll
                for (int bj = 0; bj < 2; ++bj)
#pragma unroll
                    for (int n = 0; n < 2; ++n) { const size_t o = off + bj * HALF + n * 16; const f32x4 b = *(const f32x4*)(base + o); *(f32x4*)(out + o) = b + scale * acc[ai][bj][m][n]; }
                asm volatile("" ::: "memory"); }
    }
};
struct EpiC1 {
    static constexpr bool PERM = true, AFTER_DRAIN = false;
    bf16_t* hq; bf16_t* s5A; bf16_t* convin;
    __device__ __forceinline__ void operator()(const f32x4 (&acc)[2][2][4][2], const Unit& u, int wr, int wc, int fr, int fq) const {
        const int pn = u.pn, rowb = u.pm * BM + wr * 64 + fr, cl = wc * 32 + 8 * fq;
        bf16_t* p0; int sAI, sM1, sM0, sBJ;
        if (pn < 8) { p0 = hq + (size_t)(pn >> 1) * TOK * 512 + (size_t)rowb * 512 + (pn & 1) * 256 + cl; sAI = 128 * 512; sM1 = 32 * 512; sM0 = 16 * 512; sBJ = 128; }
        else if (pn < 10) { const int c5 = (pn - 8) * 256 + cl, g = c5 >> 4, ch = c5 & 15;
            p0 = s5A + ((size_t)(g * 512 + u.pm * 8 + 2 * wr) * 640 + 128 + fr * 16 + ch); sAI = 4 * 640; sM1 = 640; sM0 = 256; sBJ = 8 * 512 * 640; }
        else { p0 = convin + (size_t)rowb * 1024 + (pn - 10) * 256 + cl; sAI = 128 * 1024; sM1 = 32 * 1024; sM0 = 16 * 1024; sBJ = 128; }
#pragma unroll
        for (int ai = 0; ai < 2; ++ai)
#pragma unroll
            for (int m = 0; m < 4; ++m) {
#pragma unroll
                for (int bj = 0; bj < 2; ++bj)
                    *(u32x4*)(p0 + (size_t)(ai * sAI + (m >> 1) * sM1 + (m & 1) * sM0 + bj * sBJ)) = pack8(acc[ai][bj][m][0], acc[ai][bj][m][1]);
                asm volatile("" ::: "memory"); }
    }
};
struct EpiC2 {
    static constexpr bool PERM = true, AFTER_DRAIN = false;
    bf16_t* qkv;
    __device__ __forceinline__ void operator()(const f32x4 (&acc)[2][2][4][2], const Unit& u, int wr, int wc, int fr, int fq) const {
        const int which = u.pn / 6, hp = u.pn % 6, rowt = u.pm * BM, b = rowt >> 13, t0 = (rowt & 8191) + wr * 64 + fr;
        bf16_t* p0 = qkv + ((size_t)(which * 24 + b * 12 + 2 * hp) * SEQ + t0) * 128 + wc * 32 + 8 * fq;
#pragma unroll
        for (int ai = 0; ai < 2; ++ai)
#pragma unroll
            for (int m = 0; m < 4; ++m) {
#pragma unroll
                for (int bj = 0; bj < 2; ++bj)
                    *(u32x4*)(p0 + (size_t)bj * SEQ * 128 + (size_t)(ai * HALF + m * 16) * 128) = pack8(acc[ai][bj][m][0], acc[ai][bj][m][1]);
                asm volatile("" ::: "memory"); }
    }
};
struct EpiS5e {
    static constexpr bool PERM = false, AFTER_DRAIN = false;
    float* E;
    __device__ __forceinline__ void operator()(const f32x4 (&acc)[2][2][4][2], const Unit& u, int wr, int wc, int fr, int fq) const {
        const int row0 = u.pm * BM + wr * 64 + fr, col0 = wc * 32 + 4 * fq;
#pragma unroll
        for (int ai = 0; ai < 2; ++ai)
#pragma unroll
            for (int m = 0; m < 4; ++m) { float* rowp = E + (size_t)(u.grp * 512 + row0 + ai * HALF + m * 16) * 128 + col0;
#pragma unroll
                for (int n = 0; n < 2; ++n) *(f32x4*)(rowp + n * 16) = acc[ai][0][m][n]; }
    }
};
struct EpiS5m {
    static constexpr bool PERM = true, AFTER_DRAIN = false;
    const bf16_t* s5A; const float* dskip; bf16_t* Z;
    __device__ __forceinline__ void operator()(const f32x4 (&acc)[2][2][4][2], const Unit& u, int wr, int wc, int fr, int fq) const {
        const int g = u.grp, chunk0 = u.pm * BM + wr * 64 + fr, c0 = 8 * (fq & 1), t0 = u.pn * 16 + 2 * wc + (fq >> 1);
        const f32x4 d0 = *(const f32x4*)(dskip + g * 16 + c0), d1 = *(const f32x4*)(dskip + g * 16 + c0 + 4);
        const bf16_t* up = s5A + (size_t)(g * 512 + chunk0) * 640 + 128 + t0 * 16 + c0;
        bf16_t* zp = Z + (size_t)(chunk0 * 32 + t0) * 512 + g * 16 + c0;
#pragma unroll
        for (int ai = 0; ai < 2; ++ai)
#pragma unroll
            for (int m = 0; m < 4; ++m) {
#pragma unroll
                for (int bj = 0; bj < 2; ++bj) {
                    const u32x4 uu = *(const u32x4*)(up + (size_t)(ai * HALF + m * 16) * 640 + bj * 128);
                    f32x4 v0 = acc[ai][bj][m][0], v1 = acc[ai][bj][m][1];
                    v0[0] += d0[0] * bflo(uu.x); v0[1] += d0[1] * bfhi(uu.x); v0[2] += d0[2] * bflo(uu.y); v0[3] += d0[3] * bfhi(uu.y);
                    v1[0] += d1[0] * bflo(uu.z); v1[1] += d1[1] * bfhi(uu.z); v1[2] += d1[2] * bflo(uu.w); v1[3] += d1[3] * bfhi(uu.w);
#pragma unroll
                    for (int j = 0; j < 4; ++j) { v0[j] = gelu_tanh(v0[j]); v1[j] = gelu_tanh(v1[j]); }
                    *(u32x4*)(zp + (size_t)(ai * HALF + m * 16) * 32 * 512 + bj * 8 * 512) = pack8(v0, v1); }
                asm volatile("" ::: "memory"); }
    }
};
struct EpiBranch {
    static constexpr bool PERM = true, AFTER_DRAIN = false;
    bf16_t* Ball;
    __device__ __forceinline__ void operator()(const f32x4 (&acc)[2][2][4][2], const Unit& u, int wr, int wc, int fr, int fq) const {
        const int row0 = u.pm * BM + wr * 64 + fr, col0 = u.grp * 1024 + u.pn * BM + wc * 32 + 8 * fq;
#pragma unroll
        for (int ai = 0; ai < 2; ++ai)
#pragma unroll
            for (int m = 0; m < 4; ++m) { bf16_t* rowp = Ball + (size_t)(row0 + ai * HALF + m * 16) * 4096 + col0;
#pragma unroll
                for (int bj = 0; bj < 2; ++bj) *(u32x4*)(rowp + bj * HALF) = pack8(acc[ai][bj][m][0], acc[ai][bj][m][1]); }
    }
};
struct EpiGateMerge {
    static constexpr bool PERM = false, AFTER_DRAIN = false;
    const bf16_t* Ball; bf16_t* merged;
    __device__ __forceinline__ void operator()(const f32x4 (&acc)[2][2][4][2], const Unit& u, int wr, int wc, int fr, int fq) const {
        const int row0 = u.pm * BM + wr * 64 + fr, mc = u.pn * 64 + wc * 16 + 4 * fq;
#pragma unroll
        for (int ai = 0; ai < 2; ++ai)
#pragma unroll
            for (int m = 0; m < 4; ++m) { const int row = row0 + ai * HALF + m * 16; const bf16_t* bp = Ball + (size_t)row * 4096 + mc;
                f32x4 s = {0.f, 0.f, 0.f, 0.f};
#pragma unroll
                for (int bj = 0; bj < 2; ++bj)
#pragma unroll
                    for (int n = 0; n < 2; ++n) { const u32x2 bv = *(const u32x2*)(bp + (2 * bj + n) * 1024); const f32x4 gt = acc[ai][bj][m][n];
                        s[0] += sigm(gt[0]) * bflo(bv.x); s[1] += sigm(gt[1]) * bfhi(bv.x); s[2] += sigm(gt[2]) * bflo(bv.y); s[3] += sigm(gt[3]) * bfhi(bv.y); }
                u32x2 w; w.x = cvt_pk_bf16(s[0], s[1]); w.y = cvt_pk_bf16(s[2], s[3]);
                *(u32x2*)(merged + (size_t)row * DM + mc) = w; }
    }
};

template <class Epi, class Sched, bool ALIGN_EPI = false, bool SP2 = false>
__device__ __forceinline__ void gemm_phase(PG8_LAS unsigned char* lds, const Gemm g, const Sched& S, const Epi& E, int tid_opaque) {
    const int tid = tid_opaque, wid = __builtin_amdgcn_readfirstlane(tid >> 6), lane = tid & 63, wr = wid >> 2, wc = wid & 3, fr = lane & 15, fq = lane >> 4;
    const int K = g.K, nt = K / BK, lda = g.lda, ldb = g.ldb;
    unsigned voffA[2], voffB[2];
#pragma unroll
    for (int i = 0; i < 2; ++i) { int R, C; stage_rc(tid * 16 + i * 8192, R, C); const int Rb = Epi::PERM ? ((R & ~31) + perm32(R & 31)) : R;
        voffA[i] = (unsigned)(R * lda + C) * 2u; voffB[i] = (unsigned)(Rb * ldb + C) * 2u; }
    const size_t kstep = (size_t)(BK * 2);
    const size_t hstepA = (size_t)HALF * lda * 2, hstepB = (size_t)HALF * ldb * 2;

    const unsigned ldsw = (unsigned)wid * 1024u;
    const int aoff = lds_byte(wr * 64 + fr, fq * 8), boff = lds_byte(wc * 32 + fr, fq * 8);
#define PG8_SA(b, h) (((b) * 2 + (h)) * HTB)
#define PG8_SB(b, h) ((4 + (b) * 2 + (h)) * HTB)
#define PG8_STAGE(bufoff, gbase, voff) do { _Pragma("unroll") for (int _i = 0; _i < 2; ++_i) \
        __builtin_amdgcn_global_load_lds((const unsigned*)((const char*)(gbase) + (voff)[_i]), (PG8_LAS unsigned*)(lds + (bufoff) + ldsw + _i * 8192), 16, 0, 0); } while (0)
#define PG8_LDA(dst, b, h) do { _Pragma("unroll") for (int m = 0; m < 4; ++m) _Pragma("unroll") for (int k = 0; k < 2; ++k) dst[m][k] = *(const PG8_LAS bf16x8*)(lds + PG8_SA(b, h) + aoff + m * 2048 + k * 1024); } while (0)
#define PG8_LDB(dst, b, h) do { _Pragma("unroll") for (int n = 0; n < 2; ++n) _Pragma("unroll") for (int k = 0; k < 2; ++k) dst[n][k] = *(const PG8_LAS bf16x8*)(lds + PG8_SB(b, h) + boff + n * 2048 + k * 1024); } while (0)
#define PG8_MMA(ai, bj, At, Bt) do { __builtin_amdgcn_s_setprio(1); _Pragma("unroll") for (int m = 0; m < 4; ++m) _Pragma("unroll") for (int n = 0; n < 2; ++n) _Pragma("unroll") for (int k = 0; k < 2; ++k) \
        acc[ai][bj][m][n] = __builtin_amdgcn_mfma_f32_16x16x32_bf16(Bt[n][k], At[m][k], acc[ai][bj][m][n], 0, 0, 0); __builtin_amdgcn_s_setprio(0); } while (0)
#define PG8_WAIT_V(n) asm volatile("s_waitcnt vmcnt(" #n ")" ::: "memory")
#define PG8_WAIT_L(n) asm volatile("s_waitcnt lgkmcnt(" #n ")" ::: "memory")
#define PG8_BAR __builtin_amdgcn_s_barrier()
#define PG8_SCHED __builtin_amdgcn_sched_barrier(0)
    Unit cur, nxt; int ui = 0;
    if (!S.next(0, cur)) return;
    f32x4 acc[2][2][4][2];
#pragma unroll
    for (int a = 0; a < 2; ++a)
#pragma unroll
        for (int b = 0; b < 2; ++b)
#pragma unroll
            for (int m = 0; m < 4; ++m)
#pragma unroll
                for (int n = 0; n < 2; ++n) acc[a][b][m][n] = (f32x4){0.f, 0.f, 0.f, 0.f};
    bf16x8 At[4][2], B0[2][2], B1[2][2];
    const char* cA = (const char*)g.A + cur.aoff; const char* cB = (const char*)g.Bt + cur.boff;
    S.a_ready(cur);
    if constexpr (SP2) {
        PG8_STAGE(PG8_SB(0, 0), cB, voffB); PG8_STAGE(PG8_SB(0, 1), cB + hstepB, voffB); PG8_STAGE(PG8_SA(0, 0), cA, voffA); PG8_STAGE(PG8_SA(0, 1), cA + hstepA, voffA);
        if (wr == 1) PG8_BAR;
        PG8_WAIT_V(2); PG8_BAR;
        PG8_STAGE(PG8_SB(1, 0), cB + kstep, voffB); PG8_STAGE(PG8_SA(1, 0), cA + kstep, voffA); PG8_STAGE(PG8_SB(1, 1), cB + hstepB + kstep, voffB);
        PG8_WAIT_V(6); PG8_BAR;
    } else {
        PG8_STAGE(PG8_SB(0, 0), cB, voffB); PG8_STAGE(PG8_SA(0, 0), cA, voffA); PG8_STAGE(PG8_SB(0, 1), cB + hstepB, voffB); PG8_STAGE(PG8_SA(0, 1), cA + hstepA, voffA);
        if (wr == 1) PG8_BAR;
        PG8_WAIT_V(4); PG8_BAR;
        PG8_STAGE(PG8_SB(1, 0), cB + kstep, voffB); PG8_STAGE(PG8_SA(1, 0), cA + kstep, voffA); PG8_STAGE(PG8_SB(1, 1), cB + hstepB + kstep, voffB);
        PG8_WAIT_V(6); PG8_BAR;
    }
    for (;;) {
        const bool has_next = S.next(ui + 1, nxt);
        const char* nA = has_next ? (const char*)g.A + nxt.aoff : cA; const char* nB = has_next ? (const char*)g.Bt + nxt.boff : cB;
        for (int t = 0; t < nt; t += 2) {
            const bool last = (t == nt - 2);
            const char* a1 = cA + (size_t)(t + 1) * kstep;
            const char* a2 = last ? nA : cA + (size_t)(t + 2) * kstep; const char* b2 = last ? nB : cB + (size_t)(t + 2) * kstep;
            const char* a3 = a2 + kstep; const char* b3 = b2 + kstep;
            if (last && has_next) S.a_ready(nxt);
            if constexpr (SP2) {
            PG8_LDB(B0, 0, 0); PG8_LDB(B1, 0, 1); PG8_SCHED; PG8_LDA(At, 0, 0); PG8_STAGE(PG8_SA(1, 1), a1 + hstepA, voffA);
            PG8_WAIT_V(8); PG8_WAIT_L(0); PG8_BAR; PG8_MMA(0, 0, At, B0); PG8_MMA(0, 1, At, B1); PG8_BAR; PG8_SCHED;
            PG8_LDA(At, 0, 1); PG8_STAGE(PG8_SB(0, 0), b2, voffB); PG8_STAGE(PG8_SB(0, 1), b2 + hstepB, voffB); PG8_STAGE(PG8_SA(0, 0), a2, voffA);
            PG8_WAIT_V(8); PG8_WAIT_L(0); PG8_BAR; PG8_MMA(1, 0, At, B0); PG8_MMA(1, 1, At, B1); PG8_BAR; PG8_SCHED;
            PG8_LDB(B0, 1, 0); PG8_LDB(B1, 1, 1); PG8_SCHED; PG8_LDA(At, 1, 0); PG8_STAGE(PG8_SA(0, 1), a2 + hstepA, voffA);
            PG8_WAIT_V(8); PG8_WAIT_L(0); PG8_BAR; PG8_MMA(0, 0, At, B0); PG8_MMA(0, 1, At, B1); PG8_BAR; PG8_SCHED;
            PG8_LDA(At, 1, 1); PG8_STAGE(PG8_SB(1, 0), b3, voffB); PG8_STAGE(PG8_SB(1, 1), b3 + hstepB, voffB); PG8_STAGE(PG8_SA(1, 0), a3, voffA);
            PG8_WAIT_V(8); PG8_WAIT_L(0); PG8_BAR; PG8_MMA(1, 0, At, B0); PG8_MMA(1, 1, At, B1); PG8_BAR; PG8_SCHED;
            } else {
            PG8_LDB(B0, 0, 0); PG8_SCHED; PG8_LDA(At, 0, 0); PG8_STAGE(PG8_SA(1, 1), a1 + hstepA, voffA);
            PG8_WAIT_L(8); PG8_BAR; PG8_WAIT_L(0); PG8_MMA(0, 0, At, B0); PG8_BAR; PG8_SCHED;
            PG8_LDB(B1, 0, 1); PG8_STAGE(PG8_SB(0, 0), b2, voffB);
            PG8_BAR; PG8_WAIT_L(0); PG8_MMA(0, 1, At, B1); PG8_BAR;
            PG8_LDA(At, 0, 1); PG8_STAGE(PG8_SA(0, 0), a2, voffA);
            PG8_BAR; PG8_WAIT_L(0); PG8_MMA(1, 0, At, B0); PG8_BAR; PG8_SCHED;
            PG8_STAGE(PG8_SB(0, 1), b2 + hstepB, voffB);
            PG8_WAIT_V(6); PG8_BAR; PG8_MMA(1, 1, At, B1); PG8_BAR;
            PG8_LDB(B0, 1, 0); PG8_SCHED; PG8_LDA(At, 1, 0); PG8_STAGE(PG8_SA(0, 1), a2 + hstepA, voffA);
            PG8_WAIT_L(8); PG8_BAR; PG8_WAIT_L(0); PG8_MMA(0, 0, At, B0); PG8_BAR; PG8_SCHED;
            PG8_LDB(B1, 1, 1); PG8_STAGE(PG8_SB(1, 0), b3, voffB);
            PG8_BAR; PG8_WAIT_L(0); PG8_MMA(0, 1, At, B1); PG8_BAR;
            PG8_LDA(At, 1, 1); PG8_STAGE(PG8_SA(1, 0), a3, voffA);
            PG8_BAR; PG8_WAIT_L(0); PG8_MMA(1, 0, At, B0); PG8_BAR; PG8_SCHED;
            PG8_STAGE(PG8_SB(1, 1), b3 + hstepB, voffB);
            PG8_WAIT_V(6); PG8_BAR; PG8_MMA(1, 1, At, B1); PG8_BAR;
            }
        }
        if constexpr (ALIGN_EPI) { if (wr == 0) PG8_BAR; }
        if constexpr (!Epi::AFTER_DRAIN) { int fr_ = fr, fq_ = fq; asm volatile("" : "+v"(fr_), "+v"(fq_)); E(acc, cur, wr, wc, fr_, fq_); S.done(cur); }
        if (!has_next) break;
#pragma unroll
        for (int a = 0; a < 2; ++a)
#pragma unroll
            for (int b = 0; b < 2; ++b)
#pragma unroll
                for (int m = 0; m < 4; ++m)
#pragma unroll
                    for (int n = 0; n < 2; ++n) acc[a][b][m][n] = (f32x4){0.f, 0.f, 0.f, 0.f};
        cur = nxt; cA = nA; cB = nB; ++ui;
        if constexpr (ALIGN_EPI) { if (wr == 1) PG8_BAR; }
    }
    PG8_WAIT_V(0);
    if constexpr (!ALIGN_EPI) { if (wr == 0) PG8_BAR; }
    PG8_BAR;
    if constexpr (Epi::AFTER_DRAIN) { E.fused(acc, cur, wr, wc, fr, fq, lds, wid, lane); S.done(cur); }
#undef PG8_SA
#undef PG8_SB
#undef PG8_STAGE
#undef PG8_LDA
#undef PG8_LDB
#undef PG8_MMA
#undef PG8_WAIT_V
#undef PG8_WAIT_L
#undef PG8_BAR
#undef PG8_SCHED
}

}

constexpr size_t MiB = 1u << 20;
constexpr size_t WS_CTL = 0;
constexpr size_t WS_ROPE = 1 * MiB;
constexpr size_t WS_LSE = 3 * MiB;
constexpr size_t WS_HGD = 4 * MiB;
constexpr size_t WS_A32 = WS_HGD + 768 * 1024;
constexpr size_t WS_S5E = 5 * MiB;
constexpr size_t WS_W = 13 * MiB;
constexpr size_t W_GU1 = WS_W, W_D1 = W_GU1 + 11 * MiB, W_GU2 = W_D1 + 11 * MiB / 2, W_D2 = W_GU2 + 11 * MiB;
constexpr size_t W_C1 = WS_W + 33 * MiB, W_C2 = W_C1 + 7 * MiB, W_GATE = W_C2 + 9 * MiB, W_BR = W_GATE + 8 * MiB, W_OUT = W_BR + 4 * MiB, W_GLU = W_OUT + 2 * MiB;
constexpr size_t W_S5M = W_GLU + 1 * MiB, W_S5E = W_S5M + 20 * MiB;
constexpr size_t WS_XN = 105 * MiB;
constexpr size_t WS_Y = 137 * MiB;
constexpr size_t WS_MERGED = 201 * MiB;
constexpr size_t WS_R = 233 * MiB;
constexpr size_t R_HQ = WS_R, R_S5A = WS_R + 64 * MiB, R_CONV = WS_R + 84 * MiB, R_HST = WS_R + 116 * MiB;
constexpr size_t R_QKV = WS_R, R_HBUF = WS_R, R_BALL = WS_R;
constexpr size_t WS_END = 381 * MiB;
static_assert(W_S5E + 8 * MiB <= WS_XN && W_D2 + 11 * MiB / 2 <= W_C1, "weight map");
constexpr size_t QKV_WHICH = (size_t)24 * SEQ * 128;

constexpr int LDS_BYTES = 151552;
constexpr int NWAVES = 8, NTHREADS = 512;

struct Args { const float* in[30]; float* out; unsigned char* ws; int ph_lo, ph_hi; };

struct Ctx {
    LAS unsigned char* lds; int tid, lane, wave, G, bid, zo;
    const float* const* in; float* out; unsigned char* ws;
};
#define INP(c, k) ((c).in[(k) + (c).zo])

template <int MT, int NT, int KT>
__device__ __forceinline__ void wave_mma(f32x4 (&acc)[MT][NT], const LAS bf16_t* A, int lda, const LAS bf16_t* Bt, int ldb, int lane) {
    const int r = lane & 15, q = lane >> 4;
#pragma unroll
    for (int kk = 0; kk < KT; ++kk) {
        bf16x8 a[MT], b[NT];
#pragma unroll
        for (int mt = 0; mt < MT; ++mt) a[mt] = *(const LAS bf16x8*)(A + (mt * 16 + r) * lda + kk * 32 + q * 8);
#pragma unroll
        for (int nt = 0; nt < NT; ++nt) b[nt] = *(const LAS bf16x8*)(Bt + (nt * 16 + r) * ldb + kk * 32 + q * 8);
#pragma unroll
        for (int mt = 0; mt < MT; ++mt)
#pragma unroll
            for (int nt = 0; nt < NT; ++nt) acc[mt][nt] = __builtin_amdgcn_mfma_f32_16x16x32_bf16(a[mt], b[nt], acc[mt][nt], 0, 0, 0);
    }
}

__device__ __forceinline__ int rowmap(int kind, int n) {
    if (kind == 0) return n;
    if (kind == 1) return 256 * (n >> 7) + (n & 127);
    if (kind == 2) return 256 * (n >> 7) + 128 + (n & 127);
    const int k = n >> 10, mcol = n & 1023, pn = mcol >> 6, ml = mcol & 63, wc = ml >> 4, fq = (ml & 15) >> 2, i = ml & 3;
    return pn * 256 + 128 * (k >> 1) + 32 * wc + 16 * (k & 1) + 4 * fq + i;
}
__device__ __forceinline__ void transpose_item(const float* W, int ldw, int col0, int K, int Ncols, bf16_t* dst, const float* gain, int kind, LAS float* scr, int item, int lane) {
    const int nblk = Ncols / 32, kb = item / nblk, nb = item % nblk, k0 = 64 * kb, n0 = 32 * nb;
#pragma unroll 8
    for (int i = 0; i < 32; ++i) { const int kk = 2 * i + (lane >> 5); float v = W[(size_t)(k0 + kk) * ldw + col0 + n0 + (lane & 31)]; if (gain) v *= gain[k0 + kk]; scr[kk * 33 + (lane & 31)] = v; }
    LDS_WAIT(); asm volatile("" ::: "memory");
    const int c = lane & 7;
#pragma unroll
    for (int j = 0; j < 4; ++j) { const int n = (lane >> 3) + 8 * j; const LAS float* s = scr + (8 * c) * 33 + n;
        u32x4 o; o.x = pk2(s[0 * 33], s[1 * 33]); o.y = pk2(s[2 * 33], s[3 * 33]); o.z = pk2(s[4 * 33], s[5 * 33]); o.w = pk2(s[6 * 33], s[7 * 33]);
        *(u32x4*)(dst + (size_t)rowmap(kind, n0 + n) * K + k0 + 8 * c) = o; }
    LDS_WAIT(); asm volatile("" ::: "memory");
}

__device__ __forceinline__ void s5_tables(const Ctx& c, int l, int g) {
    LAS float* pwr = (LAS float*)c.lds; LAS float* pwi = pwr + 2112; LAS float* bbr = pwi + 2112; LAS float* bbi = bbr + 1024;
    LAS float* cr = bbi + 1024; LAS float* ci = cr + 1024; LAS float* Kj = ci + 1024;
    const int lg = l * 32 + g, tid = c.tid;
    const float* a_re = INP(c, 10) + lg * 64; const float* a_im = INP(c, 11) + lg * 64; const float* log_dt = INP(c, 12) + lg;
    const float* b_re = INP(c, 13) + (size_t)lg * 1024; const float* b_im = INP(c, 14) + (size_t)lg * 1024;
    const float* c_re = INP(c, 15) + (size_t)lg * 1024; const float* c_im = INP(c, 16) + (size_t)lg * 1024;
    if (tid < 64) {
        const int p = tid; const float dtf = expf(log_dt[0]), arf = a_re[p], aif = a_im[p], magf = expf(arf * dtf);
        const double ar = arf, ai = aif, abr = (double)(magf * cosf(aif * dtf)), abi = (double)(magf * sinf(aif * dtf)), den = ar * ar + ai * ai;
        const double zr = ((abr - 1.0) * ar + abi * ai) / den, zi = (abi * ar - (abr - 1.0) * ai) / den;
        double pr = 1.0, pi = 0.0;
        for (int j = 0; j <= 32; ++j) { pwr[p * 33 + j] = (float)pr; pwi[p * 33 + j] = (float)pi; const double nr = pr * abr - pi * abi, ni = pr * abi + pi * abr; pr = nr; pi = ni; }
        float* a32 = (float*)(c.ws + WS_A32) + (g * 64 + p) * 2; a32[0] = pwr[p * 33 + 32]; a32[1] = pwi[p * 33 + 32];
        for (int k = 0; k < 16; ++k) { const double br = b_re[p * 16 + k], bi = b_im[p * 16 + k]; bbr[p * 16 + k] = (float)(zr * br - zi * bi); bbi[p * 16 + k] = (float)(zr * bi + zi * br); }
    }
    for (int i = tid; i < 1024; i += NTHREADS) { cr[i] = c_re[i]; ci[i] = c_im[i]; }
    __syncthreads();
    for (int e = tid; e < 8192; e += NTHREADS) { const int j = e >> 8, cc = (e >> 4) & 15, c2 = e & 15; float s = 0.f;
        for (int p = 0; p < 64; ++p) { const float ar = pwr[p * 33 + j], ai = pwi[p * 33 + j], br = bbr[p * 16 + c2], bi = bbi[p * 16 + c2];
            const float xr = ar * br - ai * bi, xi = ar * bi + ai * br; s += cr[cc * 64 + p] * xr - ci[cc * 64 + p] * xi; }
        Kj[e] = s; }
    __syncthreads();
    bf16_t* dm = (bf16_t*)(c.ws + W_S5M) + (size_t)g * 512 * 640;
    for (int ch = tid; ch < 512 * 80; ch += NTHREADS) { const int row = ch / 80, cch = ch % 80, t = row >> 4, cc = row & 15, col0 = cch * 8; float v[8];
        if (col0 < 64) {
#pragma unroll
            for (int e = 0; e < 8; ++e) { const int p = col0 + e; v[e] = cr[cc * 64 + p] * pwr[p * 33 + t + 1] - ci[cc * 64 + p] * pwi[p * 33 + t + 1]; }
        } else if (col0 < 128) {
#pragma unroll
            for (int e = 0; e < 8; ++e) { const int p = col0 - 64 + e; v[e] = -(cr[cc * 64 + p] * pwi[p * 33 + t + 1] + ci[cc * 64 + p] * pwr[p * 33 + t + 1]); }
        } else { const int s = (col0 - 128) >> 4, cb = (col0 - 128) & 15;
#pragma unroll
            for (int e = 0; e < 8; ++e) v[e] = (s <= t) ? Kj[(t - s) * 256 + cc * 16 + cb + e] : 0.f;
        }
        u32x4 o; o.x = pk2(v[0], v[1]); o.y = pk2(v[2], v[3]); o.z = pk2(v[4], v[5]); o.w = pk2(v[6], v[7]);
        *(u32x4*)(dm + (size_t)row * 640 + col0) = o; }
    bf16_t* de = (bf16_t*)(c.ws + W_S5E) + (size_t)g * 256 * 512;
    for (int ch = tid; ch < 256 * 64; ch += NTHREADS) { const int row = ch >> 6, col0 = (ch & 63) * 8, s = col0 >> 4, cb = col0 & 15; float v[8];
#pragma unroll
        for (int e = 0; e < 8; ++e) {
            if (row < 64) { const int p = row; v[e] = pwr[p * 33 + 31 - s] * bbr[p * 16 + cb + e] - pwi[p * 33 + 31 - s] * bbi[p * 16 + cb + e]; }
            else if (row < 128) { const int p = row - 64; v[e] = pwr[p * 33 + 31 - s] * bbi[p * 16 + cb + e] + pwi[p * 33 + 31 - s] * bbr[p * 16 + cb + e]; }
            else v[e] = 0.f; }
        u32x4 o; o.x = pk2(v[0], v[1]); o.y = pk2(v[2], v[3]); o.z = pk2(v[4], v[5]); o.w = pk2(v[6], v[7]);
        *(u32x4*)(de + (size_t)row * 512 + col0) = o; }
    __syncthreads();
}

__device__ __forceinline__ void phase_wprep(const Ctx& c, int l) {
    for (int g = c.bid; g < 32; g += c.G) s5_tables(c, l, g);
    if (l == 0) {
        const int* pos = (const int*)INP(c, 1); f32x2* rope = (f32x2*)(c.ws + WS_ROPE);
        for (int e = c.bid * NTHREADS + c.tid; e < TOK * 16; e += c.G * NTHREADS) { const int tok = e >> 4, i = e & 15;
            const float ang = (float)pos[tok] * exp2f(-1.1832230355827609f * (float)i); rope[e] = (f32x2){cosf(ang), sinf(ang)}; }
    }
    __syncthreads();
    LAS float* scr = (LAS float*)(c.lds + c.wave * 16384);
    const int gw = c.bid * NWAVES + c.wave, NGW = c.G * NWAVES;
    const float* n1 = INP(c, 2) + l * DM; const float* nm = INP(c, 6) + l * DM; const float* n2 = INP(c, 25) + l * DM;
    const float* wg1 = INP(c, 3) + (size_t)l * DM * DFF; const float* wu1 = INP(c, 4) + (size_t)l * DM * DFF; const float* wd1 = INP(c, 5) + (size_t)l * DFF * DM;
    const float* wg2 = INP(c, 26) + (size_t)l * DM * DFF; const float* wu2 = INP(c, 27) + (size_t)l * DM * DFF; const float* wd2 = INP(c, 28) + (size_t)l * DFF * DM;
    const float* win = INP(c, 7) + (size_t)l * DM * INW; const float* wbr = INP(c, 23) + (size_t)l * 4 * 512 * DM; const float* wout = INP(c, 24) + (size_t)l * DM * DM;
    const float* wglu = INP(c, 18) + (size_t)l * 512 * 1024;
    unsigned char* ws = c.ws;
    for (int it = gw; it < 16384; it += NGW) {
        int r = it;
        if (r < 1408) { transpose_item(wg1, DFF, 0, DM, DFF, (bf16_t*)(ws + W_GU1), n1, 1, scr, r, c.lane); continue; } r -= 1408;
        if (r < 1408) { transpose_item(wu1, DFF, 0, DM, DFF, (bf16_t*)(ws + W_GU1), n1, 2, scr, r, c.lane); continue; } r -= 1408;
        if (r < 1408) { transpose_item(wd1, DM, 0, DFF, DM, (bf16_t*)(ws + W_D1), nullptr, 0, scr, r, c.lane); continue; } r -= 1408;
        if (r < 1408) { transpose_item(wg2, DFF, 0, DM, DFF, (bf16_t*)(ws + W_GU2), n2, 1, scr, r, c.lane); continue; } r -= 1408;
        if (r < 1408) { transpose_item(wu2, DFF, 0, DM, DFF, (bf16_t*)(ws + W_GU2), n2, 2, scr, r, c.lane); continue; } r -= 1408;
        if (r < 1408) { transpose_item(wd2, DM, 0, DFF, DM, (bf16_t*)(ws + W_D2), nullptr, 0, scr, r, c.lane); continue; } r -= 1408;
        if (r < 1792) { transpose_item(win, INW, 0, DM, 3584, (bf16_t*)(ws + W_C1), nm, 0, scr, r, c.lane); continue; } r -= 1792;
        if (r < 2304) { transpose_item(win, INW, 3584, DM, 4608, (bf16_t*)(ws + W_C2), nm, 0, scr, r, c.lane); continue; } r -= 2304;
        if (r < 2048) { transpose_item(win, INW, 8192, DM, 4096, (bf16_t*)(ws + W_GATE), nm, 3, scr, r, c.lane); continue; } r -= 2048;
        if (r < 1024) { const int k = r >> 8; transpose_item(wbr + (size_t)k * 512 * DM, DM, 0, 512, DM, (bf16_t*)(ws + W_BR) + (size_t)k * 1024 * 512, nullptr, 0, scr, r & 255, c.lane); continue; } r -= 1024;
        if (r < 512) { transpose_item(wout, DM, 0, DM, DM, (bf16_t*)(ws + W_OUT), nullptr, 0, scr, r, c.lane); continue; } r -= 512;
        if (r < 128) { transpose_item(wglu, 1024, 0, 512, 512, (bf16_t*)(ws + W_GLU), nullptr, 1, scr, r, c.lane); continue; } r -= 128;
        transpose_item(wglu, 1024, 512, 512, 512, (bf16_t*)(ws + W_GLU), nullptr, 2, scr, r, c.lane);
    }
}

__device__ __forceinline__ void phase_norm(const Ctx& c, const float* x, bf16_t* xn) {
    const int gw = c.bid * NWAVES + c.wave, NGW = c.G * NWAVES;
    for (int row = gw; row < TOK; row += NGW) {
        const f32x4* xr = (const f32x4*)(x + (size_t)row * DM) + c.lane; f32x4 v[4]; float s = 0.f;
#pragma unroll
        for (int j = 0; j < 4; ++j) { v[j] = xr[64 * j]; s += (v[j][0] * v[j][0] + v[j][1] * v[j][1]) + (v[j][2] * v[j][2] + v[j][3] * v[j][3]); }
        const float rs = 1.f / sqrtf(wave_sum(s) * (1.f / DM) + NORM_EPS);
        u32x2* o = (u32x2*)(xn + (size_t)row * DM) + c.lane;
#pragma unroll
        for (int j = 0; j < 4; ++j) { u32x2 w; w.x = pk2(v[j][0] * rs, v[j][1] * rs); w.y = pk2(v[j][2] * rs, v[j][3] * rs); o[64 * j] = w; }
    }
}
__device__ __forceinline__ void phase_final_norm(const Ctx& c, float* x, const float* gain) {
    const int gw = c.bid * NWAVES + c.wave, NGW = c.G * NWAVES;
    for (int row = gw; row < TOK; row += NGW) {
        f32x4* xr = (f32x4*)(x + (size_t)row * DM) + c.lane; f32x4 v[4]; float s = 0.f;
#pragma unroll
        for (int j = 0; j < 4; ++j) { v[j] = xr[64 * j]; s += (v[j][0] * v[j][0] + v[j][1] * v[j][1]) + (v[j][2] * v[j][2] + v[j][3] * v[j][3]); }
        const float rs = 1.f / sqrtf(wave_sum(s) * (1.f / DM) + NORM_EPS);
#pragma unroll
        for (int j = 0; j < 4; ++j) { const f32x4 gn = ((const f32x4*)gain)[c.lane + 64 * j]; xr[64 * j] = v[j] * rs * gn; }
    }
}

__device__ __forceinline__ void phase_conv(const Ctx& c, int l) {
    LAS float* z = (LAS float*)c.lds; LAS float* red = z + 62 * 512;
    const bf16_t* cin = (const bf16_t*)(c.ws + R_CONV); bf16_t* yc = (bf16_t*)(c.ws + WS_Y) + (size_t)2 * TOK * 512;
    const int ch = c.tid;
    const float* cw = INP(c, 19) + (size_t)l * 31 * 512; const float cb = INP(c, 20)[l * 512 + ch], lg = INP(c, 21)[l * 512 + ch], lb = INP(c, 22)[l * 512 + ch];
    float w[31];
#pragma unroll
    for (int j = 0; j < 31; ++j) w[j] = cw[j * 512 + ch];
    for (int unit = c.bid; unit < TOK / 32; unit += c.G) {
        const int b = unit >> 8, t0 = (unit & 255) * 32;
        for (int r = 0; r < 62; ++r) { const int t = t0 - 30 + r; float v = 0.f;
            if (t >= 0) { const bf16_t* rp = cin + (size_t)(b * SEQ + t) * 1024; v = bf2f(rp[ch]) * sigm(bf2f(rp[512 + ch])); }
            z[r * 512 + ch] = v; }
        __syncthreads();
#pragma unroll 1
        for (int blk = 0; blk < 4; ++blk) {
            float zr[38];
#pragma unroll
            for (int i = 0; i < 38; ++i) zr[i] = z[(blk * 8 + i) * 512 + ch];
            float o[8];
#pragma unroll
            for (int tt = 0; tt < 8; ++tt) { float a = cb;
#pragma unroll
                for (int j = 0; j < 31; ++j) a += w[j] * zr[tt + j];
                o[tt] = a; }
            LAS float* rb = red + (blk & 1) * 128;
#pragma unroll
            for (int tt = 0; tt < 8; ++tt) { const float s1 = wave_sum(o[tt]), s2 = wave_sum(o[tt] * o[tt]); if (c.lane == 0) { rb[c.wave * 16 + tt * 2] = s1; rb[c.wave * 16 + tt * 2 + 1] = s2; } }
            __syncthreads();
#pragma unroll
            for (int tt = 0; tt < 8; ++tt) { float s1 = 0.f, s2 = 0.f;
#pragma unroll
                for (int wv = 0; wv < 8; ++wv) { s1 += rb[wv * 16 + tt * 2]; s2 += rb[wv * 16 + tt * 2 + 1]; }
                const float mean = s1 * (1.f / 512.f), var = fmaxf(s2 * (1.f / 512.f) - mean * mean, 0.f), rstd = 1.f / sqrtf(var + NORM_EPS);
                const float y = (o[tt] - mean) * rstd * lg + lb;
                yc[(size_t)(b * SEQ + t0 + blk * 8 + tt) * 512 + ch] = (bf16_t)f2bf(siluf(y)); }
        }
        __syncthreads();
    }
}

__device__ __forceinline__ float hg_lb(const Ctx& c, int l, int col) {
    if (l == 0) return 0.f;
    const float z0 = INP(c, 8)[col], z1 = INP(c, 8)[512 + col], m = fmaxf(z0, z1), e0 = expf(z0 - m), e1 = expf(z1 - m);
    return e1 / (e0 + e1);
}
__device__ __forceinline__ void hg_logf(const bf16_t* hf, int row0, int col, float lbv, int k, int rg, LAS float* bL, LAS float* seg, float (&kk)[16]) {
    float run = 0.f;
#pragma unroll
    for (int j = 0; j < 16; ++j) { const int s = rg * 16 + j; const float f = bf2f(hf[(size_t)(row0 + s) * 512 + col]);
        const float ex = expf(-f), sg = 1.f / (1.f + ex);
        const float lf = (lbv == 0.f) ? -log1pf(ex) : logf(lbv + (1.f - lbv) * sg);
        kk[j] = (1.f - lbv) * ex * sg; run += lf; bL[s * 129 + k] = run; }
    seg[rg * 128 + k] = run;
}
__device__ __forceinline__ void hg_load_vT(const bf16_t* hv, int row0, int col, int k, int rg, LAS bf16_t* vT) {
    unsigned w[8];
#pragma unroll
    for (int j = 0; j < 8; ++j) { const unsigned lo = hv[(size_t)(row0 + rg * 16 + 2 * j) * 512 + col], hi = hv[(size_t)(row0 + rg * 16 + 2 * j + 1) * 512 + col]; w[j] = lo | (hi << 16); }
    LAS u32x4* d = (LAS u32x4*)(vT + k * 72 + rg * 16);
    d[0] = (u32x4){w[0], w[1], w[2], w[3]}; d[1] = (u32x4){w[4], w[5], w[6], w[7]};
}
constexpr int HG1_KDT = 35072, HG1_VT = 53504;
__device__ __forceinline__ void phase_hg1(const Ctx& c, int l) {
    LAS float* bL = (LAS float*)c.lds; LAS float* seg = bL + 64 * 129;
    LAS bf16_t* kdT = (LAS bf16_t*)(c.lds + HG1_KDT); LAS bf16_t* vT = (LAS bf16_t*)(c.lds + HG1_VT);
    const bf16_t* hf = (const bf16_t*)(c.ws + R_HQ) + (size_t)TOK * 512; const bf16_t* hv = hf + (size_t)TOK * 512;
    bf16_t* hst = (bf16_t*)(c.ws + R_HST); float* hgd = (float*)(c.ws + WS_HGD);
    const int k = c.tid & 127, rg = c.tid >> 7, r = c.lane & 15, q = c.lane >> 4;
    for (int unit = c.bid; unit < 1024; unit += c.G) {
        const int b = unit >> 9, n = (unit >> 2) & 127, h = unit & 3, row0 = b * SEQ + n * 64, col = h * 128 + k;
        const float lbv = hg_lb(c, l, col);
        float kk[16];
        hg_logf(hf, row0, col, lbv, k, rg, bL, seg, kk);
        hg_load_vT(hv, row0, col, k, rg, vT);
        __syncthreads();
        float pre = 0.f;
        for (int s = 0; s < rg; ++s) pre += seg[s * 128 + k];
        const float blast = (seg[k] + seg[128 + k]) + (seg[256 + k] + seg[384 + k]);
        unsigned w[8];
#pragma unroll
        for (int j = 0; j < 8; ++j) { const int s = rg * 16 + 2 * j;
            const float b0 = bL[s * 129 + k] + pre, b1 = bL[(s + 1) * 129 + k] + pre;
            w[j] = pk2(kk[2 * j] * expf(blast - b0), kk[2 * j + 1] * expf(blast - b1)); }
        { LAS u32x4* d = (LAS u32x4*)(kdT + k * 72 + rg * 16); d[0] = (u32x4){w[0], w[1], w[2], w[3]}; d[1] = (u32x4){w[4], w[5], w[6], w[7]}; }
        if (rg == 0) hgd[unit * 128 + k] = expf(blast);
        __syncthreads();
        f32x4 acc[1][8];
#pragma unroll
        for (int nt = 0; nt < 8; ++nt) acc[0][nt] = (f32x4){0.f, 0.f, 0.f, 0.f};
        wave_mma<1, 8, 2>(acc, vT + (16 * c.wave) * 72, 72, kdT, 72, c.lane);
        bf16_t* dst = hst + (size_t)unit * 16384;
#pragma unroll
        for (int nt = 0; nt < 8; ++nt)
#pragma unroll
            for (int j = 0; j < 4; ++j) dst[(16 * c.wave + 4 * q + j) * 128 + nt * 16 + r] = (bf16_t)f2bf(acc[0][nt][j]);
        __syncthreads();
    }
}
__device__ __forceinline__ void phase_hg2(const Ctx& c) {
    bf16_t* hst = (bf16_t*)(c.ws + R_HST); const float* hgd = (const float*)(c.ws + WS_HGD);
    for (int idx = c.bid * NTHREADS + c.tid; idx < 65536; idx += c.G * NTHREADS) {
        const int bh = idx >> 13, e2 = idx & 8191, b = bh >> 2, h = bh & 3, kc = (e2 * 2) & 127;
        float s0 = 0.f, s1 = 0.f;
        for (int n0 = 0; n0 < 128; n0 += 8) {
            unsigned u[8]; f32x2 d[8];
#pragma unroll
            for (int i = 0; i < 8; ++i) { const int unit = (b * 128 + n0 + i) * 4 + h; u[i] = ((const unsigned*)(hst + (size_t)unit * 16384))[e2]; d[i] = *(const f32x2*)(hgd + unit * 128 + kc); }
#pragma unroll
            for (int i = 0; i < 8; ++i) { const int unit = (b * 128 + n0 + i) * 4 + h; ((unsigned*)(hst + (size_t)unit * 16384))[e2] = pk2(s0, s1);
                s0 = d[i][0] * s0 + bflo(u[i]); s1 = d[i][1] * s1 + bfhi(u[i]); }
        }
    }
}
constexpr int HG3_QD = 35072, HG3_ST = 52480, HG3_QT = 87296, HG3_KT = 104704, HG3_P = 122112, HG3_VT = 131328;
static_assert(HG3_VT + 128 * 72 * 2 <= LDS_BYTES, "hg3 LDS map");
__device__ __forceinline__ void phase_hg3(const Ctx& c, int l) {
    LAS float* bL = (LAS float*)c.lds; LAS float* seg = bL + 64 * 129;
    LAS bf16_t* qd = (LAS bf16_t*)(c.lds + HG3_QD); LAS bf16_t* ST = (LAS bf16_t*)(c.lds + HG3_ST); LAS bf16_t* qt = (LAS bf16_t*)(c.lds + HG3_QT);
    LAS bf16_t* kt = (LAS bf16_t*)(c.lds + HG3_KT); LAS bf16_t* P = (LAS bf16_t*)(c.lds + HG3_P); LAS bf16_t* vT = (LAS bf16_t*)(c.lds + HG3_VT);
    const bf16_t* hq = (const bf16_t*)(c.ws + R_HQ); const bf16_t* hf = hq + (size_t)TOK * 512; const bf16_t* hv = hf + (size_t)TOK * 512; const bf16_t* hg = hv + (size_t)TOK * 512;
    const bf16_t* hst = (const bf16_t*)(c.ws + R_HST); bf16_t* ya = (bf16_t*)(c.ws + WS_Y);
    const float* gnorm = INP(c, 9) + l * 512;
    const int k = c.tid & 127, rg = c.tid >> 7, r = c.lane & 15, q = c.lane >> 4, w = c.wave;
    for (int unit = c.bid; unit < 1024; unit += c.G) {
        const int b = unit >> 9, n = (unit >> 2) & 127, h = unit & 3, row0 = b * SEQ + n * 64, col = h * 128 + k;
        const float lbv = hg_lb(c, l, col);
        float kk[16];
        hg_logf(hf, row0, col, lbv, k, rg, bL, seg, kk);
        hg_load_vT(hv, row0, col, k, rg, vT);
#pragma unroll
        for (int i = 0; i < 4; ++i) { const int id = c.tid + NTHREADS * i, v = id >> 4, cc = id & 15;
            *(LAS u32x4*)(ST + v * 136 + cc * 8) = *(const u32x4*)(hst + (size_t)unit * 16384 + v * 128 + cc * 8); }
        __syncthreads();
        float pre = 0.f;
        for (int s = 0; s < rg; ++s) pre += seg[s * 128 + k];
        const float bref = bL[31 * 129 + k] + seg[k];
#pragma unroll
        for (int j = 0; j < 16; ++j) { const int s = rg * 16 + j; const float bv = bL[s * 129 + k] + pre;
            const float qf = siluf(bf2f(hq[(size_t)(row0 + s) * 512 + col])) * 0.08838834764831845f;
            qd[s * 136 + k] = (bf16_t)f2bf(qf * expf(bv));
            qt[s * 136 + k] = (bf16_t)f2bf(qf * expf(fminf(bv - bref, 80.f)));
            kt[s * 136 + k] = (bf16_t)f2bf(kk[j] * expf(fminf(bref - bv, 80.f))); }
        __syncthreads();
        {
            f32x4 a2[1][2] = {{(f32x4){0.f, 0.f, 0.f, 0.f}, (f32x4){0.f, 0.f, 0.f, 0.f}}};
            wave_mma<1, 2, 4>(a2, qt + (16 * (w >> 1)) * 136, 136, kt + (32 * (w & 1)) * 136, 136, c.lane);
#pragma unroll
            for (int nt = 0; nt < 2; ++nt)
#pragma unroll
                for (int j = 0; j < 4; ++j) { const int t = 16 * (w >> 1) + 4 * q + j, s = 32 * (w & 1) + nt * 16 + r; P[t * 72 + s] = (bf16_t)f2bf(s <= t ? a2[0][nt][j] : 0.f); }
        }
        __syncthreads();
        {
            f32x4 a4[1][4];
#pragma unroll
            for (int nt = 0; nt < 4; ++nt) a4[0][nt] = (f32x4){0.f, 0.f, 0.f, 0.f};
            wave_mma<1, 4, 4>(a4, qd + (16 * (w >> 1)) * 136, 136, ST + (64 * (w & 1)) * 136, 136, c.lane);
            wave_mma<1, 4, 2>(a4, P + (16 * (w >> 1)) * 72, 72, vT + (64 * (w & 1)) * 72, 72, c.lane);
#pragma unroll
            for (int nt = 0; nt < 4; ++nt)
#pragma unroll
                for (int j = 0; j < 4; ++j) bL[(16 * (w >> 1) + 4 * q + j) * 129 + 64 * (w & 1) + nt * 16 + r] = a4[0][nt][j];
        }
        __syncthreads();
        {
            const int t = c.tid >> 3, v0 = (c.tid & 7) * 16; float o[16]; float ss = 0.f;
#pragma unroll
            for (int e = 0; e < 16; ++e) { o[e] = bL[t * 129 + v0 + e]; ss += o[e] * o[e]; }
            ss += __shfl_xor(ss, 1); ss += __shfl_xor(ss, 2); ss += __shfl_xor(ss, 4);
            const float rs = 1.f / sqrtf(ss * (1.f / 128.f) + NORM_EPS);
            const bf16_t* gp = hg + (size_t)(row0 + t) * 512 + h * 128 + v0; const u32x4 g0 = *(const u32x4*)gp, g1 = *(const u32x4*)(gp + 8);
            const unsigned gw[8] = {g0.x, g0.y, g0.z, g0.w, g1.x, g1.y, g1.z, g1.w}; unsigned ow[8];
#pragma unroll
            for (int e = 0; e < 8; ++e) { const float ga = bflo(gw[e]), gb = bfhi(gw[e]);
                ow[e] = pk2(o[2 * e] * rs * gnorm[h * 128 + v0 + 2 * e] * siluf(ga), o[2 * e + 1] * rs * gnorm[h * 128 + v0 + 2 * e + 1] * siluf(gb)); }
            bf16_t* yp = ya + (size_t)(row0 + t) * 512 + h * 128 + v0;
            *(u32x4*)yp = (u32x4){ow[0], ow[1], ow[2], ow[3]}; *(u32x4*)(yp + 8) = (u32x4){ow[4], ow[5], ow[6], ow[7]};
        }
        __syncthreads();
    }
}

__device__ __forceinline__ void phase_s5scan(const Ctx& c) {
    const int idx = c.bid * NTHREADS + c.tid;
    if (idx >= 4096) return;
    const int b = idx >> 11, g = (idx >> 6) & 31, p = idx & 63;
    const float* a32 = (const float*)(c.ws + WS_A32) + (g * 64 + p) * 2; const float ar = a32[0], ai = a32[1];
    bf16_t* s5A = (bf16_t*)(c.ws + R_S5A); const float* E = (const float*)(c.ws + WS_S5E);
    float xr = 0.f, xi = 0.f;
    for (int n0 = 0; n0 < 256; n0 += 8) {
        float er[8], ei[8];
#pragma unroll
        for (int i = 0; i < 8; ++i) { const size_t row = (size_t)g * 512 + b * 256 + n0 + i; er[i] = E[row * 128 + p]; ei[i] = E[row * 128 + 64 + p]; }
#pragma unroll
        for (int i = 0; i < 8; ++i) { const size_t row = (size_t)g * 512 + b * 256 + n0 + i; s5A[row * 640 + p] = (bf16_t)f2bf(xr); s5A[row * 640 + 64 + p] = (bf16_t)f2bf(xi);
            const float nr = ar * xr - ai * xi + er[i], ni = ar * xi + ai * xr + ei[i]; xr = nr; xi = ni; }
    }
}

constexpr int AT_K = 17408, AT_VT = 69632, AT_S = 120832;
static_assert(AT_S + 32 * 196 * 4 <= LDS_BYTES, "attention LDS map");
__device__ __forceinline__ float wave_max(float v) {
#pragma unroll
    for (int o = 1; o < 64; o <<= 1) v = fmaxf(v, __shfl_xor(v, o));
    return v;
}
__device__ __forceinline__ void attn_stage_rope(LAS bf16_t* dst, const bf16_t* src, const f32x2* rope_b, int first, int nrows, int sh, int res, int tid) {
    for (int id = tid; id < nrows * 16; id += NTHREADS) {
        const int row = id >> 4, cc = id & 15, idx = first + row; u32x4 v = (u32x4){0u, 0u, 0u, 0u};
        if (idx >= 0) { const int tok = (idx << sh) + res; const bf16_t* rp = src + (size_t)tok * 128;
            v = *(const u32x4*)(rp + cc * 8);
            if (cc < 4) { const u32x4 pv = *(const u32x4*)(rp + (cc ^ 2) * 8); const f32x4* cs = (const f32x4*)(rope_b + (size_t)tok * 16 + 8 * (cc & 1));
                const unsigned vw[4] = {v.x, v.y, v.z, v.w}, pw[4] = {pv.x, pv.y, pv.z, pv.w}; unsigned ow[4];
#pragma unroll
                for (int e = 0; e < 4; ++e) { const f32x4 t = cs[e];
                    const float x0 = bflo(vw[e]), x1 = bfhi(vw[e]), y0 = bflo(pw[e]), y1 = bfhi(pw[e]);
                    float o0, o1;
                    if (cc < 2) { o0 = x0 * t[0] - y0 * t[1]; o1 = x1 * t[2] - y1 * t[3]; }
                    else        { o0 = x0 * t[0] + y0 * t[1]; o1 = x1 * t[2] + y1 * t[3]; }
                    ow[e] = pk2(o0, o1); }
                v = (u32x4){ow[0], ow[1], ow[2], ow[3]}; } }
        *(LAS u32x4*)(dst + row * 136 + cc * 8) = v; }
}
__device__ __forceinline__ void phase_attn(const Ctx& c) {
    LAS bf16_t* Qs = (LAS bf16_t*)c.lds; LAS bf16_t* Ks = (LAS bf16_t*)(c.lds + AT_K); LAS bf16_t* Vt = (LAS bf16_t*)(c.lds + AT_VT); LAS float* S = (LAS float*)(c.lds + AT_S);
    bf16_t* qkv = (bf16_t*)(c.ws + R_QKV); float* lse = (float*)(c.ws + WS_LSE); const f32x2* rope = (const f32x2*)(c.ws + WS_ROPE);
    const int r = c.lane & 15, q = c.lane >> 4, w = c.wave;
    for (int unit = c.bid; unit < 3072; unit += c.G) {
        const int bh = unit >> 7, u7 = unit & 127, b = bh / 12, h = bh % 12, sh = 2 * (h >> 2), per = 128 >> sh, res = u7 / per, jb = u7 % per;
        const int i0 = 64 * jb, j0 = i0 - 128;
        bf16_t* qb = qkv + (size_t)bh * SEQ * 128; const bf16_t* kb = qkv + QKV_WHICH + (size_t)bh * SEQ * 128; const bf16_t* vb = qkv + 2 * QKV_WHICH + (size_t)bh * SEQ * 128;
        const f32x2* rope_b = rope + (size_t)b * SEQ * 16;
        attn_stage_rope(Qs, qb, rope_b, i0, 64, sh, res, c.tid);
        attn_stage_rope(Ks, kb, rope_b, j0, 192, sh, res, c.tid);
#pragma unroll
        for (int ps = 0; ps < 3; ++ps)
#pragma unroll
            for (int hf = 0; hf < 2; ++hf) { const int kk = ps * 64 + c.lane, cc = w + 8 * hf, idx = j0 + kk; u32x4 v = (u32x4){0u, 0u, 0u, 0u};
                if (idx >= 0) v = *(const u32x4*)(vb + (size_t)((idx << sh) + res) * 128 + cc * 8);
                const unsigned vw[4] = {v.x, v.y, v.z, v.w};
#pragma unroll
                for (int e = 0; e < 4; ++e) { Vt[(cc * 8 + 2 * e) * 200 + kk] = (bf16_t)(vw[e] & 0xffffu); Vt[(cc * 8 + 2 * e + 1) * 200 + kk] = (bf16_t)(vw[e] >> 16); } }
        __syncthreads();
#pragma unroll 1
        for (int hq = 0; hq < 2; ++hq) {
            {
                f32x4 a3[1][3];
#pragma unroll
                for (int nt = 0; nt < 3; ++nt) a3[0][nt] = (f32x4){0.f, 0.f, 0.f, 0.f};
                wave_mma<1, 3, 4>(a3, Qs + (32 * hq + 16 * (w & 1)) * 136, 136, Ks + (48 * (w >> 1)) * 136, 136, c.lane);
#pragma unroll
                for (int nt = 0; nt < 3; ++nt)
#pragma unroll
                    for (int j = 0; j < 4; ++j) { const int t = 16 * (w & 1) + 4 * q + j, kk = 48 * (w >> 1) + nt * 16 + r, i = i0 + 32 * hq + t, jn = j0 + kk;
                        const bool ok = (jn >= 0) && (jn <= i) && (i - jn <= 128);
                        S[t * 196 + kk] = ok ? a3[0][nt][j] * 0.08838834764831845f : -1e30f; }
            }
            __syncthreads();
#pragma unroll
            for (int rr = 0; rr < 4; ++rr) { const int t = 4 * w + rr; LAS float* sr = S + t * 196;
                const float s0 = sr[c.lane], s1 = sr[64 + c.lane], s2 = sr[128 + c.lane];
                const float m = wave_max(fmaxf(s0, fmaxf(s1, s2)));
                const float e0 = __expf(s0 - m), e1 = __expf(s1 - m), e2 = __expf(s2 - m);
                const float sum = wave_sum(e0 + e1 + e2), inv = 1.f / sum;
                LAS bf16_t* pr = (LAS bf16_t*)sr;
                pr[c.lane] = (bf16_t)f2bf(e0 * inv); pr[64 + c.lane] = (bf16_t)f2bf(e1 * inv); pr[128 + c.lane] = (bf16_t)f2bf(e2 * inv);
                if (c.lane == 0) lse[(size_t)bh * SEQ + (((i0 + 32 * hq + t) << sh) + res)] = m + logf(sum); }
            __syncthreads();
            {
                f32x4 a2[1][2] = {{(f32x4){0.f, 0.f, 0.f, 0.f}, (f32x4){0.f, 0.f, 0.f, 0.f}}};
                wave_mma<1, 2, 6>(a2, (LAS bf16_t*)S + (16 * (w & 1)) * 392, 392, Vt + (32 * (w >> 1)) * 200, 200, c.lane);
#pragma unroll
                for (int nt = 0; nt < 2; ++nt)
#pragma unroll
                    for (int j = 0; j < 4; ++j) { const int t = 16 * (w & 1) + 4 * q + j, dim = 32 * (w >> 1) + nt * 16 + r, tok = ((i0 + 32 * hq + t) << sh) + res;
                        qb[(size_t)tok * 128 + dim] = (bf16_t)f2bf(a2[0][nt][j]); }
            }
            __syncthreads();
        }
    }
}
__device__ __forceinline__ void phase_attn_merge(const Ctx& c) {
    const bf16_t* qkv = (const bf16_t*)(c.ws + R_QKV); const float* lse = (const float*)(c.ws + WS_LSE); bf16_t* yd = (bf16_t*)(c.ws + WS_Y) + (size_t)3 * TOK * 512;
    for (int id = c.bid * NTHREADS + c.tid; id < TOK * 64; id += c.G * NTHREADS) {
        const int row = id >> 6, hp = (id >> 4) & 3, cc = id & 15, b = row >> 13, t = row & 8191;
        float lw[3]; u32x4 ov[3];
#pragma unroll
        for (int g = 0; g < 3; ++g) { const int bh = b * 12 + g * 4 + hp; lw[g] = lse[(size_t)bh * SEQ + t]; ov[g] = *(const u32x4*)(qkv + ((size_t)bh * SEQ + t) * 128 + cc * 8); }
        const float m = fmaxf(lw[0], fmaxf(lw[1], lw[2])); float e[3], s = 0.f;
#pragma unroll
        for (int g = 0; g < 3; ++g) { e[g] = __expf(lw[g] - m); s += e[g]; }
        const float inv = 1.f / s; float o[8];
#pragma unroll
        for (int i = 0; i < 8; ++i) o[i] = 0.f;
#pragma unroll
        for (int g = 0; g < 3; ++g) { const float wg = e[g] * inv; const unsigned vw[4] = {ov[g].x, ov[g].y, ov[g].z, ov[g].w};
#pragma unroll
            for (int i = 0; i < 4; ++i) { o[2 * i] += wg * bflo(vw[i]); o[2 * i + 1] += wg * bfhi(vw[i]); } }
        *(u32x4*)(yd + (size_t)row * 512 + hp * 128 + cc * 8) = (u32x4){pk2(o[0], o[1]), pk2(o[2], o[3]), pk2(o[4], o[5]), pk2(o[6], o[7])};
    }
}

constexpr int PH_PER_LAYER = 17, N_PHASES = NLAYER * PH_PER_LAYER + 1;
#ifndef MK_MASK
#define MK_MASK 0xFFFFF
#endif
#ifndef MK_SPLIT
#define MK_SPLIT 0
#endif

template <class Epi> __device__ __forceinline__ void run_gemm(const Ctx& c, const bf16_t* A, int lda, const bf16_t* Bt, int ldb, int K, int N, const Epi& E) {
    pg8::Gemm g{A, Bt, lda, ldb, K}; pg8::StaticOrder S; S.init(TOK, N, c.G, c.bid, lda, ldb);
    int t_ = c.tid; asm volatile("" : "+v"(t_));
    pg8::gemm_phase<Epi, pg8::StaticOrder, true, true>(c.lds, g, S, E, t_);
}

__global__ void __launch_bounds__(NTHREADS, 2) hgpm_fwd(Args args) {
    extern __shared__ __attribute__((aligned(16))) unsigned char lds_raw[];
    Ctx c; c.lds = (LAS unsigned char*)lds_raw; c.G = gridDim.x; c.bid = blockIdx.x; c.in = args.in;

    for (int ph = args.ph_lo; ph < args.ph_hi; ++ph) {
        const int l = ph / PH_PER_LAYER, p = ph % PH_PER_LAYER;
        { int t_ = threadIdx.x; asm volatile("" : "+v"(t_)); c.tid = t_; c.lane = t_ & 63; c.wave = __builtin_amdgcn_readfirstlane(t_ >> 6); }
        { int z_ = 0; asm volatile("" : "+s"(z_)); c.zo = z_; c.ws = args.ws + z_; c.out = args.out + z_; }
        unsigned char* ws = c.ws;
        bf16_t* XN = (bf16_t*)(ws + WS_XN); bf16_t* Y = (bf16_t*)(ws + WS_Y); bf16_t* MERGED = (bf16_t*)(ws + WS_MERGED); bf16_t* Z = MERGED;
        bf16_t* HBUF = (bf16_t*)(ws + R_HBUF); bf16_t* BALL = (bf16_t*)(ws + R_BALL); bf16_t* S5A = (bf16_t*)(ws + R_S5A);
        if (ph == N_PHASES - 1) { phase_final_norm(c, c.out, INP(c, 29)); }
        else switch (p) {
#if (MK_MASK >> 0) & 1
        case 0: phase_wprep(c, l); phase_norm(c, l == 0 ? INP(c, 0) : c.out, XN); break;
#endif
#if (MK_MASK >> 1) & 1
        case 1: case 15: run_gemm(c, XN, DM, (const bf16_t*)(ws + (p == 1 ? W_GU1 : W_GU2)), DM, DM, 2 * DFF, pg8::EpiGated<0>{HBUF, DFF}); break;
#endif
#if (MK_MASK >> 2) & 1
        case 2: case 16: run_gemm(c, HBUF, DFF, (const bf16_t*)(ws + (p == 2 ? W_D1 : W_D2)), DFF, DFF, DM, pg8::EpiResid{(l == 0 && p == 2) ? INP(c, 0) : c.out, c.out, 0.5f}); break;
#endif
#if (MK_MASK >> 3) & 1
        case 3: case 14: phase_norm(c, c.out, XN); break;
#endif
#if (MK_MASK >> 4) & 1
        case 4: run_gemm(c, XN, DM, (const bf16_t*)(ws + W_C1), DM, DM, 3584, pg8::EpiC1{(bf16_t*)(ws + R_HQ), S5A, (bf16_t*)(ws + R_CONV)}); break;
#endif
#if (MK_MASK >> 5) & 1
        case 5: { pg8::Gemm g{S5A, (const bf16_t*)(ws + W_S5E), 640, 512, 512}; pg8::S5eOrder S{c.G, c.bid};
#if (MK_MASK >> 19) & 1
                  pg8::gemm_phase<pg8::EpiS5e, pg8::S5eOrder, true, true>(c.lds, g, S, pg8::EpiS5e{(float*)(ws + WS_S5E)}, c.tid);
#endif
#if (MK_MASK >> 16) & 1
                  phase_hg1(c, l);
#endif
#if (MK_MASK >> 17) & 1
                  phase_conv(c, l);
#endif
                  } break;
#endif
#if (MK_MASK >> 6) & 1
        case 6: phase_hg2(c); phase_s5scan(c); break;
#endif
#if (MK_MASK >> 7) & 1
        case 7: { pg8::Gemm g{S5A, (const bf16_t*)(ws + W_S5M), 640, 640, 640}; pg8::S5mOrder S{c.G, c.bid};
#if (MK_MASK >> 19) & 1
                  pg8::gemm_phase<pg8::EpiS5m, pg8::S5mOrder, true, true>(c.lds, g, S, pg8::EpiS5m{S5A, INP(c, 17) + l * 512, Z}, c.tid);
#endif
#if (MK_MASK >> 18) & 1
                  phase_hg3(c, l);
#endif
                  } break;
#endif
#if (MK_MASK >> 8) & 1
        case 8:
#if (MK_MASK >> 16) & 1
                run_gemm(c, Z, 512, (const bf16_t*)(ws + W_GLU), 512, 512, 1024, pg8::EpiGated<1>{Y + (size_t)TOK * 512, 512});
#endif
#if (MK_MASK >> 17) & 1
                run_gemm(c, XN, DM, (const bf16_t*)(ws + W_C2), DM, DM, 4608, pg8::EpiC2{(bf16_t*)(ws + R_QKV)});
#endif
                break;
#endif
#if (MK_MASK >> 9) & 1
        case 9: phase_attn(c); break;
#endif
#if (MK_MASK >> 10) & 1
        case 10: phase_attn_merge(c); break;
#endif
#if (MK_MASK >> 11) & 1
        case 11: { pg8::Gemm g{Y, (const bf16_t*)(ws + W_BR), 512, 512, 512}; pg8::BranchOrder S; S.init(c.G, c.bid);
                   pg8::gemm_phase<pg8::EpiBranch, pg8::BranchOrder, true, true>(c.lds, g, S, pg8::EpiBranch{BALL}, c.tid); } break;
#endif
#if (MK_MASK >> 12) & 1
        case 12: run_gemm(c, XN, DM, (const bf16_t*)(ws + W_GATE), DM, DM, 4096, pg8::EpiGateMerge{BALL, MERGED}); break;
#endif
#if (MK_MASK >> 13) & 1
        case 13: run_gemm(c, MERGED, DM, (const bf16_t*)(ws + W_OUT), DM, DM, DM, pg8::EpiResid{c.out, c.out, 1.0f}); break;
#endif
        }
        if (ph + 1 < args.ph_hi) { __syncthreads(); cg::this_grid().sync(); }
    }
}

extern "C" void kernel_launch(void* const* d_in, const int* in_sizes, int n_in, void* d_out, int out_size, void* d_ws, size_t ws_size, hipStream_t stream) {
    static int grid = 0;
    if (grid == 0) {
        if (n_in != 30 || in_sizes[0] != TOK * DM || out_size != TOK * DM || ws_size < WS_END) {
            fprintf(stderr, "kernel_launch: unexpected problem: n_in %d, in0 %d, out %d, ws %zu (need %zu)\n", n_in, n_in > 0 ? in_sizes[0] : -1, out_size, ws_size, (size_t)WS_END); grid = -1; return; }
        int dev = 0, cus = 0, per_cu = 0;
        if (hipGetDevice(&dev) != hipSuccess || hipDeviceGetAttribute(&cus, hipDeviceAttributeMultiprocessorCount, dev) != hipSuccess) { fprintf(stderr, "kernel_launch: device query failed\n"); grid = -1; return; }
        if (hipFuncSetAttribute((const void*)hgpm_fwd, hipFuncAttributeMaxDynamicSharedMemorySize, LDS_BYTES) != hipSuccess) { fprintf(stderr, "kernel_launch: hipFuncSetAttribute failed\n"); grid = -1; return; }
        if (hipOccupancyMaxActiveBlocksPerMultiprocessor(&per_cu, (const void*)hgpm_fwd, NTHREADS, LDS_BYTES) != hipSuccess || per_cu < 1) { fprintf(stderr, "kernel_launch: occupancy query says %d blocks per CU\n", per_cu); (void)hipGetLastError(); grid = -1; return; }
        grid = cus * 1;
    }
    if (grid < 0) return;
    (void)hipMemsetAsync((char*)d_ws + WS_CTL, 0, 1 * MiB, stream);
    Args a{};
    for (int i = 0; i < 30; ++i) a.in[i] = (const float*)d_in[i];
    a.out = (float*)d_out; a.ws = (unsigned char*)d_ws;
#if MK_SPLIT
    for (int ph = 0; ph < N_PHASES; ++ph) { a.ph_lo = ph; a.ph_hi = ph + 1; hipLaunchKernelGGL(hgpm_fwd, dim3(grid), dim3(NTHREADS), LDS_BYTES, stream, a); }
#else
    a.ph_lo = 0; a.ph_hi = N_PHASES;
    void* kargs[] = {&a};
    const hipError_t e = hipLaunchCooperativeKernel((const void*)hgpm_fwd, dim3(grid), dim3(NTHREADS), kargs, LDS_BYTES, stream);
    if (e != hipSuccess) fprintf(stderr, "kernel_launch: cooperative launch failed: %s (grid %d)\n", hipGetErrorString(e), grid);
#endif
}
```

```cpp
#include <hip/hip_runtime.h>
#include <hip/hip_cooperative_groups.h>
#include <cstdio>
#include <cstdint>
namespace cg = cooperative_groups;

#define LAS __attribute__((address_space(3)))
typedef unsigned short bf16_t;
typedef short bf16x8 __attribute__((ext_vector_type(8)));
typedef float f32x4 __attribute__((ext_vector_type(4)));
typedef float f32x2 __attribute__((ext_vector_type(2)));
typedef unsigned u32x4 __attribute__((ext_vector_type(4)));
typedef unsigned u32x2 __attribute__((ext_vector_type(2)));

constexpr int BATCH = 2, SEQ = 8192, TOK = BATCH * SEQ, DM = 1024, DFF = 2816, NLAYER = 2, INW = 12288;
constexpr float NORM_EPS = 1e-6f;

__device__ __forceinline__ unsigned f2bf(float f) { unsigned u = __builtin_bit_cast(unsigned, f); return (u + 0x7fffu + ((u >> 16) & 1u)) >> 16; }
__device__ __forceinline__ float bf2f(unsigned b) { return __builtin_bit_cast(float, b << 16); }
__device__ __forceinline__ unsigned pk2(float lo, float hi) { return f2bf(lo) | (f2bf(hi) << 16); }
__device__ __forceinline__ float bflo(unsigned w) { return __builtin_bit_cast(float, w << 16); }
__device__ __forceinline__ float bfhi(unsigned w) { return __builtin_bit_cast(float, w & 0xffff0000u); }
__device__ __forceinline__ float sigm(float x) { return 1.f / (1.f + __expf(-x)); }
__device__ __forceinline__ float siluf(float x) { return x / (1.f + __expf(-x)); }
__device__ __forceinline__ float gelu_tanh(float x) { const float y = 0.7978845608028654f * (x + 0.044715f * x * x * x); const float t = 1.f - 2.f / (1.f + __expf(2.f * y)); return 0.5f * x * (1.f + t); }
__device__ __forceinline__ float wave_sum(float v) {
#pragma unroll
    for (int o = 1; o < 64; o <<= 1) v += __shfl_xor(v, o);
    return v;
}
#define LDS_WAIT() asm volatile("s_waitcnt lgkmcnt(0)" ::: "memory")

namespace pg8 {
#define PG8_LAS __attribute__((address_space(3)))
constexpr int BM = 256, BK = 64, HALF = 128, HTB = HALF * BK * 2  , STAGE_BYTES = 8 * HTB, NXCD = 8, WGM = 8;

__host__ __device__ __forceinline__ int lds_byte(int r, int c) { const int st = (r >> 4) * 2 + (c >> 5), rr = r & 15, cc = c & 31, ob = rr * 64 + cc * 2; return st * 1024 + (ob ^ (((ob >> 9) & 1) << 5)); }
__host__ __device__ __forceinline__ void stage_rc(int b, int& R, int& C) { const int st = b / 1024, sb = b % 1024, swz = sb ^ (((sb >> 9) & 1) << 5); R = (st >> 1) * 16 + swz / 64; C = (st & 1) * 32 + (swz % 64) / 2; }
__host__ __device__ __forceinline__ int perm32(int rho) { const int n = rho >> 4, i = rho & 15; return 8 * (i >> 2) + 4 * n + (i & 3); }

struct Unit { int pm, pn, grp; size_t aoff, boff; };
struct Gemm { const bf16_t* A; const bf16_t* Bt; int lda, ldb, K; };

struct StaticOrder {
    int nM, nN, nwg, G, c, lda, ldb;
    __device__ __forceinline__ void init(int M, int N, int G_, int c_, int lda_, int ldb_) { nM = M / BM; nN = N / BM; nwg = nM * nN; G = G_; c = c_; lda = lda_; ldb = ldb_; }
    __device__ __forceinline__ bool next(int i, Unit& u) const {
        const long L = (long)i * G + c; if (L >= nwg) return false;
        int wgid = (int)L; { const int q = nwg / NXCD, r = nwg % NXCD, xcd = wgid % NXCD, off = wgid / NXCD; wgid = (xcd < r ? xcd * (q + 1) : r * (q + 1) + (xcd - r) * q) + off; }
        const int nig = WGM * nN, gid = wgid / nig, fm = gid * WGM, gsz = (nM - fm) < WGM ? (nM - fm) : WGM;
        u.pm = fm + ((wgid % nig) % gsz); u.pn = (wgid % nig) / gsz; u.grp = 0;
        u.aoff = (size_t)u.pm * 256 * lda * 2; u.boff = (size_t)u.pn * 256 * ldb * 2; return true;
    }
    __device__ __forceinline__ void a_ready(const Unit&) const {}
    __device__ __forceinline__ void done(const Unit&) const {}
};
struct BranchOrder {
    StaticOrder so;
    __device__ __forceinline__ void init(int G_, int c_) { so.init(TOK, 1024, G_, c_, 512, 512); }
    __device__ __forceinline__ bool next(int i, Unit& u) const {
        const long L = (long)i * so.G + so.c; if (L >= 1024) return false;
        const int k = (int)(L >> 8); StaticOrder s2 = so; s2.G = 256; s2.c = (int)(L & 255);
        if (!s2.next(0, u)) return false;
        u.grp = k; u.aoff += (size_t)k * TOK * 512 * 2; u.boff += (size_t)k * 1024 * 512 * 2; return true;
    }
    __device__ __forceinline__ void a_ready(const Unit&) const {}
    __device__ __forceinline__ void done(const Unit&) const {}
};
struct S5eOrder {
    int G, c;
    __device__ __forceinline__ bool next(int i, Unit& u) const {
        const long L = (long)i * G + c; if (L >= 64) return false;
        const int g = (int)L >> 1, pm = (int)L & 1; u.pm = pm; u.pn = 0; u.grp = g;
        u.aoff = ((size_t)(g * 512 + pm * 256) * 640 + 128) * 2; u.boff = (size_t)g * 256 * 512 * 2; return true;
    }
    __device__ __forceinline__ void a_ready(const Unit&) const {}
    __device__ __forceinline__ void done(const Unit&) const {}
};
struct S5mOrder {
    int G, c;
    __device__ __forceinline__ bool next(int i, Unit& u) const {
        const long L = (long)i * G + c; if (L >= 128) return false;
        const int g = (int)L >> 2, pm = ((int)L >> 1) & 1, pn = (int)L & 1; u.pm = pm; u.pn = pn; u.grp = g;
        u.aoff = (size_t)(g * 512 + pm * 256) * 640 * 2; u.boff = (size_t)(g * 512 + pn * 256) * 640 * 2; return true;
    }
    __device__ __forceinline__ void a_ready(const Unit&) const {}
    __device__ __forceinline__ void done(const Unit&) const {}
};

__device__ __forceinline__ unsigned cvt_pk_bf16(float lo, float hi) { unsigned r; asm volatile("v_cvt_pk_bf16_f32 %0, %1, %2" : "=v"(r) : "v"(lo), "v"(hi)); return r; }
__device__ __forceinline__ u32x4 pack8(const f32x4& v0, const f32x4& v1) { u32x4 w; w.x = cvt_pk_bf16(v0[0], v0[1]); w.y = cvt_pk_bf16(v0[2], v0[3]); w.z = cvt_pk_bf16(v1[0], v1[1]); w.w = cvt_pk_bf16(v1[2], v1[3]); return w; }

template <int MODE> struct EpiGated {
    static constexpr bool PERM = true, AFTER_DRAIN = false;
    bf16_t* O; int ldo;
    __device__ __forceinline__ void operator()(const f32x4 (&acc)[2][2][4][2], const Unit& u, int wr, int wc, int fr, int fq) const {
        const int row0 = u.pm * BM + wr * 64 + fr, col0 = u.pn * 128 + wc * 32 + 8 * fq;
#pragma unroll
        for (int ai = 0; ai < 2; ++ai)
#pragma unroll
            for (int m = 0; m < 4; ++m) { bf16_t* rowp = O + (size_t)(row0 + ai * HALF + m * 16) * ldo + col0;
                f32x4 v[2];
#pragma unroll
                for (int n = 0; n < 2; ++n)
#pragma unroll
                    for (int j = 0; j < 4; ++j) { const float a = acc[ai][0][m][n][j], b = acc[ai][1][m][n][j]; v[n][j] = (MODE == 0) ? siluf(a) * b : a * sigm(b); }
                *(u32x4*)rowp = pack8(v[0], v[1]); asm volatile("" ::: "memory"); }
    }
};
struct EpiResid {
    static constexpr bool PERM = false, AFTER_DRAIN = false;
    const float* base; float* out; float scale;
    __device__ __forceinline__ void operator()(const f32x4 (&acc)[2][2][4][2], const Unit& u, int wr, int wc, int fr, int fq) const {
        const int row0 = u.pm * BM + wr * 64 + fr, col0 = u.pn * BM + wc * 32 + 4 * fq;
#pragma unroll
        for (int ai = 0; ai < 2; ++ai)
#pragma unroll
            for (int m = 0; m < 4; ++m) { const size_t off = (size_t)(row0 + ai * HALF + m * 16) * DM + col0;
#pragma unroll
                for (int bj = 0; bj < 2; ++bj)
#pragma unroll
                    for (int n = 0; n < 2; ++n) { const size_t o = off + bj * HALF + n * 16; const f32x4 b = *(const f32x4*)(base + o); *(f32x4*)(out + o) = b + scale * acc[ai][bj][m][n]; }
                asm volatile("" ::: "memory"); }
    }
};
struct EpiC1 {
    static constexpr bool PERM = true, AFTER_DRAIN = false;
    bf16_t* hq; bf16_t* s5A; bf16_t* convin;
    __device__ __forceinline__ void operator()(const f32x4 (&acc)[2][2][4][2], const Unit& u, int wr, int wc, int fr, int fq) const {
        const int pn = u.pn, rowb = u.pm * BM + wr * 64 + fr, cl = wc * 32 + 8 * fq;
        bf16_t* p0; int sAI, sM1, sM0, sBJ;
        if (pn < 8) { p0 = hq + (size_t)(pn >> 1) * TOK * 512 + (size_t)rowb * 512 + (pn & 1) * 256 + cl; sAI = 128 * 512; sM1 = 32 * 512; sM0 = 16 * 512; sBJ = 128; }
        else if (pn < 10) { const int c5 = (pn - 8) * 256 + cl, g = c5 >> 4, ch = c5 & 15;
            p0 = s5A + ((size_t)(g * 512 + u.pm * 8 + 2 * wr) * 640 + 128 + fr * 16 + ch); sAI = 4 * 640; sM1 = 640; sM0 = 256; sBJ = 8 * 512 * 640; }
        else { p0 = convin + (size_t)rowb * 1024 + (pn - 10) * 256 + cl; sAI = 128 * 1024; sM1 = 32 * 1024; sM0 = 16 * 1024; sBJ = 128; }
#pragma unroll
        for (int ai = 0; ai < 2; ++ai)
#pragma unroll
            for (int m = 0; m < 4; ++m) {
#pragma unroll
                for (int bj = 0; bj < 2; ++bj)
                    *(u32x4*)(p0 + (size_t)(ai * sAI + (m >> 1) * sM1 + (m & 1) * sM0 + bj * sBJ)) = pack8(acc[ai][bj][m][0], acc[ai][bj][m][1]);
                asm volatile("" ::: "memory"); }
    }
};
struct EpiC2 {
    static constexpr bool PERM = true, AFTER_DRAIN = false;
    bf16_t* qkv;
    __device__ __forceinline__ void operator()(const f32x4 (&acc)[2][2][4][2], const Unit& u, int wr, int wc, int fr, int fq) const {
        const int which = u.pn / 6, hp = u.pn % 6, rowt = u.pm * BM, b = rowt >> 13, t0 = (rowt & 8191) + wr * 64 + fr;
        bf16_t* p0 = qkv + ((size_t)(which * 24 + b * 12 + 2 * hp) * SEQ + t0) * 128 + wc * 32 + 8 * fq;
#pragma unroll
        for (int ai = 0; ai < 2; ++ai)
#pragma unroll
            for (int m = 0; m < 4; ++m) {
#pragma unroll
                for (int bj = 0; bj < 2; ++bj)
                    *(u32x4*)(p0 + (size_t)bj * SEQ * 128 + (size_t)(ai * HALF + m * 16) * 128) = pack8(acc[ai][bj][m][0], acc[ai][bj][m][1]);
                asm volatile("" ::: "memory"); }
    }
};
struct EpiS5e {
    static constexpr bool PERM = false, AFTER_DRAIN = false;
    float* E;
    __device__ __forceinline__ void operator()(const f32x4 (&acc)[2][2][4][2], const Unit& u, int wr, int wc, int fr, int fq) const {
        const int row0 = u.pm * BM + wr * 64 + fr, col0 = wc * 32 + 4 * fq;
#pragma unroll
        for (int ai = 0; ai < 2; ++ai)
#pragma unroll
            for (int m = 0; m < 4; ++m) { float* rowp = E + (size_t)(u.grp * 512 + row0 + ai * HALF + m * 16) * 128 + col0;
#pragma unroll
                for (int n = 0; n < 2; ++n) *(f32x4*)(rowp + n * 16) = acc[ai][0][m][n]; }
    }
};
struct EpiS5m {
    static constexpr bool PERM = true, AFTER_DRAIN = false;
    const bf16_t* s5A; const float* dskip; bf16_t* Z;
    __device__ __forceinline__ void operator()(const f32x4 (&acc)[2][2][4][2], const Unit& u, int wr, int wc, int fr, int fq) const {
        const int g = u.grp, chunk0 = u.pm * BM + wr * 64 + fr, c0 = 8 * (fq & 1), t0 = u.pn * 16 + 2 * wc + (fq >> 1);
        const f32x4 d0 = *(const f32x4*)(dskip + g * 16 + c0), d1 = *(const f32x4*)(dskip + g * 16 + c0 + 4);
        const bf16_t* up = s5A + (size_t)(g * 512 + chunk0) * 640 + 128 + t0 * 16 + c0;
        bf16_t* zp = Z + (size_t)(chunk0 * 32 + t0) * 512 + g * 16 + c0;
#pragma unroll
        for (int ai = 0; ai < 2; ++ai)
#pragma unroll
            for (int m = 0; m < 4; ++m) {
#pragma unroll
                for (int bj = 0; bj < 2; ++bj) {
                    const u32x4 uu = *(const u32x4*)(up + (size_t)(ai * HALF + m * 16) * 640 + bj * 128);
                    f32x4 v0 = acc[ai][bj][m][0], v1 = acc[ai][bj][m][1];
                    v0[0] += d0[0] * bflo(uu.x); v0[1] += d0[1] * bfhi(uu.x); v0[2] += d0[2] * bflo(uu.y); v0[3] += d0[3] * bfhi(uu.y);
                    v1[0] += d1[0] * bflo(uu.z); v1[1] += d1[1] * bfhi(uu.z); v1[2] += d1[2] * bflo(uu.w); v1[3] += d1[3] * bfhi(uu.w);
#pragma unroll
                    for (int j = 0; j < 4; ++j) { v0[j] = gelu_tanh(v0[j]); v1[j] = gelu_tanh(v1[j]); }
                    *(u32x4*)(zp + (size_t)(ai * HALF + m * 16) * 32 * 512 + bj * 8 * 512) = pack8(v0, v1); }
                asm volatile("" ::: "memory"); }
    }
};
struct EpiBranch {
    static constexpr bool PERM = true, AFTER_DRAIN = false;
    bf16_t* Ball;
    __device__ __forceinline__ void operator()(const f32x4 (&acc)[2][2][4][2], const Unit& u, int wr, int wc, int fr, int fq) const {
        const int row0 = u.pm * BM + wr * 64 + fr, col0 = u.grp * 1024 + u.pn * BM + wc * 32 + 8 * fq;
#pragma unroll
        for (int ai = 0; ai < 2; ++ai)
#pragma unroll
            for (int m = 0; m < 4; ++m) { bf16_t* rowp = Ball + (size_t)(row0 + ai * HALF + m * 16) * 4096 + col0;
#pragma unroll
                for (int bj = 0; bj < 2; ++bj) *(u32x4*)(rowp + bj * HALF) = pack8(acc[ai][bj][m][0], acc[ai][bj][m][1]); }
    }
};
struct EpiGateMerge {
    static constexpr bool PERM = false, AFTER_DRAIN = false;
    const bf16_t* Ball; bf16_t* merged;
    __device__ __forceinline__ void operator()(const f32x4 (&acc)[2][2][4][2], const Unit& u, int wr, int wc, int fr, int fq) const {
        const int row0 = u.pm * BM + wr * 64 + fr, mc = u.pn * 64 + wc * 16 + 4 * fq;
#pragma unroll
        for (int ai = 0; ai < 2; ++ai)
#pragma unroll
            for (int m = 0; m < 4; ++m) { const int row = row0 + ai * HALF + m * 16; const bf16_t* bp = Ball + (size_t)row * 4096 + mc;
                f32x4 s = {0.f, 0.f, 0.f, 0.f};
#pragma unroll
                for (int bj = 0; bj < 2; ++bj)
#pragma unroll
                    for (int n = 0; n < 2; ++n) { const u32x2 bv = *(const u32x2*)(bp + (2 * bj + n) * 1024); const f32x4 gt = acc[ai][bj][m][n];
                        s[0] += sigm(gt[0]) * bflo(bv.x); s[1] += sigm(gt[1]) * bfhi(bv.x); s[2] += sigm(gt[2]) * bflo(bv.y); s[3] += sigm(gt[3]) * bfhi(bv.y); }
                u32x2 w; w.x = cvt_pk_bf16(s[0], s[1]); w.y = cvt_pk_bf16(s[2], s[3]);
                *(u32x2*)(merged + (size_t)row * DM + mc) = w; }
    }
};

template <class Epi, class Sched, bool ALIGN_EPI = false, bool SP2 = false>
__device__ __forceinline__ void gemm_phase(PG8_LAS unsigned char* lds, const Gemm g, const Sched& S, const Epi& E, int tid_opaque) {
    const int tid = tid_opaque, wid = __builtin_amdgcn_readfirstlane(tid >> 6), lane = tid & 63, wr = wid >> 2, wc = wid & 3, fr = lane & 15, fq = lane >> 4;
    const int K = g.K, nt = K / BK, lda = g.lda, ldb = g.ldb;
    unsigned voffA[2], voffB[2];
#pragma unroll
    for (int i = 0; i < 2; ++i) { int R, C; stage_rc(tid * 16 + i * 8192, R, C); const int Rb = Epi::PERM ? ((R & ~31) + perm32(R & 31)) : R;
        voffA[i] = (unsigned)(R * lda + C) * 2u; voffB[i] = (unsigned)(Rb * ldb + C) * 2u; }
    const size_t kstep = (size_t)(BK * 2);
    const size_t hstepA = (size_t)HALF * lda * 2, hstepB = (size_t)HALF * ldb * 2;

    const unsigned ldsw = (unsigned)wid * 1024u;
    const int aoff = lds_byte(wr * 64 + fr, fq * 8), boff = lds_byte(wc * 32 + fr, fq * 8);
#define PG8_SA(b, h) (((b) * 2 + (h)) * HTB)
#define PG8_SB(b, h) ((4 + (b) * 2 + (h)) * HTB)
#define PG8_STAGE(bufoff, gbase, voff) do { _Pragma("unroll") for (int _i = 0; _i < 2; ++_i) \
        __builtin_amdgcn_global_load_lds((const unsigned*)((const char*)(gbase) + (voff)[_i]), (PG8_LAS unsigned*)(lds + (bufoff) + ldsw + _i * 8192), 16, 0, 0); } while (0)
#define PG8_LDA(dst, b, h) do { _Pragma("unroll") for (int m = 0; m < 4; ++m) _Pragma("unroll") for (int k = 0; k < 2; ++k) dst[m][k] = *(const PG8_LAS bf16x8*)(lds + PG8_SA(b, h) + aoff + m * 2048 + k * 1024); } while (0)
#define PG8_LDB(dst, b, h) do { _Pragma("unroll") for (int n = 0; n < 2; ++n) _Pragma("unroll") for (int k = 0; k < 2; ++k) dst[n][k] = *(const PG8_LAS bf16x8*)(lds + PG8_SB(b, h) + boff + n * 2048 + k * 1024); } while (0)
#define PG8_MMA(ai, bj, At, Bt) do { __builtin_amdgcn_s_setprio(1); _Pragma("unroll") for (int m = 0; m < 4; ++m) _Pragma("unroll") for (int n = 0; n < 2; ++n) _Pragma("unroll") for (int k = 0; k < 2; ++k) \
        acc[ai][bj][m][n] = __builtin_amdgcn_mfma_f32_16x16x32_bf16(Bt[n][k], At[m][k], acc[ai][bj][m][n], 0, 0, 0); __builtin_amdgcn_s_setprio(0); } while (0)
#define PG8_WAIT_V(n) asm volatile("s_waitcnt vmcnt(" #n ")" ::: "memory")
#define PG8_WAIT_L(n) asm volatile("s_waitcnt lgkmcnt(" #n ")" ::: "memory")
#define PG8_BAR __builtin_amdgcn_s_barrier()
#define PG8_SCHED __builtin_amdgcn_sched_barrier(0)
    Unit cur, nxt; int ui = 0;
    if (!S.next(0, cur)) return;
    f32x4 acc[2][2][4][2];
#pragma unroll
    for (int a = 0; a < 2; ++a)
#pragma unroll
        for (int b = 0; b < 2; ++b)
#pragma unroll
            for (int m = 0; m < 4; ++m)
#pragma unroll
                for (int n = 0; n < 2; ++n) acc[a][b][m][n] = (f32x4){0.f, 0.f, 0.f, 0.f};
    bf16x8 At[4][2], B0[2][2], B1[2][2];
    const char* cA = (const char*)g.A + cur.aoff; const char* cB = (const char*)g.Bt + cur.boff;
    S.a_ready(cur);
    if constexpr (SP2) {
        PG8_STAGE(PG8_SB(0, 0), cB, voffB); PG8_STAGE(PG8_SB(0, 1), cB + hstepB, voffB); PG8_STAGE(PG8_SA(0, 0), cA, voffA); PG8_STAGE(PG8_SA(0, 1), cA + hstepA, voffA);
        if (wr == 1) PG8_BAR;
        PG8_WAIT_V(2); PG8_BAR;
        PG8_STAGE(PG8_SB(1, 0), cB + kstep, voffB); PG8_STAGE(PG8_SA(1, 0), cA + kstep, voffA); PG8_STAGE(PG8_SB(1, 1), cB + hstepB + kstep, voffB);
        PG8_WAIT_V(6); PG8_BAR;
    } else {
        PG8_STAGE(PG8_SB(0, 0), cB, voffB); PG8_STAGE(PG8_SA(0, 0), cA, voffA); PG8_STAGE(PG8_SB(0, 1), cB + hstepB, voffB); PG8_STAGE(PG8_SA(0, 1), cA + hstepA, voffA);
        if (wr == 1) PG8_BAR;
        PG8_WAIT_V(4); PG8_BAR;
        PG8_STAGE(PG8_SB(1, 0), cB + kstep, voffB); PG8_STAGE(PG8_SA(1, 0), cA + kstep, voffA); PG8_STAGE(PG8_SB(1, 1), cB + hstepB + kstep, voffB);
        PG8_WAIT_V(6); PG8_BAR;
    }
    for (;;) {
        const bool has_next = S.next(ui + 1, nxt);
        const char* nA = has_next ? (const char*)g.A + nxt.aoff : cA; const char* nB = has_next ? (const char*)g.Bt + nxt.boff : cB;
        for (int t = 0; t < nt; t += 2) {
            const bool last = (t == nt - 2);
            const char* a1 = cA + (size_t)(t + 1) * kstep;
            const char* a2 = last ? nA : cA + (size_t)(t + 2) * kstep; const char* b2 = last ? nB : cB + (size_t)(t + 2) * kstep;
            const char* a3 = a2 + kstep; const char* b3 = b2 + kstep;
            if (last && has_next) S.a_ready(nxt);
            if constexpr (SP2) {
            PG8_LDB(B0, 0, 0); PG8_LDB(B1, 0, 1); PG8_SCHED; PG8_LDA(At, 0, 0); PG8_STAGE(PG8_SA(1, 1), a1 + hstepA, voffA);
            PG8_WAIT_V(8); PG8_WAIT_L(0); PG8_BAR; PG8_MMA(0, 0, At, B0); PG8_MMA(0, 1, At, B1); PG8_BAR; PG8_SCHED;
            PG8_LDA(At, 0, 1); PG8_STAGE(PG8_SB(0, 0), b2, voffB); PG8_STAGE(PG8_SB(0, 1), b2 + hstepB, voffB); PG8_STAGE(PG8_SA(0, 0), a2, voffA);
            PG8_WAIT_V(8); PG8_WAIT_L(0); PG8_BAR; PG8_MMA(1, 0, At, B0); PG8_MMA(1, 1, At, B1); PG8_BAR; PG8_SCHED;
            PG8_LDB(B0, 1, 0); PG8_LDB(B1, 1, 1); PG8_SCHED; PG8_LDA(At, 1, 0); PG8_STAGE(PG8_SA(0, 1), a2 + hstepA, voffA);
            PG8_WAIT_V(8); PG8_WAIT_L(0); PG8_BAR; PG8_MMA(0, 0, At, B0); PG8_MMA(0, 1, At, B1); PG8_BAR; PG8_SCHED;
            PG8_LDA(At, 1, 1); PG8_STAGE(PG8_SB(1, 0), b3, voffB); PG8_STAGE(PG8_SB(1, 1), b3 + hstepB, voffB); PG8_STAGE(PG8_SA(1, 0), a3, voffA);
            PG8_WAIT_V(8); PG8_WAIT_L(0); PG8_BAR; PG8_MMA(1, 0, At, B0); PG8_MMA(1, 1, At, B1); PG8_BAR; PG8_SCHED;
            } else {
            PG8_LDB(B0, 0, 0); PG8_SCHED; PG8_LDA(At, 0, 0); PG8_STAGE(PG8_SA(1, 1), a1 + hstepA, voffA);
            PG8_WAIT_L(8); PG8_BAR; PG8_WAIT_L(0); PG8_MMA(0, 0, At, B0); PG8_BAR; PG8_SCHED;
            PG8_LDB(B1, 0, 1); PG8_STAGE(PG8_SB(0, 0), b2, voffB);
            PG8_BAR; PG8_WAIT_L(0); PG8_MMA(0, 1, At, B1); PG8_BAR;
            PG8_LDA(At, 0, 1); PG8_STAGE(PG8_SA(0, 0), a2, voffA);
            PG8_BAR; PG8_WAIT_L(0); PG8_MMA(1, 0, At, B0); PG8_BAR; PG8_SCHED;
            PG8_STAGE(PG8_SB(0, 1), b2 + hstepB, voffB);
            PG8_WAIT_V(6); PG8_BAR; PG8_MMA(1, 1, At, B1); PG8_BAR;
            PG8_LDB(B0, 1, 0); PG8_SCHED; PG8_LDA(At, 1, 0); PG8_STAGE(PG8_SA(0, 1), a2 + hstepA, voffA);
            PG8_WAIT_L(8); PG8_BAR; PG8_WAIT_L(0); PG8_MMA(0, 0, At, B0); PG8_BAR; PG8_SCHED;
            PG8_LDB(B1, 1, 1); PG8_STAGE(PG8_SB(1, 0), b3, voffB);
            PG8_BAR; PG8_WAIT_L(0); PG8_MMA(0, 1, At, B1); PG8_BAR;
            PG8_LDA(At, 1, 1); PG8_STAGE(PG8_SA(1, 0), a3, voffA);
            PG8_BAR; PG8_WAIT_L(0); PG8_MMA(1, 0, At, B0); PG8_BAR; PG8_SCHED;
            PG8_STAGE(PG8_SB(1, 1), b3 + hstepB, voffB);
            PG8_WAIT_V(6); PG8_BAR; PG8_MMA(1, 1, At, B1); PG8_BAR;
            }
        }
        if constexpr (ALIGN_EPI) { if (wr == 0) PG8_BAR; }
        if constexpr (!Epi::AFTER_DRAIN) { int fr_ = fr, fq_ = fq; asm volatile("" : "+v"(fr_), "+v"(fq_)); E(acc, cur, wr, wc, fr_, fq_); S.done(cur); }
        if (!has_next) break;
#pragma unroll
        for (int a = 0; a < 2; ++a)
#pragma unroll
            for (int b = 0; b < 2; ++b)
#pragma unroll
                for (int m = 0; m < 4; ++m)
#pragma unroll
                    for (int n = 0; n < 2; ++n) acc[a][b][m][n] = (f32x4){0.f, 0.f, 0.f, 0.f};
        cur = nxt; cA = nA; cB = nB; ++ui;
        if constexpr (ALIGN_EPI) { if (wr == 1) PG8_BAR; }
    }
    PG8_WAIT_V(0);
    if constexpr (!ALIGN_EPI) { if (wr == 0) PG8_BAR; }
    PG8_BAR;
    if constexpr (Epi::AFTER_DRAIN) { E.fused(acc, cur, wr, wc, fr, fq, lds, wid, lane); S.done(cur); }
#undef PG8_SA
#undef PG8_SB
#undef PG8_STAGE
#undef PG8_LDA
#undef PG8_LDB
#undef PG8_MMA
#undef PG8_WAIT_V
#undef PG8_WAIT_L
#undef PG8_BAR
#undef PG8_SCHED
}

}

constexpr size_t MiB = 1u << 20;
constexpr size_t WS_CTL = 0;
constexpr size_t WS_ROPE = 1 * MiB;
constexpr size_t WS_LSE = 3 * MiB;
constexpr size_t WS_HGD = 4 * MiB;
constexpr size_t WS_A32 = WS_HGD + 768 * 1024;
constexpr size_t WS_S5E = 5 * MiB;
constexpr size_t WS_W = 13 * MiB;
constexpr size_t W_GU1 = WS_W, W_D1 = W_GU1 + 11 * MiB, W_GU2 = W_D1 + 11 * MiB / 2, W_D2 = W_GU2 + 11 * MiB;
constexpr size_t W_C1 = WS_W + 33 * MiB, W_C2 = W_C1 + 7 * MiB, W_GATE = W_C2 + 9 * MiB, W_BR = W_GATE + 8 * MiB, W_OUT = W_BR + 4 * MiB, W_GLU = W_OUT + 2 * MiB;
constexpr size_t W_S5M = W_GLU + 1 * MiB, W_S5E = W_S5M + 20 * MiB;
constexpr size_t WS_XN = 105 * MiB;
constexpr size_t WS_Y = 137 * MiB;
constexpr size_t WS_MERGED = 201 * MiB;
constexpr size_t WS_R = 233 * MiB;
constexpr size_t R_HQ = WS_R, R_S5A = WS_R + 64 * MiB, R_CONV = WS_R + 84 * MiB, R_HST = WS_R + 116 * MiB;
constexpr size_t R_QKV = WS_R, R_HBUF = WS_R, R_BALL = WS_R;
constexpr size_t WS_END = 381 * MiB;
static_assert(W_S5E + 8 * MiB <= WS_XN && W_D2 + 11 * MiB / 2 <= W_C1, "weight map");
constexpr size_t QKV_WHICH = (size_t)24 * SEQ * 128;

constexpr int LDS_BYTES = 151552;
constexpr int NWAVES = 8, NTHREADS = 512;

struct Args { const float* in[30]; float* out; unsigned char* ws; int ph_lo, ph_hi; };

struct Ctx {
    LAS unsigned char* lds; int tid, lane, wave, G, bid, zo;
    const float* const* in; float* out; unsigned char* ws;
};
#define INP(c, k) ((c).in[(k) + (c).zo])

template <int MT, int NT, int KT>
__device__ __forceinline__ void wave_mma(f32x4 (&acc)[MT][NT], const LAS bf16_t* A, int lda, const LAS bf16_t* Bt, int ldb, int lane) {
    const int r = lane & 15, q = lane >> 4;
#pragma unroll
    for (int kk = 0; kk < KT; ++kk) {
        bf16x8 a[MT], b[NT];
#pragma unroll
        for (int mt = 0; mt < MT; ++mt) a[mt] = *(const LAS bf16x8*)(A + (mt * 16 + r) * lda + kk * 32 + q * 8);
#pragma unroll
        for (int nt = 0; nt < NT; ++nt) b[nt] = *(const LAS bf16x8*)(Bt + (nt * 16 + r) * ldb + kk * 32 + q * 8);
#pragma unroll
        for (int mt = 0; mt < MT; ++mt)
#pragma unroll
            for (int nt = 0; nt < NT; ++nt) acc[mt][nt] = __builtin_amdgcn_mfma_f32_16x16x32_bf16(a[mt], b[nt], acc[mt][nt], 0, 0, 0);
    }
}

__device__ __forceinline__ int rowmap(int kind, int n) {
    if (kind == 0) return n;
    if (kind == 1) return 256 * (n >> 7) + (n & 127);
    if (kind == 2) return 256 * (n >> 7) + 128 + (n & 127);
    const int k = n >> 10, mcol = n & 1023, pn = mcol >> 6, ml = mcol & 63, wc = ml >> 4, fq = (ml & 15) >> 2, i = ml & 3;
    return pn * 256 + 128 * (k >> 1) + 32 * wc + 16 * (k & 1) + 4 * fq + i;
}
__device__ __forceinline__ void transpose_item(const float* W, int ldw, int col0, int K, int Ncols, bf16_t* dst, const float* gain, int kind, LAS float* scr, int item, int lane) {
    const int nblk = Ncols / 32, kb = item / nblk, nb = item % nblk, k0 = 64 * kb, n0 = 32 * nb;
#pragma unroll 8
    for (int i = 0; i < 32; ++i) { const int kk = 2 * i + (lane >> 5); float v = W[(size_t)(k0 + kk) * ldw + col0 + n0 + (lane & 31)]; if (gain) v *= gain[k0 + kk]; scr[kk * 33 + (lane & 31)] = v; }
    LDS_WAIT(); asm volatile("" ::: "memory");
    const int c = lane & 7;
#pragma unroll
    for (int j = 0; j < 4; ++j) { const int n = (lane >> 3) + 8 * j; const LAS float* s = scr + (8 * c) * 33 + n;
        u32x4 o; o.x = pk2(s[0 * 33], s[1 * 33]); o.y = pk2(s[2 * 33], s[3 * 33]); o.z = pk2(s[4 * 33], s[5 * 33]); o.w = pk2(s[6 * 33], s[7 * 33]);
        *(u32x4*)(dst + (size_t)rowmap(kind, n0 + n) * K + k0 + 8 * c) = o; }
    LDS_WAIT(); asm volatile("" ::: "memory");
}

__device__ __forceinline__ void s5_tables(const Ctx& c, int l, int g) {
    LAS float* pwr = (LAS float*)c.lds; LAS float* pwi = pwr + 2112; LAS float* bbr = pwi + 2112; LAS float* bbi = bbr + 1024;
    LAS float* cr = bbi + 1024; LAS float* ci = cr + 1024; LAS float* Kj = ci + 1024;
    const int lg = l * 32 + g, tid = c.tid;
    const float* a_re = INP(c, 10) + lg * 64; const float* a_im = INP(c, 11) + lg * 64; const float* log_dt = INP(c, 12) + lg;
    const float* b_re = INP(c, 13) + (size_t)lg * 1024; const float* b_im = INP(c, 14) + (size_t)lg * 1024;
    const float* c_re = INP(c, 15) + (size_t)lg * 1024; const float* c_im = INP(c, 16) + (size_t)lg * 1024;
    if (tid < 64) {
        const int p = tid; const float dtf = expf(log_dt[0]), arf = a_re[p], aif = a_im[p], magf = expf(arf * dtf);
        const double ar = arf, ai = aif, abr = (double)(magf * cosf(aif * dtf)), abi = (double)(magf * sinf(aif * dtf)), den = ar * ar + ai * ai;
        const double zr = ((abr - 1.0) * ar + abi * ai) / den, zi = (abi * ar - (abr - 1.0) * ai) / den;
        double pr = 1.0, pi = 0.0;
        for (int j = 0; j <= 32; ++j) { pwr[p * 33 + j] = (float)pr; pwi[p * 33 + j] = (float)pi; const double nr = pr * abr - pi * abi, ni = pr * abi + pi * abr; pr = nr; pi = ni; }
        float* a32 = (float*)(c.ws + WS_A32) + (g * 64 + p) * 2; a32[0] = pwr[p * 33 + 32]; a32[1] = pwi[p * 33 + 32];
        for (int k = 0; k < 16; ++k) { const double br = b_re[p * 16 + k], bi = b_im[p * 16 + k]; bbr[p * 16 + k] = (float)(zr * br - zi * bi); bbi[p * 16 + k] = (float)(zr * bi + zi * br); }
    }
    for (int i = tid; i < 1024; i += NTHREADS) { cr[i] = c_re[i]; ci[i] = c_im[i]; }
    __syncthreads();
    for (int e = tid; e < 8192; e += NTHREADS) { const int j = e >> 8, cc = (e >> 4) & 15, c2 = e & 15; float s = 0.f;
        for (int p = 0; p < 64; ++p) { const float ar = pwr[p * 33 + j], ai = pwi[p * 33 + j], br = bbr[p * 16 + c2], bi = bbi[p * 16 + c2];
            const float xr = ar * br - ai * bi, xi = ar * bi + ai * br; s += cr[cc * 64 + p] * xr - ci[cc * 64 + p] * xi; }
        Kj[e] = s; }
    __syncthreads();
    bf16_t* dm = (bf16_t*)(c.ws + W_S5M) + (size_t)g * 512 * 640;
    for (int ch = tid; ch < 512 * 80; ch += NTHREADS) { const int row = ch / 80, cch = ch % 80, t = row >> 4, cc = row & 15, col0 = cch * 8; float v[8];
        if (col0 < 64) {
#pragma unroll
            for (int e = 0; e < 8; ++e) { const int p = col0 + e; v[e] = cr[cc * 64 + p] * pwr[p * 33 + t + 1] - ci[cc * 64 + p] * pwi[p * 33 + t + 1]; }
        } else if (col0 < 128) {
#pragma unroll
            for (int e = 0; e < 8; ++e) { const int p = col0 - 64 + e; v[e] = -(cr[cc * 64 + p] * pwi[p * 33 + t + 1] + ci[cc * 64 + p] * pwr[p * 33 + t + 1]); }
        } else { const int s = (col0 - 128) >> 4, cb = (col0 - 128) & 15;
#pragma unroll
            for (int e = 0; e < 8; ++e) v[e] = (s <= t) ? Kj[(t - s) * 256 + cc * 16 + cb + e] : 0.f;
        }
        u32x4 o; o.x = pk2(v[0], v[1]); o.y = pk2(v[2], v[3]); o.z = pk2(v[4], v[5]); o.w = pk2(v[6], v[7]);
        *(u32x4*)(dm + (size_t)row * 640 + col0) = o; }
    bf16_t* de = (bf16_t*)(c.ws + W_S5E) + (size_t)g * 256 * 512;
    for (int ch = tid; ch < 256 * 64; ch += NTHREADS) { const int row = ch >> 6, col0 = (ch & 63) * 8, s = col0 >> 4, cb = col0 & 15; float v[8];
#pragma unroll
        for (int e = 0; e < 8; ++e) {
            if (row < 64) { const int p = row; v[e] = pwr[p * 33 + 31 - s] * bbr[p * 16 + cb + e] - pwi[p * 33 + 31 - s] * bbi[p * 16 + cb + e]; }
            else if (row < 128) { const int p = row - 64; v[e] = pwr[p * 33 + 31 - s] * bbi[p * 16 + cb + e] + pwi[p * 33 + 31 - s] * bbr[p * 16 + cb + e]; }
            else v[e] = 0.f; }
        u32x4 o; o.x = pk2(v[0], v[1]); o.y = pk2(v[2], v[3]); o.z = pk2(v[4], v[5]); o.w = pk2(v[6], v[7]);
        *(u32x4*)(de + (size_t)row * 512 + col0) = o; }
    __syncthreads();
}

__device__ __forceinline__ void phase_wprep(const Ctx& c, int l) {
    for (int g = c.bid; g < 32; g += c.G) s5_tables(c, l, g);
    if (l == 0) {
        const int* pos = (const int*)INP(c, 1); f32x2* rope = (f32x2*)(c.ws + WS_ROPE);
        for (int e = c.bid * NTHREADS + c.tid; e < TOK * 16; e += c.G * NTHREADS) { const int tok = e >> 4, i = e & 15;
            const float ang = (float)pos[tok] * exp2f(-1.1832230355827609f * (float)i); rope[e] = (f32x2){cosf(ang), sinf(ang)}; }
    }
    __syncthreads();
    LAS float* scr = (LAS float*)(c.lds + c.wave * 16384);
    const int gw = c.bid * NWAVES + c.wave, NGW = c.G * NWAVES;
    const float* n1 = INP(c, 2) + l * DM; const float* nm = INP(c, 6) + l * DM; const float* n2 = INP(c, 25) + l * DM;
    const float* wg1 = INP(c, 3) + (size_t)l * DM * DFF; const float* wu1 = INP(c, 4) + (size_t)l * DM * DFF; const float* wd1 = INP(c, 5) + (size_t)l * DFF * DM;
    const float* wg2 = INP(c, 26) + (size_t)l * DM * DFF; const float* wu2 = INP(c, 27) + (size_t)l * DM * DFF; const float* wd2 = INP(c, 28) + (size_t)l * DFF * DM;
    const float* win = INP(c, 7) + (size_t)l * DM * INW; const float* wbr = INP(c, 23) + (size_t)l * 4 * 512 * DM; const float* wout = INP(c, 24) + (size_t)l * DM * DM;
    const float* wglu = INP(c, 18) + (size_t)l * 512 * 1024;
    unsigned char* ws = c.ws;
    for (int it = gw; it < 16384; it += NGW) {
        int r = it;
        if (r < 1408) { transpose_item(wg1, DFF, 0, DM, DFF, (bf16_t*)(ws + W_GU1), n1, 1, scr, r, c.lane); continue; } r -= 1408;
        if (r < 1408) { transpose_item(wu1, DFF, 0, DM, DFF, (bf16_t*)(ws + W_GU1), n1, 2, scr, r, c.lane); continue; } r -= 1408;
        if (r < 1408) { transpose_item(wd1, DM, 0, DFF, DM, (bf16_t*)(ws + W_D1), nullptr, 0, scr, r, c.lane); continue; } r -= 1408;
        if (r < 1408) { transpose_item(wg2, DFF, 0, DM, DFF, (bf16_t*)(ws + W_GU2), n2, 1, scr, r, c.lane); continue; } r -= 1408;
        if (r < 1408) { transpose_item(wu2, DFF, 0, DM, DFF, (bf16_t*)(ws + W_GU2), n2, 2, scr, r, c.lane); continue; } r -= 1408;
        if (r < 1408) { transpose_item(wd2, DM, 0, DFF, DM, (bf16_t*)(ws + W_D2), nullptr, 0, scr, r, c.lane); continue; } r -= 1408;
        if (r < 1792) { transpose_item(win, INW, 0, DM, 3584, (bf16_t*)(ws + W_C1), nm, 0, scr, r, c.lane); continue; } r -= 1792;
        if (r < 2304) { transpose_item(win, INW, 3584, DM, 4608, (bf16_t*)(ws + W_C2), nm, 0, scr, r, c.lane); continue; } r -= 2304;
        if (r < 2048) { transpose_item(win, INW, 8192, DM, 4096, (bf16_t*)(ws + W_GATE), nm, 3, scr, r, c.lane); continue; } r -= 2048;
        if (r < 1024) { const int k = r >> 8; transpose_item(wbr + (size_t)k * 512 * DM, DM, 0, 512, DM, (bf16_t*)(ws + W_BR) + (size_t)k * 1024 * 512, nullptr, 0, scr, r & 255, c.lane); continue; } r -= 1024;
        if (r < 512) { transpose_item(wout, DM, 0, DM, DM, (bf16_t*)(ws + W_OUT), nullptr, 0, scr, r, c.lane); continue; } r -= 512;
        if (r < 128) { transpose_item(wglu, 1024, 0, 512, 512, (bf16_t*)(ws + W_GLU), nullptr, 1, scr, r, c.lane); continue; } r -= 128;
        transpose_item(wglu, 1024, 512, 512, 512, (bf16_t*)(ws + W_GLU), nullptr, 2, scr, r, c.lane);
    }
}

__device__ __forceinline__ void phase_norm(const Ctx& c, const float* x, bf16_t* xn) {
    const int gw = c.bid * NWAVES + c.wave, NGW = c.G * NWAVES;
    for (int row = gw; row < TOK; row += NGW) {
        const f32x4* xr = (const f32x4*)(x + (size_t)row * DM) + c.lane; f32x4 v[4]; float s = 0.f;
#pragma unroll
        for (int j = 0; j < 4; ++j) { v[j] = xr[64 * j]; s += (v[j][0] * v[j][0] + v[j][1] * v[j][1]) + (v[j][2] * v[j][2] + v[j][3] * v[j][3]); }
        const float rs = 1.f / sqrtf(wave_sum(s) * (1.f / DM) + NORM_EPS);
        u32x2* o = (u32x2*)(xn + (size_t)row * DM) + c.lane;
#pragma unroll
        for (int j = 0; j < 4; ++j) { u32x2 w; w.x = pk2(v[j][0] * rs, v[j][1] * rs); w.y = pk2(v[j][2] * rs, v[j][3] * rs); o[64 * j] = w; }
    }
}
__device__ __forceinline__ void phase_final_norm(const Ctx& c, float* x, const float* gain) {
    const int gw = c.bid * NWAVES + c.wave, NGW = c.G * NWAVES;
    for (int row = gw; row < TOK; row += NGW) {
        f32x4* xr = (f32x4*)(x + (size_t)row * DM) + c.lane; f32x4 v[4]; float s = 0.f;
#pragma unroll
        for (int j = 0; j < 4; ++j) { v[j] = xr[64 * j]; s += (v[j][0] * v[j][0] + v[j][1] * v[j][1]) + (v[j][2] * v[j][2] + v[j][3] * v[j][3]); }
        const float rs = 1.f / sqrtf(wave_sum(s) * (1.f / DM) + NORM_EPS);
#pragma unroll
        for (int j = 0; j < 4; ++j) { const f32x4 gn = ((const f32x4*)gain)[c.lane + 64 * j]; xr[64 * j] = v[j] * rs * gn; }
    }
}

__device__ __forceinline__ void phase_conv(const Ctx& c, int l) {
    LAS float* z = (LAS float*)c.lds; LAS float* red = z + 62 * 512;
    const bf16_t* cin = (const bf16_t*)(c.ws + R_CONV); bf16_t* yc = (bf16_t*)(c.ws + WS_Y) + (size_t)2 * TOK * 512;
    const int ch = c.tid;
    const float* cw = INP(c, 19) + (size_t)l * 31 * 512; const float cb = INP(c, 20)[l * 512 + ch], lg = INP(c, 21)[l * 512 + ch], lb = INP(c, 22)[l * 512 + ch];
    float w[31];
#pragma unroll
    for (int j = 0; j < 31; ++j) w[j] = cw[j * 512 + ch];
    for (int unit = c.bid; unit < TOK / 32; unit += c.G) {
        const int b = unit >> 8, t0 = (unit & 255) * 32;
        for (int r = 0; r < 62; ++r) { const int t = t0 - 30 + r; float v = 0.f;
            if (t >= 0) { const bf16_t* rp = cin + (size_t)(b * SEQ + t) * 1024; v = bf2f(rp[ch]) * sigm(bf2f(rp[512 + ch])); }
            z[r * 512 + ch] = v; }
        __syncthreads();
#pragma unroll 1
        for (int blk = 0; blk < 4; ++blk) {
            float zr[38];
#pragma unroll
            for (int i = 0; i < 38; ++i) zr[i] = z[(blk * 8 + i) * 512 + ch];
            float o[8];
#pragma unroll
            for (int tt = 0; tt < 8; ++tt) { float a = cb;
#pragma unroll
                for (int j = 0; j < 31; ++j) a += w[j] * zr[tt + j];
                o[tt] = a; }
            LAS float* rb = red + (blk & 1) * 128;
#pragma unroll
            for (int tt = 0; tt < 8; ++tt) { const float s1 = wave_sum(o[tt]), s2 = wave_sum(o[tt] * o[tt]); if (c.lane == 0) { rb[c.wave * 16 + tt * 2] = s1; rb[c.wave * 16 + tt * 2 + 1] = s2; } }
            __syncthreads();
#pragma unroll
            for (int tt = 0; tt < 8; ++tt) { float s1 = 0.f, s2 = 0.f;
#pragma unroll
                for (int wv = 0; wv < 8; ++wv) { s1 += rb[wv * 16 + tt * 2]; s2 += rb[wv * 16 + tt * 2 + 1]; }
                const float mean = s1 * (1.f / 512.f), var = fmaxf(s2 * (1.f / 512.f) - mean * mean, 0.f), rstd = 1.f / sqrtf(var + NORM_EPS);
                const float y = (o[tt] - mean) * rstd * lg + lb;
                yc[(size_t)(b * SEQ + t0 + blk * 8 + tt) * 512 + ch] = (bf16_t)f2bf(siluf(y)); }
        }
        __syncthreads();
    }
}
#define XB_TMO      128
#define XB_XCNT(j)  (256  + 64 * (j))
#define XB_XSUB(j)  (1280 + 64 * (j))
#define XB_XGEN(j)  (2304 + 64 * (j))
#define XB_TOP      3328
#define XB_TOPGEN   3392
#define XCD_BAR_WORDS 3456
#define XB_SPIN_CAP (1u << 18)

__device__ __forceinline__ unsigned xb_ld(unsigned* p)              { return __hip_atomic_load(p, __ATOMIC_RELAXED, __HIP_MEMORY_SCOPE_AGENT); }
__device__ __forceinline__ unsigned xb_add(unsigned* p, unsigned v) { return __hip_atomic_fetch_add(p, v, __ATOMIC_RELAXED, __HIP_MEMORY_SCOPE_AGENT); }
__device__ __forceinline__ unsigned xb_xcc_id() { return (unsigned)__builtin_amdgcn_s_getreg((3 << 11) | 20) & 0xFu; }
#define XB_SPIN(cond, bar) do { unsigned _sp = 0; while (cond) { __builtin_amdgcn_s_sleep(1); \
    if ((++_sp & 255u) == 0u) { if (xb_ld(&(bar)[XB_TMO])) break; if (_sp > XB_SPIN_CAP) { atomicAdd(&(bar)[XB_TMO], 1u); break; } } } } while (0)

struct XcdBarrier {
    unsigned* bar; unsigned x;
    volatile LAS unsigned* st;
};

__device__ __forceinline__ XcdBarrier xcd_barrier_post(unsigned* bar, volatile LAS unsigned* st) {
    XcdBarrier b; b.bar = bar; b.x = xb_xcc_id(); b.st = st;
    if (threadIdx.x == 0) (void)xb_add(&bar[XB_XCNT(b.x)], 1u);
    return b;
}
__device__ __forceinline__ void xcd_barrier_complete(unsigned* bar, unsigned x, unsigned& nloc, unsigned& nx) {
    const unsigned G = gridDim.x * gridDim.y * gridDim.z;
    unsigned sum, cnt, mine, sp = 0u;
    for (;;) {
        sum = 0u; cnt = 0u; mine = 0u;
#pragma unroll
        for (unsigned j = 0; j < 16; ++j) { const unsigned c = xb_ld(&bar[XB_XCNT(j)]); sum += c; cnt += (c > 0u) ? 1u : 0u; mine = (j == x) ? c : mine; }
        if (sum == G) break;
        __builtin_amdgcn_s_sleep(1);
        if ((++sp & 255u) == 0u) { if (xb_ld(&bar[XB_TMO])) break; if (sp > XB_SPIN_CAP) { atomicAdd(&bar[XB_TMO], 1u); break; } }
    }
    nloc = mine > 0u ? mine : 1u; nx = cnt > 0u ? cnt : 1u;
}

__device__ __forceinline__ void xcd_barrier(const XcdBarrier& b) {
    asm volatile("s_waitcnt vmcnt(0)" ::: "memory");
    __syncthreads();
    if (threadIdx.x == 0) {
        unsigned* bar = b.bar;
        __builtin_amdgcn_s_waitcnt(0);
        unsigned nloc = b.st[0], nx = b.st[1];
        if (nloc == 0u) { xcd_barrier_complete(bar, b.x, nloc, nx); b.st[0] = nloc; b.st[1] = nx; }
        const unsigned old = xb_add(&bar[XB_XSUB(b.x)], 1u);
        const unsigned gen = old / nloc;
        if (old + 1u == (gen + 1u) * nloc) {
            __builtin_amdgcn_fence(__ATOMIC_RELEASE, "agent");
            asm volatile("s_waitcnt vmcnt(0)" ::: "memory");
            const unsigned og = xb_add(&bar[XB_TOP], 1u);
            const unsigned tg = og / nx;
            if (og + 1u == (tg + 1u) * nx) xb_add(&bar[XB_TOPGEN], 1u);
            else XB_SPIN(xb_ld(&bar[XB_TOPGEN]) == tg, bar);
            __builtin_amdgcn_fence(__ATOMIC_ACQUIRE, "agent");
            xb_add(&bar[XB_XGEN(b.x)], 1u);
            asm volatile("s_waitcnt vmcnt(0)" ::: "memory");
        } else {
            XB_SPIN(xb_ld(&bar[XB_XGEN(b.x)]) == gen, bar);
            __builtin_amdgcn_fence(__ATOMIC_ACQUIRE, "agent");
            asm volatile("s_waitcnt vmcnt(0)" ::: "memory");
        }
    }
    __syncthreads();
}

__device__ __forceinline__ float hg_lb(const Ctx& c, int l, int col) {
    if (l == 0) return 0.f;
    const float z0 = INP(c, 8)[col], z1 = INP(c, 8)[512 + col], m = fmaxf(z0, z1), e0 = expf(z0 - m), e1 = expf(z1 - m);
    return e1 / (e0 + e1);
}
__device__ __forceinline__ void hg_logf(const bf16_t* hf, int row0, int col, float lbv, int k, int rg, LAS float* bL, LAS float* seg, float (&kk)[16]) {
    float run = 0.f;
#pragma unroll
    for (int j = 0; j < 16; ++j) { const int s = rg * 16 + j; const float f = bf2f(hf[(size_t)(row0 + s) * 512 + col]);
        const float ex = expf(-f), sg = 1.f / (1.f + ex);
        const float lf = (lbv == 0.f) ? -log1pf(ex) : logf(lbv + (1.f - lbv) * sg);
        kk[j] = (1.f - lbv) * ex * sg; run += lf; bL[s * 129 + k] = run; }
    seg[rg * 128 + k] = run;
}
__device__ __forceinline__ void hg_load_vT(const bf16_t* hv, int row0, int col, int k, int rg, LAS bf16_t* vT) {
    unsigned w[8];
#pragma unroll
    for (int j = 0; j < 8; ++j) { const unsigned lo = hv[(size_t)(row0 + rg * 16 + 2 * j) * 512 + col], hi = hv[(size_t)(row0 + rg * 16 + 2 * j + 1) * 512 + col]; w[j] = lo | (hi << 16); }
    LAS u32x4* d = (LAS u32x4*)(vT + k * 72 + rg * 16);
    d[0] = (u32x4){w[0], w[1], w[2], w[3]}; d[1] = (u32x4){w[4], w[5], w[6], w[7]};
}
constexpr int HG1_KDT = 35072, HG1_VT = 53504;
__device__ __forceinline__ void phase_hg1(const Ctx& c, int l) {
    LAS float* bL = (LAS float*)c.lds; LAS float* seg = bL + 64 * 129;
    LAS bf16_t* kdT = (LAS bf16_t*)(c.lds + HG1_KDT); LAS bf16_t* vT = (LAS bf16_t*)(c.lds + HG1_VT);
    const bf16_t* hf = (const bf16_t*)(c.ws + R_HQ) + (size_t)TOK * 512; const bf16_t* hv = hf + (size_t)TOK * 512;
    bf16_t* hst = (bf16_t*)(c.ws + R_HST); float* hgd = (float*)(c.ws + WS_HGD);
    const int k = c.tid & 127, rg = c.tid >> 7, r = c.lane & 15, q = c.lane >> 4;
    for (int unit = c.bid; unit < 1024; unit += c.G) {
        const int b = unit >> 9, n = (unit >> 2) & 127, h = unit & 3, row0 = b * SEQ + n * 64, col = h * 128 + k;
        const float lbv = hg_lb(c, l, col);
        float kk[16];
        hg_logf(hf, row0, col, lbv, k, rg, bL, seg, kk);
        hg_load_vT(hv, row0, col, k, rg, vT);
        __syncthreads();
        float pre = 0.f;
        for (int s = 0; s < rg; ++s) pre += seg[s * 128 + k];
        const float blast = (seg[k] + seg[128 + k]) + (seg[256 + k] + seg[384 + k]);
        unsigned w[8];
#pragma unroll
        for (int j = 0; j < 8; ++j) { const int s = rg * 16 + 2 * j;
            const float b0 = bL[s * 129 + k] + pre, b1 = bL[(s + 1) * 129 + k] + pre;
            w[j] = pk2(kk[2 * j] * expf(blast - b0), kk[2 * j + 1] * expf(blast - b1)); }
        { LAS u32x4* d = (LAS u32x4*)(kdT + k * 72 + rg * 16); d[0] = (u32x4){w[0], w[1], w[2], w[3]}; d[1] = (u32x4){w[4], w[5], w[6], w[7]}; }
        if (rg == 0) hgd[unit * 128 + k] = expf(blast);
        __syncthreads();
        f32x4 acc[1][8];
#pragma unroll
        for (int nt = 0; nt < 8; ++nt) acc[0][nt] = (f32x4){0.f, 0.f, 0.f, 0.f};
        wave_mma<1, 8, 2>(acc, vT + (16 * c.wave) * 72, 72, kdT, 72, c.lane);
        bf16_t* dst = hst + (size_t)unit * 16384;
#pragma unroll
        for (int nt = 0; nt < 8; ++nt)
#pragma unroll
            for (int j = 0; j < 4; ++j) dst[(16 * c.wave + 4 * q + j) * 128 + nt * 16 + r] = (bf16_t)f2bf(acc[0][nt][j]);
        __syncthreads();
    }
}
__device__ __forceinline__ void phase_hg2(const Ctx& c) {
    bf16_t* hst = (bf16_t*)(c.ws + R_HST); const float* hgd = (const float*)(c.ws + WS_HGD);
    for (int idx = c.bid * NTHREADS + c.tid; idx < 65536; idx += c.G * NTHREADS) {
        const int bh = idx >> 13, e2 = idx & 8191, b = bh >> 2, h = bh & 3, kc = (e2 * 2) & 127;
        float s0 = 0.f, s1 = 0.f;
        for (int n0 = 0; n0 < 128; n0 += 8) {
            unsigned u[8]; f32x2 d[8];
#pragma unroll
            for (int i = 0; i < 8; ++i) { const int unit = (b * 128 + n0 + i) * 4 + h; u[i] = ((const unsigned*)(hst + (size_t)unit * 16384))[e2]; d[i] = *(const f32x2*)(hgd + unit * 128 + kc); }
#pragma unroll
            for (int i = 0; i < 8; ++i) { const int unit = (b * 128 + n0 + i) * 4 + h; ((unsigned*)(hst + (size_t)unit * 16384))[e2] = pk2(s0, s1);
                s0 = d[i][0] * s0 + bflo(u[i]); s1 = d[i][1] * s1 + bfhi(u[i]); }
        }
    }
}
constexpr int HG3_QD = 35072, HG3_ST = 52480, HG3_QT = 87296, HG3_KT = 104704, HG3_P = 122112, HG3_VT = 131328;
static_assert(HG3_VT + 128 * 72 * 2 <= LDS_BYTES, "hg3 LDS map");
__device__ __forceinline__ void phase_hg3(const Ctx& c, int l) {
    LAS float* bL = (LAS float*)c.lds; LAS float* seg = bL + 64 * 129;
    LAS bf16_t* qd = (LAS bf16_t*)(c.lds + HG3_QD); LAS bf16_t* ST = (LAS bf16_t*)(c.lds + HG3_ST); LAS bf16_t* qt = (LAS bf16_t*)(c.lds + HG3_QT);
    LAS bf16_t* kt = (LAS bf16_t*)(c.lds + HG3_KT); LAS bf16_t* P = (LAS bf16_t*)(c.lds + HG3_P); LAS bf16_t* vT = (LAS bf16_t*)(c.lds + HG3_VT);
    const bf16_t* hq = (const bf16_t*)(c.ws + R_HQ); const bf16_t* hf = hq + (size_t)TOK * 512; const bf16_t* hv = hf + (size_t)TOK * 512; const bf16_t* hg = hv + (size_t)TOK * 512;
    const bf16_t* hst = (const bf16_t*)(c.ws + R_HST); bf16_t* ya = (bf16_t*)(c.ws + WS_Y);
    const float* gnorm = INP(c, 9) + l * 512;
    const int k = c.tid & 127, rg = c.tid >> 7, r = c.lane & 15, q = c.lane >> 4, w = c.wave;
    for (int unit = c.bid; unit < 1024; unit += c.G) {
        const int b = unit >> 9, n = (unit >> 2) & 127, h = unit & 3, row0 = b * SEQ + n * 64, col = h * 128 + k;
        const float lbv = hg_lb(c, l, col);
        float kk[16];
        hg_logf(hf, row0, col, lbv, k, rg, bL, seg, kk);
        hg_load_vT(hv, row0, col, k, rg, vT);
#pragma unroll
        for (int i = 0; i < 4; ++i) { const int id = c.tid + NTHREADS * i, v = id >> 4, cc = id & 15;
            *(LAS u32x4*)(ST + v * 136 + cc * 8) = *(const u32x4*)(hst + (size_t)unit * 16384 + v * 128 + cc * 8); }
        __syncthreads();
        float pre = 0.f;
        for (int s = 0; s < rg; ++s) pre += seg[s * 128 + k];
        const float bref = bL[31 * 129 + k] + seg[k];
#pragma unroll
        for (int j = 0; j < 16; ++j) { const int s = rg * 16 + j; const float bv = bL[s * 129 + k] + pre;
            const float qf = siluf(bf2f(hq[(size_t)(row0 + s) * 512 + col])) * 0.08838834764831845f;
            qd[s * 136 + k] = (bf16_t)f2bf(qf * expf(bv));
            qt[s * 136 + k] = (bf16_t)f2bf(qf * expf(fminf(bv - bref, 80.f)));
            kt[s * 136 + k] = (bf16_t)f2bf(kk[j] * expf(fminf(bref - bv, 80.f))); }
        __syncthreads();
        {
            f32x4 a2[1][2] = {{(f32x4){0.f, 0.f, 0.f, 0.f}, (f32x4){0.f, 0.f, 0.f, 0.f}}};
            wave_mma<1, 2, 4>(a2, qt + (16 * (w >> 1)) * 136, 136, kt + (32 * (w & 1)) * 136, 136, c.lane);
#pragma unroll
            for (int nt = 0; nt < 2; ++nt)
#pragma unroll
                for (int j = 0; j < 4; ++j) { const int t = 16 * (w >> 1) + 4 * q + j, s = 32 * (w & 1) + nt * 16 + r; P[t * 72 + s] = (bf16_t)f2bf(s <= t ? a2[0][nt][j] : 0.f); }
        }
        __syncthreads();
        {
            f32x4 a4[1][4];
#pragma unroll
            for (int nt = 0; nt < 4; ++nt) a4[0][nt] = (f32x4){0.f, 0.f, 0.f, 0.f};
            wave_mma<1, 4, 4>(a4, qd + (16 * (w >> 1)) * 136, 136, ST + (64 * (w & 1)) * 136, 136, c.lane);
            wave_mma<1, 4, 2>(a4, P + (16 * (w >> 1)) * 72, 72, vT + (64 * (w & 1)) * 72, 72, c.lane);
#pragma unroll
            for (int nt = 0; nt < 4; ++nt)
#pragma unroll
                for (int j = 0; j < 4; ++j) bL[(16 * (w >> 1) + 4 * q + j) * 129 + 64 * (w & 1) + nt * 16 + r] = a4[0][nt][j];
        }
        __syncthreads();
        {
            const int t = c.tid >> 3, v0 = (c.tid & 7) * 16; float o[16]; float ss = 0.f;
#pragma unroll
            for (int e = 0; e < 16; ++e) { o[e] = bL[t * 129 + v0 + e]; ss += o[e] * o[e]; }
            ss += __shfl_xor(ss, 1); ss += __shfl_xor(ss, 2); ss += __shfl_xor(ss, 4);
            const float rs = 1.f / sqrtf(ss * (1.f / 128.f) + NORM_EPS);
            const bf16_t* gp = hg + (size_t)(row0 + t) * 512 + h * 128 + v0; const u32x4 g0 = *(const u32x4*)gp, g1 = *(const u32x4*)(gp + 8);
            const unsigned gw[8] = {g0.x, g0.y, g0.z, g0.w, g1.x, g1.y, g1.z, g1.w}; unsigned ow[8];
#pragma unroll
            for (int e = 0; e < 8; ++e) { const float ga = bflo(gw[e]), gb = bfhi(gw[e]);
                ow[e] = pk2(o[2 * e] * rs * gnorm[h * 128 + v0 + 2 * e] * siluf(ga), o[2 * e + 1] * rs * gnorm[h * 128 + v0 + 2 * e + 1] * siluf(gb)); }
            bf16_t* yp = ya + (size_t)(row0 + t) * 512 + h * 128 + v0;
            *(u32x4*)yp = (u32x4){ow[0], ow[1], ow[2], ow[3]}; *(u32x4*)(yp + 8) = (u32x4){ow[4], ow[5], ow[6], ow[7]};
        }
        __syncthreads();
    }
}

__device__ __forceinline__ void phase_s5scan(const Ctx& c) {
    const int idx = c.bid * NTHREADS + c.tid;
    if (idx >= 4096) return;
    const int b = idx >> 11, g = (idx >> 6) & 31, p = idx & 63;
    const float* a32 = (const float*)(c.ws + WS_A32) + (g * 64 + p) * 2; const float ar = a32[0], ai = a32[1];
    bf16_t* s5A = (bf16_t*)(c.ws + R_S5A); const float* E = (const float*)(c.ws + WS_S5E);
    float xr = 0.f, xi = 0.f;
    for (int n0 = 0; n0 < 256; n0 += 8) {
        float er[8], ei[8];
#pragma unroll
        for (int i = 0; i < 8; ++i) { const size_t row = (size_t)g * 512 + b * 256 + n0 + i; er[i] = E[row * 128 + p]; ei[i] = E[row * 128 + 64 + p]; }
#pragma unroll
        for (int i = 0; i < 8; ++i) { const size_t row = (size_t)g * 512 + b * 256 + n0 + i; s5A[row * 640 + p] = (bf16_t)f2bf(xr); s5A[row * 640 + 64 + p] = (bf16_t)f2bf(xi);
            const float nr = ar * xr - ai * xi + er[i], ni = ar * xi + ai * xr + ei[i]; xr = nr; xi = ni; }
    }
}

constexpr int AT_K = 17408, AT_VT = 69632, AT_S = 120832;
static_assert(AT_S + 32 * 196 * 4 <= LDS_BYTES, "attention LDS map");
__device__ __forceinline__ float wave_max(float v) {
#pragma unroll
    for (int o = 1; o < 64; o <<= 1) v = fmaxf(v, __shfl_xor(v, o));
    return v;
}
__device__ __forceinline__ void attn_stage_rope(LAS bf16_t* dst, const bf16_t* src, const f32x2* rope_b, int first, int nrows, int sh, int res, int tid) {
    for (int id = tid; id < nrows * 16; id += NTHREADS) {
        const int row = id >> 4, cc = id & 15, idx = first + row; u32x4 v = (u32x4){0u, 0u, 0u, 0u};
        if (idx >= 0) { const int tok = (idx << sh) + res; const bf16_t* rp = src + (size_t)tok * 128;
            v = *(const u32x4*)(rp + cc * 8);
            if (cc < 4) { const u32x4 pv = *(const u32x4*)(rp + (cc ^ 2) * 8); const f32x4* cs = (const f32x4*)(rope_b + (size_t)tok * 16 + 8 * (cc & 1));
                const unsigned vw[4] = {v.x, v.y, v.z, v.w}, pw[4] = {pv.x, pv.y, pv.z, pv.w}; unsigned ow[4];
#pragma unroll
                for (int e = 0; e < 4; ++e) { const f32x4 t = cs[e];
                    const float x0 = bflo(vw[e]), x1 = bfhi(vw[e]), y0 = bflo(pw[e]), y1 = bfhi(pw[e]);
                    float o0, o1;
                    if (cc < 2) { o0 = x0 * t[0] - y0 * t[1]; o1 = x1 * t[2] - y1 * t[3]; }
                    else        { o0 = x0 * t[0] + y0 * t[1]; o1 = x1 * t[2] + y1 * t[3]; }
                    ow[e] = pk2(o0, o1); }
                v = (u32x4){ow[0], ow[1], ow[2], ow[3]}; } }
        *(LAS u32x4*)(dst + row * 136 + cc * 8) = v; }
}
__device__ __forceinline__ void phase_attn(const Ctx& c) {
    LAS bf16_t* Qs = (LAS bf16_t*)c.lds; LAS bf16_t* Ks = (LAS bf16_t*)(c.lds + AT_K); LAS bf16_t* Vt = (LAS bf16_t*)(c.lds + AT_VT); LAS float* S = (LAS float*)(c.lds + AT_S);
    bf16_t* qkv = (bf16_t*)(c.ws + R_QKV); float* lse = (float*)(c.ws + WS_LSE); const f32x2* rope = (const f32x2*)(c.ws + WS_ROPE);
    const int r = c.lane & 15, q = c.lane >> 4, w = c.wave;
    for (int unit = c.bid; unit < 3072; unit += c.G) {
        const int bh = unit >> 7, u7 = unit & 127, b = bh / 12, h = bh % 12, sh = 2 * (h >> 2), per = 128 >> sh, res = u7 / per, jb = u7 % per;
        const int i0 = 64 * jb, j0 = i0 - 128;
        bf16_t* qb = qkv + (size_t)bh * SEQ * 128; const bf16_t* kb = qkv + QKV_WHICH + (size_t)bh * SEQ * 128; const bf16_t* vb = qkv + 2 * QKV_WHICH + (size_t)bh * SEQ * 128;
        const f32x2* rope_b = rope + (size_t)b * SEQ * 16;
        attn_stage_rope(Qs, qb, rope_b, i0, 64, sh, res, c.tid);
        attn_stage_rope(Ks, kb, rope_b, j0, 192, sh, res, c.tid);
#pragma unroll
        for (int ps = 0; ps < 3; ++ps)
#pragma unroll
            for (int hf = 0; hf < 2; ++hf) { const int kk = ps * 64 + c.lane, cc = w + 8 * hf, idx = j0 + kk; u32x4 v = (u32x4){0u, 0u, 0u, 0u};
                if (idx >= 0) v = *(const u32x4*)(vb + (size_t)((idx << sh) + res) * 128 + cc * 8);
                const unsigned vw[4] = {v.x, v.y, v.z, v.w};
#pragma unroll
                for (int e = 0; e < 4; ++e) { Vt[(cc * 8 + 2 * e) * 200 + kk] = (bf16_t)(vw[e] & 0xffffu); Vt[(cc * 8 + 2 * e + 1) * 200 + kk] = (bf16_t)(vw[e] >> 16); } }
        __syncthreads();
#pragma unroll 1
        for (int hq = 0; hq < 2; ++hq) {
            {
                f32x4 a3[1][3];
#pragma unroll
                for (int nt = 0; nt < 3; ++nt) a3[0][nt] = (f32x4){0.f, 0.f, 0.f, 0.f};
                wave_mma<1, 3, 4>(a3, Qs + (32 * hq + 16 * (w & 1)) * 136, 136, Ks + (48 * (w >> 1)) * 136, 136, c.lane);
#pragma unroll
                for (int nt = 0; nt < 3; ++nt)
#pragma unroll
                    for (int j = 0; j < 4; ++j) { const int t = 16 * (w & 1) + 4 * q + j, kk = 48 * (w >> 1) + nt * 16 + r, i = i0 + 32 * hq + t, jn = j0 + kk;
                        const bool ok = (jn >= 0) && (jn <= i) && (i - jn <= 128);
                        S[t * 196 + kk] = ok ? a3[0][nt][j] * 0.08838834764831845f : -1e30f; }
            }
            __syncthreads();
#pragma unroll
            for (int rr = 0; rr < 4; ++rr) { const int t = 4 * w + rr; LAS float* sr = S + t * 196;
                const float s0 = sr[c.lane], s1 = sr[64 + c.lane], s2 = sr[128 + c.lane];
                const float m = wave_max(fmaxf(s0, fmaxf(s1, s2)));
                const float e0 = __expf(s0 - m), e1 = __expf(s1 - m), e2 = __expf(s2 - m);
                const float sum = wave_sum(e0 + e1 + e2), inv = 1.f / sum;
                LAS bf16_t* pr = (LAS bf16_t*)sr;
                pr[c.lane] = (bf16_t)f2bf(e0 * inv); pr[64 + c.lane] = (bf16_t)f2bf(e1 * inv); pr[128 + c.lane] = (bf16_t)f2bf(e2 * inv);
                if (c.lane == 0) lse[(size_t)bh * SEQ + (((i0 + 32 * hq + t) << sh) + res)] = m + logf(sum); }
            __syncthreads();
            {
                f32x4 a2[1][2] = {{(f32x4){0.f, 0.f, 0.f, 0.f}, (f32x4){0.f, 0.f, 0.f, 0.f}}};
                wave_mma<1, 2, 6>(a2, (LAS bf16_t*)S + (16 * (w & 1)) * 392, 392, Vt + (32 * (w >> 1)) * 200, 200, c.lane);
#pragma unroll
                for (int nt = 0; nt < 2; ++nt)
#pragma unroll
                    for (int j = 0; j < 4; ++j) { const int t = 16 * (w & 1) + 4 * q + j, dim = 32 * (w >> 1) + nt * 16 + r, tok = ((i0 + 32 * hq + t) << sh) + res;
                        qb[(size_t)tok * 128 + dim] = (bf16_t)f2bf(a2[0][nt][j]); }
            }
            __syncthreads();
        }
    }
}
__device__ __forceinline__ void phase_attn_merge(const Ctx& c) {
    const bf16_t* qkv = (const bf16_t*)(c.ws + R_QKV); const float* lse = (const float*)(c.ws + WS_LSE); bf16_t* yd = (bf16_t*)(c.ws + WS_Y) + (size_t)3 * TOK * 512;
    for (int id = c.bid * NTHREADS + c.tid; id < TOK * 64; id += c.G * NTHREADS) {
        const int row = id >> 6, hp = (id >> 4) & 3, cc = id & 15, b = row >> 13, t = row & 8191;
        float lw[3]; u32x4 ov[3];
#pragma unroll
        for (int g = 0; g < 3; ++g) { const int bh = b * 12 + g * 4 + hp; lw[g] = lse[(size_t)bh * SEQ + t]; ov[g] = *(const u32x4*)(qkv + ((size_t)bh * SEQ + t) * 128 + cc * 8); }
        const float m = fmaxf(lw[0], fmaxf(lw[1], lw[2])); float e[3], s = 0.f;
#pragma unroll
        for (int g = 0; g < 3; ++g) { e[g] = __expf(lw[g] - m); s += e[g]; }
        const float inv = 1.f / s; float o[8];
#pragma unroll
        for (int i = 0; i < 8; ++i) o[i] = 0.f;
#pragma unroll
        for (int g = 0; g < 3; ++g) { const float wg = e[g] * inv; const unsigned vw[4] = {ov[g].x, ov[g].y, ov[g].z, ov[g].w};
#pragma unroll
            for (int i = 0; i < 4; ++i) { o[2 * i] += wg * bflo(vw[i]); o[2 * i + 1] += wg * bfhi(vw[i]); } }
        *(u32x4*)(yd + (size_t)row * 512 + hp * 128 + cc * 8) = (u32x4){pk2(o[0], o[1]), pk2(o[2], o[3]), pk2(o[4], o[5]), pk2(o[6], o[7])};
    }
}

constexpr int XB_LDS_OFF = 151040;
constexpr int PH_PER_LAYER = 17, N_PHASES = NLAYER * PH_PER_LAYER + 1;
#ifndef MK_MASK
#define MK_MASK 0xFFFFF
#endif
#ifndef MK_CG_SYNC
#define MK_CG_SYNC 0
#endif
#ifndef MK_SPLIT
#define MK_SPLIT 0
#endif

template <class Epi> __device__ __forceinline__ void run_gemm(const Ctx& c, const bf16_t* A, int lda, const bf16_t* Bt, int ldb, int K, int N, const Epi& E) {
    pg8::Gemm g{A, Bt, lda, ldb, K}; pg8::StaticOrder S; S.init(TOK, N, c.G, c.bid, lda, ldb);
    int t_ = c.tid; asm volatile("" : "+v"(t_));
    pg8::gemm_phase<Epi, pg8::StaticOrder, true, true>(c.lds, g, S, E, t_);
}

__global__ void __launch_bounds__(NTHREADS, 2) hgpm_fwd(Args args) {
    extern __shared__ __attribute__((aligned(16))) unsigned char lds_raw[];
    Ctx c; c.lds = (LAS unsigned char*)lds_raw; c.G = gridDim.x; c.bid = blockIdx.x; c.in = args.in;
    volatile LAS unsigned* xb_st = (volatile LAS unsigned*)(c.lds + XB_LDS_OFF);
    if (threadIdx.x < 4) xb_st[threadIdx.x] = 0u;
    __syncthreads();
    XcdBarrier bar = xcd_barrier_post((unsigned*)(args.ws + WS_CTL), xb_st);

    for (int ph = args.ph_lo; ph < args.ph_hi; ++ph) {
        const int l = ph / PH_PER_LAYER, p = ph % PH_PER_LAYER;
        { int t_ = threadIdx.x; asm volatile("" : "+v"(t_)); c.tid = t_; c.lane = t_ & 63; c.wave = __builtin_amdgcn_readfirstlane(t_ >> 6); }
        { int z_ = 0; asm volatile("" : "+s"(z_)); c.zo = z_; c.ws = args.ws + z_; c.out = args.out + z_; }
        unsigned char* ws = c.ws;
        bf16_t* XN = (bf16_t*)(ws + WS_XN); bf16_t* Y = (bf16_t*)(ws + WS_Y); bf16_t* MERGED = (bf16_t*)(ws + WS_MERGED); bf16_t* Z = MERGED;
        bf16_t* HBUF = (bf16_t*)(ws + R_HBUF); bf16_t* BALL = (bf16_t*)(ws + R_BALL); bf16_t* S5A = (bf16_t*)(ws + R_S5A);
        if (ph == N_PHASES - 1) { phase_final_norm(c, c.out, INP(c, 29)); }
        else switch (p) {
#if (MK_MASK >> 0) & 1
        case 0: phase_wprep(c, l); phase_norm(c, l == 0 ? INP(c, 0) : c.out, XN); break;
#endif
#if (MK_MASK >> 1) & 1
        case 1: case 15: run_gemm(c, XN, DM, (const bf16_t*)(ws + (p == 1 ? W_GU1 : W_GU2)), DM, DM, 2 * DFF, pg8::EpiGated<0>{HBUF, DFF}); break;
#endif
#if (MK_MASK >> 2) & 1
        case 2: case 16: run_gemm(c, HBUF, DFF, (const bf16_t*)(ws + (p == 2 ? W_D1 : W_D2)), DFF, DFF, DM, pg8::EpiResid{(l == 0 && p == 2) ? INP(c, 0) : c.out, c.out, 0.5f}); break;
#endif
#if (MK_MASK >> 3) & 1
        case 3: case 14: phase_norm(c, c.out, XN); break;
#endif
#if (MK_MASK >> 4) & 1
        case 4: run_gemm(c, XN, DM, (const bf16_t*)(ws + W_C1), DM, DM, 3584, pg8::EpiC1{(bf16_t*)(ws + R_HQ), S5A, (bf16_t*)(ws + R_CONV)}); break;
#endif
#if (MK_MASK >> 5) & 1
        case 5: { pg8::Gemm g{S5A, (const bf16_t*)(ws + W_S5E), 640, 512, 512}; pg8::S5eOrder S{c.G, c.bid};
#if (MK_MASK >> 19) & 1
                  pg8::gemm_phase<pg8::EpiS5e, pg8::S5eOrder, true, true>(c.lds, g, S, pg8::EpiS5e{(float*)(ws + WS_S5E)}, c.tid);
#endif
#if (MK_MASK >> 16) & 1
                  phase_hg1(c, l);
#endif
#if (MK_MASK >> 17) & 1
                  phase_conv(c, l);
#endif
                  } break;
#endif
#if (MK_MASK >> 6) & 1
        case 6: phase_hg2(c); phase_s5scan(c); break;
#endif
#if (MK_MASK >> 7) & 1
        case 7: { pg8::Gemm g{S5A, (const bf16_t*)(ws + W_S5M), 640, 640, 640}; pg8::S5mOrder S{c.G, c.bid};
#if (MK_MASK >> 19) & 1
                  pg8::gemm_phase<pg8::EpiS5m, pg8::S5mOrder, true, true>(c.lds, g, S, pg8::EpiS5m{S5A, INP(c, 17) + l * 512, Z}, c.tid);
#endif
#if (MK_MASK >> 18) & 1
                  phase_hg3(c, l);
#endif
                  } break;
#endif
#if (MK_MASK >> 8) & 1
        case 8:
#if (MK_MASK >> 16) & 1
                run_gemm(c, Z, 512, (const bf16_t*)(ws + W_GLU), 512, 512, 1024, pg8::EpiGated<1>{Y + (size_t)TOK * 512, 512});
#endif
#if (MK_MASK >> 17) & 1
                run_gemm(c, XN, DM, (const bf16_t*)(ws + W_C2), DM, DM, 4608, pg8::EpiC2{(bf16_t*)(ws + R_QKV)});
#endif
                break;
#endif
#if (MK_MASK >> 9) & 1
        case 9: phase_attn(c); break;
#endif
#if (MK_MASK >> 10) & 1
        case 10: phase_attn_merge(c); break;
#endif
#if (MK_MASK >> 11) & 1
        case 11: { pg8::Gemm g{Y, (const bf16_t*)(ws + W_BR), 512, 512, 512}; pg8::BranchOrder S; S.init(c.G, c.bid);
                   pg8::gemm_phase<pg8::EpiBranch, pg8::BranchOrder, true, true>(c.lds, g, S, pg8::EpiBranch{BALL}, c.tid); } break;
#endif
#if (MK_MASK >> 12) & 1
        case 12: run_gemm(c, XN, DM, (const bf16_t*)(ws + W_GATE), DM, DM, 4096, pg8::EpiGateMerge{BALL, MERGED}); break;
#endif
#if (MK_MASK >> 13) & 1
        case 13: run_gemm(c, MERGED, DM, (const bf16_t*)(ws + W_OUT), DM, DM, DM, pg8::EpiResid{c.out, c.out, 1.0f}); break;
#endif
        }
        if (ph + 1 < args.ph_hi) {
#if MK_CG_SYNC
            __syncthreads(); cg::this_grid().sync();
#else
            xcd_barrier(bar);
#endif
        }
    }
}

extern "C" void kernel_launch(void* const* d_in, const int* in_sizes, int n_in, void* d_out, int out_size, void* d_ws, size_t ws_size, hipStream_t stream) {
    static int grid = 0;
    if (grid == 0) {
        if (n_in != 30 || in_sizes[0] != TOK * DM || out_size != TOK * DM || ws_size < WS_END) {
            fprintf(stderr, "kernel_launch: unexpected problem: n_in %d, in0 %d, out %d, ws %zu (need %zu)\n", n_in, n_in > 0 ? in_sizes[0] : -1, out_size, ws_size, (size_t)WS_END); grid = -1; return; }
        int dev = 0, cus = 0, per_cu = 0;
        if (hipGetDevice(&dev) != hipSuccess || hipDeviceGetAttribute(&cus, hipDeviceAttributeMultiprocessorCount, dev) != hipSuccess) { fprintf(stderr, "kernel_launch: device query failed\n"); grid = -1; return; }
        if (hipFuncSetAttribute((const void*)hgpm_fwd, hipFuncAttributeMaxDynamicSharedMemorySize, LDS_BYTES) != hipSuccess) { fprintf(stderr, "kernel_launch: hipFuncSetAttribute failed\n"); grid = -1; return; }
        if (hipOccupancyMaxActiveBlocksPerMultiprocessor(&per_cu, (const void*)hgpm_fwd, NTHREADS, LDS_BYTES) != hipSuccess || per_cu < 1) { fprintf(stderr, "kernel_launch: occupancy query says %d blocks per CU\n", per_cu); (void)hipGetLastError(); grid = -1; return; }
        grid = cus * 1;
    }
    if (grid < 0) return;
    (void)hipMemsetAsync((char*)d_ws + WS_CTL, 0, 1 * MiB, stream);
    Args a{};
    for (int i = 0; i < 30; ++i) a.in[i] = (const float*)d_in[i];
    a.out = (float*)d_out; a.ws = (unsigned char*)d_ws;
#if MK_SPLIT
    for (int ph = 0; ph < N_PHASES; ++ph) { a.ph_lo = ph; a.ph_hi = ph + 1; hipLaunchKernelGGL(hgpm_fwd, dim3(grid), dim3(NTHREADS), LDS_BYTES, stream, a); }
#else
    a.ph_lo = 0; a.ph_hi = N_PHASES;
    void* kargs[] = {&a};
    const hipError_t e = hipLaunchCooperativeKernel((const void*)hgpm_fwd, dim3(grid), dim3(NTHREADS), kargs, LDS_BYTES, stream);
    if (e != hipSuccess) fprintf(stderr, "kernel_launch: cooperative launch failed: %s (grid %d)\n", hipGetErrorString(e), grid);
#endif
}
```

```cpp
#include <hip/hip_runtime.h>
#include <hip/hip_cooperative_groups.h>
#include <cstdio>
#include <cstdint>
namespace cg = cooperative_groups;

#define LAS __attribute__((address_space(3)))
typedef unsigned short bf16_t;
typedef short bf16x8 __attribute__((ext_vector_type(8)));
typedef float f32x4 __attribute__((ext_vector_type(4)));
typedef float f32x2 __attribute__((ext_vector_type(2)));
typedef unsigned u32x4 __attribute__((ext_vector_type(4)));
typedef unsigned u32x2 __attribute__((ext_vector_type(2)));

constexpr int BATCH = 2, SEQ = 8192, TOK = BATCH * SEQ, DM = 1024, DFF = 2816, NLAYER = 2, INW = 12288;
constexpr float NORM_EPS = 1e-6f;

__device__ __forceinline__ unsigned f2bf(float f) { unsigned u = __builtin_bit_cast(unsigned, f); return (u + 0x7fffu + ((u >> 16) & 1u)) >> 16; }
__device__ __forceinline__ float bf2f(unsigned b) { return __builtin_bit_cast(float, b << 16); }
__device__ __forceinline__ unsigned pk2(float lo, float hi) { return f2bf(lo) | (f2bf(hi) << 16); }
__device__ __forceinline__ float bflo(unsigned w) { return __builtin_bit_cast(float, w << 16); }
__device__ __forceinline__ float bfhi(unsigned w) { return __builtin_bit_cast(float, w & 0xffff0000u); }
__device__ __forceinline__ float sigm(float x) { return 1.f / (1.f + __expf(-x)); }
__device__ __forceinline__ float siluf(float x) { return x / (1.f + __expf(-x)); }
__device__ __forceinline__ float gelu_tanh(float x) { const float y = 0.7978845608028654f * (x + 0.044715f * x * x * x); const float t = 1.f - 2.f / (1.f + __expf(2.f * y)); return 0.5f * x * (1.f + t); }
__device__ __forceinline__ float wave_sum(float v) {
#pragma unroll
    for (int o = 1; o < 64; o <<= 1) v += __shfl_xor(v, o);
    return v;
}
#define LDS_WAIT() asm volatile("s_waitcnt lgkmcnt(0)" ::: "memory")

namespace pg8 {
#define PG8_LAS __attribute__((address_space(3)))
constexpr int BM = 256, BK = 64, HALF = 128, HTB = HALF * BK * 2  , STAGE_BYTES = 8 * HTB, NXCD = 8, WGM = 8;

__host__ __device__ __forceinline__ int lds_byte(int r, int c) { const int st = (r >> 4) * 2 + (c >> 5), rr = r & 15, cc = c & 31, ob = rr * 64 + cc * 2; return st * 1024 + (ob ^ (((ob >> 9) & 1) << 5)); }
__host__ __device__ __forceinline__ void stage_rc(int b, int& R, int& C) { const int st = b / 1024, sb = b % 1024, swz = sb ^ (((sb >> 9) & 1) << 5); R = (st >> 1) * 16 + swz / 64; C = (st & 1) * 32 + (swz % 64) / 2; }
__host__ __device__ __forceinline__ int perm32(int rho) { const int n = rho >> 4, i = rho & 15; return 8 * (i >> 2) + 4 * n + (i & 3); }

struct Unit { int pm, pn, grp; size_t aoff, boff; };
struct Gemm { const bf16_t* A; const bf16_t* Bt; int lda, ldb, K; };

struct StaticOrder {
    int nM, nN, nwg, G, c, lda, ldb;
    __device__ __forceinline__ void init(int M, int N, int G_, int c_, int lda_, int ldb_) { nM = M / BM; nN = N / BM; nwg = nM * nN; G = G_; c = c_; lda = lda_; ldb = ldb_; }
    __device__ __forceinline__ bool next(int i, Unit& u) const {
        const long L = (long)i * G + c; if (L >= nwg) return false;
        int wgid = (int)L; { const int q = nwg / NXCD, r = nwg % NXCD, xcd = wgid % NXCD, off = wgid / NXCD; wgid = (xcd < r ? xcd * (q + 1) : r * (q + 1) + (xcd - r) * q) + off; }
        const int nig = WGM * nN, gid = wgid / nig, fm = gid * WGM, gsz = (nM - fm) < WGM ? (nM - fm) : WGM;
        u.pm = fm + ((wgid % nig) % gsz); u.pn = (wgid % nig) / gsz; u.grp = 0;
        u.aoff = (size_t)u.pm * 256 * lda * 2; u.boff = (size_t)u.pn * 256 * ldb * 2; return true;
    }
    __device__ __forceinline__ void a_ready(const Unit&) const {}
    __device__ __forceinline__ void done(const Unit&) const {}
};
struct BranchOrder {
    StaticOrder so;
    __device__ __forceinline__ void init(int G_, int c_) { so.init(TOK, 1024, G_, c_, 512, 512); }
    __device__ __forceinline__ bool next(int i, Unit& u) const {
        const long L = (long)i * so.G + so.c; if (L >= 1024) return false;
        const int k = (int)(L >> 8); StaticOrder s2 = so; s2.G = 256; s2.c = (int)(L & 255);
        if (!s2.next(0, u)) return false;
        u.grp = k; u.aoff += (size_t)k * TOK * 512 * 2; u.boff += (size_t)k * 1024 * 512 * 2; return true;
    }
    __device__ __forceinline__ void a_ready(const Unit&) const {}
    __device__ __forceinline__ void done(const Unit&) const {}
};
struct S5eOrder {
    int G, c;
    __device__ __forceinline__ bool next(int i, Unit& u) const {
        const long L = (long)i * G + c; if (L >= 64) return false;
        const int g = (int)L >> 1, pm = (int)L & 1; u.pm = pm; u.pn = 0; u.grp = g;
        u.aoff = ((size_t)(g * 512 + pm * 256) * 640 + 128) * 2; u.boff = (size_t)g * 256 * 512 * 2; return true;
    }
    __device__ __forceinline__ void a_ready(const Unit&) const {}
    __device__ __forceinline__ void done(const Unit&) const {}
};
struct S5mOrder {
    int G, c;
    __device__ __forceinline__ bool next(int i, Unit& u) const {
        const long L = (long)i * G + c; if (L >= 128) return false;
        const int g = (int)L >> 2, pm = ((int)L >> 1) & 1, pn = (int)L & 1; u.pm = pm; u.pn = pn; u.grp = g;
        u.aoff = (size_t)(g * 512 + pm * 256) * 640 * 2; u.boff = (size_t)(g * 512 + pn * 256) * 640 * 2; return true;
    }
    __device__ __forceinline__ void a_ready(const Unit&) const {}
    __device__ __forceinline__ void done(const Unit&) const {}
};

__device__ __forceinline__ unsigned cvt_pk_bf16(float lo, float hi) { unsigned r; asm volatile("v_cvt_pk_bf16_f32 %0, %1, %2" : "=v"(r) : "v"(lo), "v"(hi)); return r; }
__device__ __forceinline__ u32x4 pack8(const f32x4& v0, const f32x4& v1) { u32x4 w; w.x = cvt_pk_bf16(v0[0], v0[1]); w.y = cvt_pk_bf16(v0[2], v0[3]); w.z = cvt_pk_bf16(v1[0], v1[1]); w.w = cvt_pk_bf16(v1[2], v1[3]); return w; }

template <int MODE> struct EpiGated {
    static constexpr bool PERM = true, AFTER_DRAIN = false;
    bf16_t* O; int ldo; const float* ssq;
    __device__ __forceinline__ void operator()(const f32x4 (&acc)[2][2][4][2], const Unit& u, int wr, int wc, int fr, int fq) const {
        const int row0 = u.pm * BM + wr * 64 + fr, col0 = u.pn * 128 + wc * 32 + 8 * fq;
#pragma unroll
        for (int ai = 0; ai < 2; ++ai)
#pragma unroll
            for (int m = 0; m < 4; ++m) { const int row = row0 + ai * HALF + m * 16; bf16_t* rowp = O + (size_t)row * ldo + col0;
                const float rs = ssq ? rsqrtf(ssq[row] * (1.f / DM) + NORM_EPS) : 1.f;
                f32x4 v[2];
#pragma unroll
                for (int n = 0; n < 2; ++n)
#pragma unroll
                    for (int j = 0; j < 4; ++j) { const float a = acc[ai][0][m][n][j] * rs, b = acc[ai][1][m][n][j] * rs; v[n][j] = (MODE == 0) ? siluf(a) * b : a * sigm(b); }
                *(u32x4*)rowp = pack8(v[0], v[1]); asm volatile("" ::: "memory"); }
    }
};
struct EpiResid {
    static constexpr bool PERM = false, AFTER_DRAIN = false;
    const float* base; float* out; float scale; bf16_t* xn; float* ssq;
    __device__ __forceinline__ void operator()(const f32x4 (&acc)[2][2][4][2], const Unit& u, int wr, int wc, int fr, int fq) const {
        const int row0 = u.pm * BM + wr * 64 + fr, col0 = u.pn * BM + wc * 32 + 4 * fq;
#pragma unroll
        for (int ai = 0; ai < 2; ++ai)
#pragma unroll
            for (int m = 0; m < 4; ++m) { const int row = row0 + ai * HALF + m * 16; const size_t off = (size_t)row * DM + col0; float ss = 0.f;
#pragma unroll
                for (int bj = 0; bj < 2; ++bj)
#pragma unroll
                    for (int n = 0; n < 2; ++n) { const size_t o = off + bj * HALF + n * 16; const f32x4 b = *(const f32x4*)(base + o); const f32x4 v = b + scale * acc[ai][bj][m][n];
                        *(f32x4*)(out + o) = v; ss += (v[0] * v[0] + v[1] * v[1]) + (v[2] * v[2] + v[3] * v[3]);
                        u32x2 w; w.x = cvt_pk_bf16(v[0], v[1]); w.y = cvt_pk_bf16(v[2], v[3]); *(u32x2*)(xn + o) = w; }
                ss += __shfl_xor(ss, 16); ss += __shfl_xor(ss, 32);
                if (fq == 0) atomicAdd(ssq + row, ss);
                asm volatile("" ::: "memory"); }
    }
};
struct EpiC1 {
    static constexpr bool PERM = true, AFTER_DRAIN = false;
    bf16_t* hq; bf16_t* s5A; bf16_t* convin; const float* ssq;
    __device__ __forceinline__ void operator()(const f32x4 (&acc)[2][2][4][2], const Unit& u, int wr, int wc, int fr, int fq) const {
        const int pn = u.pn, rowb = u.pm * BM + wr * 64 + fr, cl = wc * 32 + 8 * fq;
        bf16_t* p0; int sAI, sM1, sM0, sBJ;
        if (pn < 8) { p0 = hq + (size_t)(pn >> 1) * TOK * 512 + (size_t)rowb * 512 + (pn & 1) * 256 + cl; sAI = 128 * 512; sM1 = 32 * 512; sM0 = 16 * 512; sBJ = 128; }
        else if (pn < 10) { const int c5 = (pn - 8) * 256 + cl, g = c5 >> 4, ch = c5 & 15;
            p0 = s5A + ((size_t)(g * 512 + u.pm * 8 + 2 * wr) * 640 + 128 + fr * 16 + ch); sAI = 4 * 640; sM1 = 640; sM0 = 256; sBJ = 8 * 512 * 640; }
        else { p0 = convin + (size_t)rowb * 1024 + (pn - 10) * 256 + cl; sAI = 128 * 1024; sM1 = 32 * 1024; sM0 = 16 * 1024; sBJ = 128; }
#pragma unroll
        for (int ai = 0; ai < 2; ++ai)
#pragma unroll
            for (int m = 0; m < 4; ++m) { const float rs = rsqrtf(ssq[rowb + ai * HALF + m * 16] * (1.f / DM) + NORM_EPS);
#pragma unroll
                for (int bj = 0; bj < 2; ++bj)
                    *(u32x4*)(p0 + (size_t)(ai * sAI + (m >> 1) * sM1 + (m & 1) * sM0 + bj * sBJ)) = pack8(acc[ai][bj][m][0] * rs, acc[ai][bj][m][1] * rs);
                asm volatile("" ::: "memory"); }
    }
};
struct EpiC2 {
    static constexpr bool PERM = true, AFTER_DRAIN = false;
    bf16_t* qkv; const float* ssq;
    __device__ __forceinline__ void operator()(const f32x4 (&acc)[2][2][4][2], const Unit& u, int wr, int wc, int fr, int fq) const {
        const int which = u.pn / 6, hp = u.pn % 6, rowt = u.pm * BM, b = rowt >> 13, t0 = (rowt & 8191) + wr * 64 + fr;
        bf16_t* p0 = qkv + ((size_t)(which * 24 + b * 12 + 2 * hp) * SEQ + t0) * 128 + wc * 32 + 8 * fq;
#pragma unroll
        for (int ai = 0; ai < 2; ++ai)
#pragma unroll
            for (int m = 0; m < 4; ++m) { const float rs = rsqrtf(ssq[rowt + wr * 64 + fr + ai * HALF + m * 16] * (1.f / DM) + NORM_EPS);
#pragma unroll
                for (int bj = 0; bj < 2; ++bj)
                    *(u32x4*)(p0 + (size_t)bj * SEQ * 128 + (size_t)(ai * HALF + m * 16) * 128) = pack8(acc[ai][bj][m][0] * rs, acc[ai][bj][m][1] * rs);
                asm volatile("" ::: "memory"); }
    }
};
struct EpiS5e {
    static constexpr bool PERM = false, AFTER_DRAIN = false;
    float* E;
    __device__ __forceinline__ void operator()(const f32x4 (&acc)[2][2][4][2], const Unit& u, int wr, int wc, int fr, int fq) const {
        const int row0 = u.pm * BM + wr * 64 + fr, col0 = wc * 32 + 4 * fq;
#pragma unroll
        for (int ai = 0; ai < 2; ++ai)
#pragma unroll
            for (int m = 0; m < 4; ++m) { float* rowp = E + (size_t)(u.grp * 512 + row0 + ai * HALF + m * 16) * 128 + col0;
#pragma unroll
                for (int n = 0; n < 2; ++n) *(f32x4*)(rowp + n * 16) = acc[ai][0][m][n]; }
    }
};
struct EpiS5m {
    static constexpr bool PERM = true, AFTER_DRAIN = false;
    const bf16_t* s5A; const float* dskip; bf16_t* Z;
    __device__ __forceinline__ void operator()(const f32x4 (&acc)[2][2][4][2], const Unit& u, int wr, int wc, int fr, int fq) const {
        const int g = u.grp, chunk0 = u.pm * BM + wr * 64 + fr, c0 = 8 * (fq & 1), t0 = u.pn * 16 + 2 * wc + (fq >> 1);
        const f32x4 d0 = *(const f32x4*)(dskip + g * 16 + c0), d1 = *(const f32x4*)(dskip + g * 16 + c0 + 4);
        const bf16_t* up = s5A + (size_t)(g * 512 + chunk0) * 640 + 128 + t0 * 16 + c0;
        bf16_t* zp = Z + (size_t)(chunk0 * 32 + t0) * 512 + g * 16 + c0;
#pragma unroll
        for (int ai = 0; ai < 2; ++ai)
#pragma unroll
            for (int m = 0; m < 4; ++m) {
#pragma unroll
                for (int bj = 0; bj < 2; ++bj) {
                    const u32x4 uu = *(const u32x4*)(up + (size_t)(ai * HALF + m * 16) * 640 + bj * 128);
                    f32x4 v0 = acc[ai][bj][m][0], v1 = acc[ai][bj][m][1];
                    v0[0] += d0[0] * bflo(uu.x); v0[1] += d0[1] * bfhi(uu.x); v0[2] += d0[2] * bflo(uu.y); v0[3] += d0[3] * bfhi(uu.y);
                    v1[0] += d1[0] * bflo(uu.z); v1[1] += d1[1] * bfhi(uu.z); v1[2] += d1[2] * bflo(uu.w); v1[3] += d1[3] * bfhi(uu.w);
#pragma unroll
                    for (int j = 0; j < 4; ++j) { v0[j] = gelu_tanh(v0[j]); v1[j] = gelu_tanh(v1[j]); }
                    *(u32x4*)(zp + (size_t)(ai * HALF + m * 16) * 32 * 512 + bj * 8 * 512) = pack8(v0, v1); }
                asm volatile("" ::: "memory"); }
    }
};
struct EpiBranch {
    static constexpr bool PERM = true, AFTER_DRAIN = false;
    bf16_t* Ball;
    __device__ __forceinline__ void operator()(const f32x4 (&acc)[2][2][4][2], const Unit& u, int wr, int wc, int fr, int fq) const {
        const int row0 = u.pm * BM + wr * 64 + fr, col0 = u.grp * 1024 + u.pn * BM + wc * 32 + 8 * fq;
#pragma unroll
        for (int ai = 0; ai < 2; ++ai)
#pragma unroll
            for (int m = 0; m < 4; ++m) { bf16_t* rowp = Ball + (size_t)(row0 + ai * HALF + m * 16) * 4096 + col0;
#pragma unroll
                for (int bj = 0; bj < 2; ++bj) *(u32x4*)(rowp + bj * HALF) = pack8(acc[ai][bj][m][0], acc[ai][bj][m][1]); }
    }
};
struct EpiGateMerge {
    static constexpr bool PERM = false, AFTER_DRAIN = false;
    const bf16_t* Ball; bf16_t* merged; const float* ssq;
    __device__ __forceinline__ void operator()(const f32x4 (&acc)[2][2][4][2], const Unit& u, int wr, int wc, int fr, int fq) const {
        const int row0 = u.pm * BM + wr * 64 + fr, mc = u.pn * 64 + wc * 16 + 4 * fq;
#pragma unroll
        for (int ai = 0; ai < 2; ++ai)
#pragma unroll
            for (int m = 0; m < 4; ++m) { const int row = row0 + ai * HALF + m * 16; const bf16_t* bp = Ball + (size_t)row * 4096 + mc;
                const float rs = rsqrtf(ssq[row] * (1.f / DM) + NORM_EPS);
                f32x4 s = {0.f, 0.f, 0.f, 0.f};
#pragma unroll
                for (int bj = 0; bj < 2; ++bj)
#pragma unroll
                    for (int n = 0; n < 2; ++n) { const u32x2 bv = *(const u32x2*)(bp + (2 * bj + n) * 1024); const f32x4 gt = acc[ai][bj][m][n] * rs;
                        s[0] += sigm(gt[0]) * bflo(bv.x); s[1] += sigm(gt[1]) * bfhi(bv.x); s[2] += sigm(gt[2]) * bflo(bv.y); s[3] += sigm(gt[3]) * bfhi(bv.y); }
                u32x2 w; w.x = cvt_pk_bf16(s[0], s[1]); w.y = cvt_pk_bf16(s[2], s[3]);
                *(u32x2*)(merged + (size_t)row * DM + mc) = w; }
    }
};

template <class Epi, class Sched, bool ALIGN_EPI = false, bool SP2 = false>
__device__ __forceinline__ void gemm_phase(PG8_LAS unsigned char* lds, const Gemm g, const Sched& S, const Epi& E, int tid_opaque) {
    const int tid = tid_opaque, wid = __builtin_amdgcn_readfirstlane(tid >> 6), lane = tid & 63, wr = wid >> 2, wc = wid & 3, fr = lane & 15, fq = lane >> 4;
    const int K = g.K, nt = K / BK, lda = g.lda, ldb = g.ldb;
    unsigned voffA[2], voffB[2];
#pragma unroll
    for (int i = 0; i < 2; ++i) { int R, C; stage_rc(tid * 16 + i * 8192, R, C); const int Rb = Epi::PERM ? ((R & ~31) + perm32(R & 31)) : R;
        voffA[i] = (unsigned)(R * lda + C) * 2u; voffB[i] = (unsigned)(Rb * ldb + C) * 2u; }
    const size_t kstep = (size_t)(BK * 2);
    const size_t hstepA = (size_t)HALF * lda * 2, hstepB = (size_t)HALF * ldb * 2;

    const unsigned ldsw = (unsigned)wid * 1024u;
    const int aoff = lds_byte(wr * 64 + fr, fq * 8), boff = lds_byte(wc * 32 + fr, fq * 8);
#define PG8_SA(b, h) (((b) * 2 + (h)) * HTB)
#define PG8_SB(b, h) ((4 + (b) * 2 + (h)) * HTB)
#define PG8_STAGE(bufoff, gbase, voff) do { _Pragma("unroll") for (int _i = 0; _i < 2; ++_i) \
        __builtin_amdgcn_global_load_lds((const unsigned*)((const char*)(gbase) + (voff)[_i]), (PG8_LAS unsigned*)(lds + (bufoff) + ldsw + _i * 8192), 16, 0, 0); } while (0)
#define PG8_LDA(dst, b, h) do { _Pragma("unroll") for (int m = 0; m < 4; ++m) _Pragma("unroll") for (int k = 0; k < 2; ++k) dst[m][k] = *(const PG8_LAS bf16x8*)(lds + PG8_SA(b, h) + aoff + m * 2048 + k * 1024); } while (0)
#define PG8_LDB(dst, b, h) do { _Pragma("unroll") for (int n = 0; n < 2; ++n) _Pragma("unroll") for (int k = 0; k < 2; ++k) dst[n][k] = *(const PG8_LAS bf16x8*)(lds + PG8_SB(b, h) + boff + n * 2048 + k * 1024); } while (0)
#define PG8_MMA(ai, bj, At, Bt) do { __builtin_amdgcn_s_setprio(1); _Pragma("unroll") for (int m = 0; m < 4; ++m) _Pragma("unroll") for (int n = 0; n < 2; ++n) _Pragma("unroll") for (int k = 0; k < 2; ++k) \
        acc[ai][bj][m][n] = __builtin_amdgcn_mfma_f32_16x16x32_bf16(Bt[n][k], At[m][k], acc[ai][bj][m][n], 0, 0, 0); __builtin_amdgcn_s_setprio(0); } while (0)
#define PG8_WAIT_V(n) asm volatile("s_waitcnt vmcnt(" #n ")" ::: "memory")
#define PG8_WAIT_L(n) asm volatile("s_waitcnt lgkmcnt(" #n ")" ::: "memory")
#define PG8_BAR __builtin_amdgcn_s_barrier()
#define PG8_SCHED __builtin_amdgcn_sched_barrier(0)
    Unit cur, nxt; int ui = 0;
    if (!S.next(0, cur)) return;
    f32x4 acc[2][2][4][2];
#pragma unroll
    for (int a = 0; a < 2; ++a)
#pragma unroll
        for (int b = 0; b < 2; ++b)
#pragma unroll
            for (int m = 0; m < 4; ++m)
#pragma unroll
                for (int n = 0; n < 2; ++n) acc[a][b][m][n] = (f32x4){0.f, 0.f, 0.f, 0.f};
    bf16x8 At[4][2], B0[2][2], B1[2][2];
    const char* cA = (const char*)g.A + cur.aoff; const char* cB = (const char*)g.Bt + cur.boff;
    S.a_ready(cur);
    if constexpr (SP2) {
        PG8_STAGE(PG8_SB(0, 0), cB, voffB); PG8_STAGE(PG8_SB(0, 1), cB + hstepB, voffB); PG8_STAGE(PG8_SA(0, 0), cA, voffA); PG8_STAGE(PG8_SA(0, 1), cA + hstepA, voffA);
        if (wr == 1) PG8_BAR;
        PG8_WAIT_V(2); PG8_BAR;
        PG8_STAGE(PG8_SB(1, 0), cB + kstep, voffB); PG8_STAGE(PG8_SA(1, 0), cA + kstep, voffA); PG8_STAGE(PG8_SB(1, 1), cB + hstepB + kstep, voffB);
        PG8_WAIT_V(6); PG8_BAR;
    } else {
        PG8_STAGE(PG8_SB(0, 0), cB, voffB); PG8_STAGE(PG8_SA(0, 0), cA, voffA); PG8_STAGE(PG8_SB(0, 1), cB + hstepB, voffB); PG8_STAGE(PG8_SA(0, 1), cA + hstepA, voffA);
        if (wr == 1) PG8_BAR;
        PG8_WAIT_V(4); PG8_BAR;
        PG8_STAGE(PG8_SB(1, 0), cB + kstep, voffB); PG8_STAGE(PG8_SA(1, 0), cA + kstep, voffA); PG8_STAGE(PG8_SB(1, 1), cB + hstepB + kstep, voffB);
        PG8_WAIT_V(6); PG8_BAR;
    }
    for (;;) {
        const bool has_next = S.next(ui + 1, nxt);
        const char* nA = has_next ? (const char*)g.A + nxt.aoff : cA; const char* nB = has_next ? (const char*)g.Bt + nxt.boff : cB;
        for (int t = 0; t < nt; t += 2) {
            const bool last = (t == nt - 2);
            const char* a1 = cA + (size_t)(t + 1) * kstep;
            const char* a2 = last ? nA : cA + (size_t)(t + 2) * kstep; const char* b2 = last ? nB : cB + (size_t)(t + 2) * kstep;
            const char* a3 = a2 + kstep; const char* b3 = b2 + kstep;
            if (last && has_next) S.a_ready(nxt);
            if constexpr (SP2) {
            PG8_LDB(B0, 0, 0); PG8_LDB(B1, 0, 1); PG8_SCHED; PG8_LDA(At, 0, 0); PG8_STAGE(PG8_SA(1, 1), a1 + hstepA, voffA);
            PG8_WAIT_V(8); PG8_WAIT_L(0); PG8_BAR; PG8_MMA(0, 0, At, B0); PG8_MMA(0, 1, At, B1); PG8_BAR; PG8_SCHED;
            PG8_LDA(At, 0, 1); PG8_STAGE(PG8_SB(0, 0), b2, voffB); PG8_STAGE(PG8_SB(0, 1), b2 + hstepB, voffB); PG8_STAGE(PG8_SA(0, 0), a2, voffA);
            PG8_WAIT_V(8); PG8_WAIT_L(0); PG8_BAR; PG8_MMA(1, 0, At, B0); PG8_MMA(1, 1, At, B1); PG8_BAR; PG8_SCHED;
            PG8_LDB(B0, 1, 0); PG8_LDB(B1, 1, 1); PG8_SCHED; PG8_LDA(At, 1, 0); PG8_STAGE(PG8_SA(0, 1), a2 + hstepA, voffA);
            PG8_WAIT_V(8); PG8_WAIT_L(0); PG8_BAR; PG8_MMA(0, 0, At, B0); PG8_MMA(0, 1, At, B1); PG8_BAR; PG8_SCHED;
            PG8_LDA(At, 1, 1); PG8_STAGE(PG8_SB(1, 0), b3, voffB); PG8_STAGE(PG8_SB(1, 1), b3 + hstepB, voffB); PG8_STAGE(PG8_SA(1, 0), a3, voffA);
            PG8_WAIT_V(8); PG8_WAIT_L(0); PG8_BAR; PG8_MMA(1, 0, At, B0); PG8_MMA(1, 1, At, B1); PG8_BAR; PG8_SCHED;
            } else {
            PG8_LDB(B0, 0, 0); PG8_SCHED; PG8_LDA(At, 0, 0); PG8_STAGE(PG8_SA(1, 1), a1 + hstepA, voffA);
            PG8_WAIT_L(8); PG8_BAR; PG8_WAIT_L(0); PG8_MMA(0, 0, At, B0); PG8_BAR; PG8_SCHED;
            PG8_LDB(B1, 0, 1); PG8_STAGE(PG8_SB(0, 0), b2, voffB);
            PG8_BAR; PG8_WAIT_L(0); PG8_MMA(0, 1, At, B1); PG8_BAR;
            PG8_LDA(At, 0, 1); PG8_STAGE(PG8_SA(0, 0), a2, voffA);
            PG8_BAR; PG8_WAIT_L(0); PG8_MMA(1, 0, At, B0); PG8_BAR; PG8_SCHED;
            PG8_STAGE(PG8_SB(0, 1), b2 + hstepB, voffB);
            PG8_WAIT_V(6); PG8_BAR; PG8_MMA(1, 1, At, B1); PG8_BAR;
            PG8_LDB(B0, 1, 0); PG8_SCHED; PG8_LDA(At, 1, 0); PG8_STAGE(PG8_SA(0, 1), a2 + hstepA, voffA);
            PG8_WAIT_L(8); PG8_BAR; PG8_WAIT_L(0); PG8_MMA(0, 0, At, B0); PG8_BAR; PG8_SCHED;
            PG8_LDB(B1, 1, 1); PG8_STAGE(PG8_SB(1, 0), b3, voffB);
            PG8_BAR; PG8_WAIT_L(0); PG8_MMA(0, 1, At, B1); PG8_BAR;
            PG8_LDA(At, 1, 1); PG8_STAGE(PG8_SA(1, 0), a3, voffA);
            PG8_BAR; PG8_WAIT_L(0); PG8_MMA(1, 0, At, B0); PG8_BAR; PG8_SCHED;
            PG8_STAGE(PG8_SB(1, 1), b3 + hstepB, voffB);
            PG8_WAIT_V(6); PG8_BAR; PG8_MMA(1, 1, At, B1); PG8_BAR;
            }
        }
        if constexpr (ALIGN_EPI) { if (wr == 0) PG8_BAR; }
        if constexpr (!Epi::AFTER_DRAIN) { int fr_ = fr, fq_ = fq; asm volatile("" : "+v"(fr_), "+v"(fq_)); E(acc, cur, wr, wc, fr_, fq_); S.done(cur); }
        if (!has_next) break;
#pragma unroll
        for (int a = 0; a < 2; ++a)
#pragma unroll
            for (int b = 0; b < 2; ++b)
#pragma unroll
                for (int m = 0; m < 4; ++m)
#pragma unroll
                    for (int n = 0; n < 2; ++n) acc[a][b][m][n] = (f32x4){0.f, 0.f, 0.f, 0.f};
        cur = nxt; cA = nA; cB = nB; ++ui;
        if constexpr (ALIGN_EPI) { if (wr == 1) PG8_BAR; }
    }
    PG8_WAIT_V(0);
    if constexpr (!ALIGN_EPI) { if (wr == 0) PG8_BAR; }
    PG8_BAR;
    if constexpr (Epi::AFTER_DRAIN) { E.fused(acc, cur, wr, wc, fr, fq, lds, wid, lane); S.done(cur); }
#undef PG8_SA
#undef PG8_SB
#undef PG8_STAGE
#undef PG8_LDA
#undef PG8_LDB
#undef PG8_MMA
#undef PG8_WAIT_V
#undef PG8_WAIT_L
#undef PG8_BAR
#undef PG8_SCHED
}

}

constexpr size_t MiB = 1u << 20;
constexpr size_t WS_CTL = 0;
constexpr size_t WS_SSQ = 64 * 1024;
constexpr size_t WS_ROPE = 1 * MiB;
constexpr size_t WS_LSE = 3 * MiB;
constexpr size_t WS_HGD = 4 * MiB;
constexpr size_t WS_A32 = WS_HGD + 768 * 1024;
constexpr size_t WS_S5E = 5 * MiB;
constexpr size_t WS_W = 13 * MiB;
constexpr size_t W_GU1 = WS_W, W_D1 = W_GU1 + 11 * MiB, W_GU2 = W_D1 + 11 * MiB / 2, W_D2 = W_GU2 + 11 * MiB;
constexpr size_t W_C1 = WS_W + 33 * MiB, W_C2 = W_C1 + 7 * MiB, W_GATE = W_C2 + 9 * MiB, W_BR = W_GATE + 8 * MiB, W_OUT = W_BR + 4 * MiB, W_GLU = W_OUT + 2 * MiB;
constexpr size_t W_S5M = W_GLU + 1 * MiB, W_S5E = W_S5M + 20 * MiB;
constexpr size_t WS_XN = 105 * MiB;
constexpr size_t WS_Y = 137 * MiB;
constexpr size_t WS_MERGED = 201 * MiB;
constexpr size_t WS_R = 233 * MiB;
constexpr size_t R_HQ = WS_R, R_S5A = WS_R + 64 * MiB, R_CONV = WS_R + 84 * MiB, R_HST = WS_R + 116 * MiB;
constexpr size_t R_QKV = WS_R, R_HBUF = WS_R, R_BALL = WS_R;
constexpr size_t WS_END = 381 * MiB;
static_assert(W_S5E + 8 * MiB <= WS_XN && W_D2 + 11 * MiB / 2 <= W_C1, "weight map");
constexpr size_t QKV_WHICH = (size_t)24 * SEQ * 128;

constexpr int LDS_BYTES = 151552;
constexpr int NWAVES = 8, NTHREADS = 512;

struct Args { const float* in[30]; float* out; unsigned char* ws; int ph_lo, ph_hi; };

struct Ctx {
    LAS unsigned char* lds; int tid, lane, wave, G, bid, zo;
    const float* const* in; float* out; unsigned char* ws;
};
#define INP(c, k) ((c).in[(k) + (c).zo])

template <int MT, int NT, int KT>
__device__ __forceinline__ void wave_mma(f32x4 (&acc)[MT][NT], const LAS bf16_t* A, int lda, const LAS bf16_t* Bt, int ldb, int lane) {
    const int r = lane & 15, q = lane >> 4;
#pragma unroll
    for (int kk = 0; kk < KT; ++kk) {
        bf16x8 a[MT], b[NT];
#pragma unroll
        for (int mt = 0; mt < MT; ++mt) a[mt] = *(const LAS bf16x8*)(A + (mt * 16 + r) * lda + kk * 32 + q * 8);
#pragma unroll
        for (int nt = 0; nt < NT; ++nt) b[nt] = *(const LAS bf16x8*)(Bt + (nt * 16 + r) * ldb + kk * 32 + q * 8);
#pragma unroll
        for (int mt = 0; mt < MT; ++mt)
#pragma unroll
            for (int nt = 0; nt < NT; ++nt) acc[mt][nt] = __builtin_amdgcn_mfma_f32_16x16x32_bf16(a[mt], b[nt], acc[mt][nt], 0, 0, 0);
    }
}

__device__ __forceinline__ int rowmap(int kind, int n) {
    if (kind == 0) return n;
    if (kind == 1) return 256 * (n >> 7) + (n & 127);
    if (kind == 2) return 256 * (n >> 7) + 128 + (n & 127);
    const int k = n >> 10, mcol = n & 1023, pn = mcol >> 6, ml = mcol & 63, wc = ml >> 4, fq = (ml & 15) >> 2, i = ml & 3;
    return pn * 256 + 128 * (k >> 1) + 32 * wc + 16 * (k & 1) + 4 * fq + i;
}
__device__ __forceinline__ void transpose_item(const float* W, int ldw, int col0, int K, int Ncols, bf16_t* dst, const float* gain, int kind, LAS float* scr, int item, int lane) {
    const int nblk = Ncols / 32, kb = item / nblk, nb = item % nblk, k0 = 64 * kb, n0 = 32 * nb;
    float v[32];
#pragma unroll
    for (int i = 0; i < 32; ++i) v[i] = W[(size_t)(k0 + 2 * i + (lane >> 5)) * ldw + col0 + n0 + (lane & 31)];
    if (gain) {
#pragma unroll
        for (int i = 0; i < 32; ++i) v[i] *= gain[k0 + 2 * i + (lane >> 5)]; }
#pragma unroll
    for (int i = 0; i < 32; ++i) scr[(2 * i + (lane >> 5)) * 33 + (lane & 31)] = v[i];
    LDS_WAIT(); asm volatile("" ::: "memory");
    const int c = lane & 7;
#pragma unroll
    for (int j = 0; j < 4; ++j) { const int n = (lane >> 3) + 8 * j; const LAS float* s = scr + (8 * c) * 33 + n;
        u32x4 o; o.x = pk2(s[0 * 33], s[1 * 33]); o.y = pk2(s[2 * 33], s[3 * 33]); o.z = pk2(s[4 * 33], s[5 * 33]); o.w = pk2(s[6 * 33], s[7 * 33]);
        *(u32x4*)(dst + (size_t)rowmap(kind, n0 + n) * K + k0 + 8 * c) = o; }
    LDS_WAIT(); asm volatile("" ::: "memory");
}

__device__ __forceinline__ void s5_tables(const Ctx& c, int l, int g, int part) {
    LAS float* pwr = (LAS float*)c.lds; LAS float* pwi = pwr + 2112; LAS float* bbr = pwi + 2112; LAS float* bbi = bbr + 1024;
    LAS float* crT = bbi + 1024; LAS float* ciT = crT + 1024; LAS float* Kj = ciT + 1024;
    const int lg = l * 32 + g, tid = c.tid;
    const float* a_re = INP(c, 10) + lg * 64; const float* a_im = INP(c, 11) + lg * 64; const float* log_dt = INP(c, 12) + lg;
    const float* b_re = INP(c, 13) + (size_t)lg * 1024; const float* b_im = INP(c, 14) + (size_t)lg * 1024;
    const float* c_re = INP(c, 15) + (size_t)lg * 1024; const float* c_im = INP(c, 16) + (size_t)lg * 1024;
    if (tid < 64) {
        const int p = tid; const float dtf = expf(log_dt[0]), arf = a_re[p], aif = a_im[p], magf = expf(arf * dtf);
        const double ar = arf, ai = aif, abr = (double)(magf * cosf(aif * dtf)), abi = (double)(magf * sinf(aif * dtf)), den = ar * ar + ai * ai;
        const double zr = ((abr - 1.0) * ar + abi * ai) / den, zi = (abi * ar - (abr - 1.0) * ai) / den;
        double pr = 1.0, pi = 0.0;
        for (int j = 0; j <= 32; ++j) { pwr[p * 33 + j] = (float)pr; pwi[p * 33 + j] = (float)pi; const double nr = pr * abr - pi * abi, ni = pr * abi + pi * abr; pr = nr; pi = ni; }
        if (part == 0) { float* a32 = (float*)(c.ws + WS_A32) + (g * 64 + p) * 2; a32[0] = pwr[p * 33 + 32]; a32[1] = pwi[p * 33 + 32]; }
        for (int k = 0; k < 16; ++k) { const double br = b_re[p * 16 + k], bi = b_im[p * 16 + k]; bbr[p * 16 + k] = (float)(zr * br - zi * bi); bbi[p * 16 + k] = (float)(zr * bi + zi * br); }
    }
    for (int i = tid; i < 1024; i += NTHREADS) { const int cc = i >> 6, p = i & 63; crT[p * 16 + cc] = c_re[i]; ciT[p * 16 + cc] = c_im[i]; }
    __syncthreads();
    {
        const int j = tid >> 4, c2 = tid & 15; float acc[16];
#pragma unroll
        for (int cc = 0; cc < 16; ++cc) acc[cc] = 0.f;
        for (int p = 0; p < 64; ++p) { const float ar = pwr[p * 33 + j], ai = pwi[p * 33 + j], br = bbr[p * 16 + c2], bi = bbi[p * 16 + c2];
            const float xr = ar * br - ai * bi, xi = ar * bi + ai * br;
#pragma unroll
            for (int q4 = 0; q4 < 4; ++q4) { const f32x4 cr4 = *(const LAS f32x4*)(crT + p * 16 + 4 * q4), ci4 = *(const LAS f32x4*)(ciT + p * 16 + 4 * q4);
#pragma unroll
                for (int e = 0; e < 4; ++e) acc[4 * q4 + e] += cr4[e] * xr - ci4[e] * xi; } }
#pragma unroll
        for (int cc = 0; cc < 16; ++cc) Kj[j * 256 + cc * 16 + c2] = acc[cc];
    }
    __syncthreads();
    bf16_t* dm = (bf16_t*)(c.ws + W_S5M) + (size_t)g * 512 * 640;
    for (int ch = tid; ch < 64 * 80; ch += NTHREADS) { const int row = part * 64 + ch / 80, cch = ch % 80, t = row >> 4, cc = row & 15, col0 = cch * 8; float v[8];
        if (col0 < 64) {
#pragma unroll
            for (int e = 0; e < 8; ++e) { const int p = col0 + e; v[e] = crT[p * 16 + cc] * pwr[p * 33 + t + 1] - ciT[p * 16 + cc] * pwi[p * 33 + t + 1]; }
        } else if (col0 < 128) {
#pragma unroll
            for (int e = 0; e < 8; ++e) { const int p = col0 - 64 + e; v[e] = -(crT[p * 16 + cc] * pwi[p * 33 + t + 1] + ciT[p * 16 + cc] * pwr[p * 33 + t + 1]); }
        } else { const int s = (col0 - 128) >> 4, cb = (col0 - 128) & 15;
#pragma unroll
            for (int e = 0; e < 8; ++e) v[e] = (s <= t) ? Kj[(t - s) * 256 + cc * 16 + cb + e] : 0.f;
        }
        u32x4 o; o.x = pk2(v[0], v[1]); o.y = pk2(v[2], v[3]); o.z = pk2(v[4], v[5]); o.w = pk2(v[6], v[7]);
        *(u32x4*)(dm + (size_t)row * 640 + col0) = o; }
    bf16_t* de = (bf16_t*)(c.ws + W_S5E) + (size_t)g * 256 * 512;
    for (int ch = tid; ch < 32 * 64; ch += NTHREADS) { const int row = part * 32 + (ch >> 6), col0 = (ch & 63) * 8, s = col0 >> 4, cb = col0 & 15; float v[8];
#pragma unroll
        for (int e = 0; e < 8; ++e) {
            if (row < 64) { const int p = row; v[e] = pwr[p * 33 + 31 - s] * bbr[p * 16 + cb + e] - pwi[p * 33 + 31 - s] * bbi[p * 16 + cb + e]; }
            else if (row < 128) { const int p = row - 64; v[e] = pwr[p * 33 + 31 - s] * bbi[p * 16 + cb + e] + pwi[p * 33 + 31 - s] * bbr[p * 16 + cb + e]; }
            else v[e] = 0.f; }
        u32x4 o; o.x = pk2(v[0], v[1]); o.y = pk2(v[2], v[3]); o.z = pk2(v[4], v[5]); o.w = pk2(v[6], v[7]);
        *(u32x4*)(de + (size_t)row * 512 + col0) = o; }
    __syncthreads();
}

__device__ __forceinline__ void phase_wprep(const Ctx& c, int l) {
    for (int u = c.bid; u < 256; u += c.G) s5_tables(c, l, u >> 3, u & 7);
    if (l == 0) {
        const int* pos = (const int*)INP(c, 1); f32x2* rope = (f32x2*)(c.ws + WS_ROPE);
        for (int e = c.bid * NTHREADS + c.tid; e < TOK * 16; e += c.G * NTHREADS) { const int tok = e >> 4, i = e & 15;
            const float ang = (float)pos[tok] * exp2f(-1.1832230355827609f * (float)i); rope[e] = (f32x2){cosf(ang), sinf(ang)}; }
    }
    __syncthreads();
    LAS float* scr = (LAS float*)(c.lds + c.wave * 16384);
    const int gw = c.bid * NWAVES + c.wave, NGW = c.G * NWAVES;
    const float* n1 = INP(c, 2) + l * DM; const float* nm = INP(c, 6) + l * DM; const float* n2 = INP(c, 25) + l * DM;
    const float* wg1 = INP(c, 3) + (size_t)l * DM * DFF; const float* wu1 = INP(c, 4) + (size_t)l * DM * DFF; const float* wd1 = INP(c, 5) + (size_t)l * DFF * DM;
    const float* wg2 = INP(c, 26) + (size_t)l * DM * DFF; const float* wu2 = INP(c, 27) + (size_t)l * DM * DFF; const float* wd2 = INP(c, 28) + (size_t)l * DFF * DM;
    const float* win = INP(c, 7) + (size_t)l * DM * INW; const float* wbr = INP(c, 23) + (size_t)l * 4 * 512 * DM; const float* wout = INP(c, 24) + (size_t)l * DM * DM;
    const float* wglu = INP(c, 18) + (size_t)l * 512 * 1024;
    unsigned char* ws = c.ws;
    for (int it = gw; it < 16384; it += NGW) {
        int r = it;
        if (r < 1408) { transpose_item(wg1, DFF, 0, DM, DFF, (bf16_t*)(ws + W_GU1), n1, 1, scr, r, c.lane); continue; } r -= 1408;
        if (r < 1408) { transpose_item(wu1, DFF, 0, DM, DFF, (bf16_t*)(ws + W_GU1), n1, 2, scr, r, c.lane); continue; } r -= 1408;
        if (r < 1408) { transpose_item(wd1, DM, 0, DFF, DM, (bf16_t*)(ws + W_D1), nullptr, 0, scr, r, c.lane); continue; } r -= 1408;
        if (r < 1408) { transpose_item(wg2, DFF, 0, DM, DFF, (bf16_t*)(ws + W_GU2), n2, 1, scr, r, c.lane); continue; } r -= 1408;
        if (r < 1408) { transpose_item(wu2, DFF, 0, DM, DFF, (bf16_t*)(ws + W_GU2), n2, 2, scr, r, c.lane); continue; } r -= 1408;
        if (r < 1408) { transpose_item(wd2, DM, 0, DFF, DM, (bf16_t*)(ws + W_D2), nullptr, 0, scr, r, c.lane); continue; } r -= 1408;
        if (r < 1792) { transpose_item(win, INW, 0, DM, 3584, (bf16_t*)(ws + W_C1), nm, 0, scr, r, c.lane); continue; } r -= 1792;
        if (r < 2304) { transpose_item(win, INW, 3584, DM, 4608, (bf16_t*)(ws + W_C2), nm, 0, scr, r, c.lane); continue; } r -= 2304;
        if (r < 2048) { transpose_item(win, INW, 8192, DM, 4096, (bf16_t*)(ws + W_GATE), nm, 3, scr, r, c.lane); continue; } r -= 2048;
        if (r < 1024) { const int k = r >> 8; transpose_item(wbr + (size_t)k * 512 * DM, DM, 0, 512, DM, (bf16_t*)(ws + W_BR) + (size_t)k * 1024 * 512, nullptr, 0, scr, r & 255, c.lane); continue; } r -= 1024;
        if (r < 512) { transpose_item(wout, DM, 0, DM, DM, (bf16_t*)(ws + W_OUT), nullptr, 0, scr, r, c.lane); continue; } r -= 512;
        if (r < 128) { transpose_item(wglu, 1024, 0, 512, 512, (bf16_t*)(ws + W_GLU), nullptr, 1, scr, r, c.lane); continue; } r -= 128;
        transpose_item(wglu, 1024, 512, 512, 512, (bf16_t*)(ws + W_GLU), nullptr, 2, scr, r, c.lane);
    }
}

__device__ __forceinline__ void phase_norm_in(const Ctx& c, const float* x, bf16_t* xn, float* ssq) {
    const int gw = c.bid * NWAVES + c.wave, NGW = c.G * NWAVES;
    for (int row = gw; row < TOK; row += NGW) {
        const f32x4* xr = (const f32x4*)(x + (size_t)row * DM) + c.lane; f32x4 v[4]; float s = 0.f;
#pragma unroll
        for (int j = 0; j < 4; ++j) { v[j] = xr[64 * j]; s += (v[j][0] * v[j][0] + v[j][1] * v[j][1]) + (v[j][2] * v[j][2] + v[j][3] * v[j][3]); }
        s = wave_sum(s); if (c.lane == 0) ssq[row] = s;
        u32x2* o = (u32x2*)(xn + (size_t)row * DM) + c.lane;
#pragma unroll
        for (int j = 0; j < 4; ++j) { u32x2 w; w.x = pk2(v[j][0], v[j][1]); w.y = pk2(v[j][2], v[j][3]); o[64 * j] = w; }
    }
}
__device__ __forceinline__ void phase_final_norm(const Ctx& c, float* x, const float* gain, const float* ssq) {
    const int gw = c.bid * NWAVES + c.wave, NGW = c.G * NWAVES;
    for (int row = gw; row < TOK; row += NGW) {
        f32x4* xr = (f32x4*)(x + (size_t)row * DM) + c.lane; const float rs = rsqrtf(ssq[row] * (1.f / DM) + NORM_EPS);
#pragma unroll
        for (int j = 0; j < 4; ++j) { const f32x4 gn = ((const f32x4*)gain)[c.lane + 64 * j]; xr[64 * j] = xr[64 * j] * rs * gn; }
    }
}

__device__ __forceinline__ void phase_conv(const Ctx& c, int l) {
    LAS float* z = (LAS float*)c.lds; LAS float* red = z + 62 * 512;
    const bf16_t* cin = (const bf16_t*)(c.ws + R_CONV); bf16_t* yc = (bf16_t*)(c.ws + WS_Y) + (size_t)2 * TOK * 512;
    const int ch = c.tid;
    const float* cw = INP(c, 19) + (size_t)l * 31 * 512; const float cb = INP(c, 20)[l * 512 + ch], lg = INP(c, 21)[l * 512 + ch], lb = INP(c, 22)[l * 512 + ch];
    float w[31];
#pragma unroll
    for (int j = 0; j < 31; ++j) w[j] = cw[j * 512 + ch];
    for (int unit = c.bid; unit < TOK / 32; unit += c.G) {
        const int b = unit >> 8, t0 = (unit & 255) * 32;
        for (int r = 0; r < 62; ++r) { const int t = t0 - 30 + r; float v = 0.f;
            if (t >= 0) { const bf16_t* rp = cin + (size_t)(b * SEQ + t) * 1024; v = bf2f(rp[ch]) * sigm(bf2f(rp[512 + ch])); }
            z[r * 512 + ch] = v; }
        __syncthreads();
#pragma unroll 1
        for (int blk = 0; blk < 4; ++blk) {
            float zr[38];
#pragma unroll
            for (int i = 0; i < 38; ++i) zr[i] = z[(blk * 8 + i) * 512 + ch];
            float o[8];
#pragma unroll
            for (int tt = 0; tt < 8; ++tt) { float a = cb;
#pragma unroll
                for (int j = 0; j < 31; ++j) a += w[j] * zr[tt + j];
                o[tt] = a; }
            LAS float* rb = red + (blk & 1) * 128;
#pragma unroll
            for (int tt = 0; tt < 8; ++tt) { const float s1 = wave_sum(o[tt]), s2 = wave_sum(o[tt] * o[tt]); if (c.lane == 0) { rb[c.wave * 16 + tt * 2] = s1; rb[c.wave * 16 + tt * 2 + 1] = s2; } }
            __syncthreads();
#pragma unroll
            for (int tt = 0; tt < 8; ++tt) { float s1 = 0.f, s2 = 0.f;
#pragma unroll
                for (int wv = 0; wv < 8; ++wv) { s1 += rb[wv * 16 + tt * 2]; s2 += rb[wv * 16 + tt * 2 + 1]; }
                const float mean = s1 * (1.f / 512.f), var = fmaxf(s2 * (1.f / 512.f) - mean * mean, 0.f), rstd = 1.f / sqrtf(var + NORM_EPS);
                const float y = (o[tt] - mean) * rstd * lg + lb;
                yc[(size_t)(b * SEQ + t0 + blk * 8 + tt) * 512 + ch] = (bf16_t)f2bf(siluf(y)); }
        }
        __syncthreads();
    }
}
#define XB_TMO      128
#define XB_XCNT(j)  (256  + 64 * (j))
#define XB_XSUB(j)  (1280 + 64 * (j))
#define XB_XGEN(j)  (2304 + 64 * (j))
#define XB_TOP      3328
#define XB_TOPGEN   3392
#define XCD_BAR_WORDS 3456
#define XB_SPIN_CAP (1u << 18)

__device__ __forceinline__ unsigned xb_ld(unsigned* p)              { return __hip_atomic_load(p, __ATOMIC_RELAXED, __HIP_MEMORY_SCOPE_AGENT); }
__device__ __forceinline__ unsigned xb_add(unsigned* p, unsigned v) { return __hip_atomic_fetch_add(p, v, __ATOMIC_RELAXED, __HIP_MEMORY_SCOPE_AGENT); }
__device__ __forceinline__ unsigned xb_xcc_id() { return (unsigned)__builtin_amdgcn_s_getreg((3 << 11) | 20) & 0xFu; }
#define XB_SPIN(cond, bar) do { unsigned _sp = 0; while (cond) { __builtin_amdgcn_s_sleep(1); \
    if ((++_sp & 255u) == 0u) { if (xb_ld(&(bar)[XB_TMO])) break; if (_sp > XB_SPIN_CAP) { atomicAdd(&(bar)[XB_TMO], 1u); break; } } } } while (0)

struct XcdBarrier {
    unsigned* bar; unsigned x;
    volatile LAS unsigned* st;
};

__device__ __forceinline__ XcdBarrier xcd_barrier_post(unsigned* bar, volatile LAS unsigned* st) {
    XcdBarrier b; b.bar = bar; b.x = xb_xcc_id(); b.st = st;
    if (threadIdx.x == 0) (void)xb_add(&bar[XB_XCNT(b.x)], 1u);
    return b;
}
__device__ __forceinline__ void xcd_barrier_complete(unsigned* bar, unsigned x, unsigned& nloc, unsigned& nx) {
    const unsigned G = gridDim.x * gridDim.y * gridDim.z;
    unsigned sum, cnt, mine, sp = 0u;
    for (;;) {
        sum = 0u; cnt = 0u; mine = 0u;
#pragma unroll
        for (unsigned j = 0; j < 16; ++j) { const unsigned c = xb_ld(&bar[XB_XCNT(j)]); sum += c; cnt += (c > 0u) ? 1u : 0u; mine = (j == x) ? c : mine; }
        if (sum == G) break;
        __builtin_amdgcn_s_sleep(1);
        if ((++sp & 255u) == 0u) { if (xb_ld(&bar[XB_TMO])) break; if (sp > XB_SPIN_CAP) { atomicAdd(&bar[XB_TMO], 1u); break; } }
    }
    nloc = mine > 0u ? mine : 1u; nx = cnt > 0u ? cnt : 1u;
}

__device__ __forceinline__ void xcd_barrier(const XcdBarrier& b) {
    asm volatile("s_waitcnt vmcnt(0)" ::: "memory");
    __syncthreads();
    if (threadIdx.x == 0) {
        unsigned* bar = b.bar;
        __builtin_amdgcn_s_waitcnt(0);
        unsigned nloc = b.st[0], nx = b.st[1];
        if (nloc == 0u) { xcd_barrier_complete(bar, b.x, nloc, nx); b.st[0] = nloc; b.st[1] = nx; }
        const unsigned old = xb_add(&bar[XB_XSUB(b.x)], 1u);
        const unsigned gen = old / nloc;
        if (old + 1u == (gen + 1u) * nloc) {
            __builtin_amdgcn_fence(__ATOMIC_RELEASE, "agent");
            asm volatile("s_waitcnt vmcnt(0)" ::: "memory");
            const unsigned og = xb_add(&bar[XB_TOP], 1u);
            const unsigned tg = og / nx;
            if (og + 1u == (tg + 1u) * nx) xb_add(&bar[XB_TOPGEN], 1u);
            else XB_SPIN(xb_ld(&bar[XB_TOPGEN]) == tg, bar);
            __builtin_amdgcn_fence(__ATOMIC_ACQUIRE, "agent");
            xb_add(&bar[XB_XGEN(b.x)], 1u);
            asm volatile("s_waitcnt vmcnt(0)" ::: "memory");
        } else {
            XB_SPIN(xb_ld(&bar[XB_XGEN(b.x)]) == gen, bar);
            __builtin_amdgcn_fence(__ATOMIC_ACQUIRE, "agent");
            asm volatile("s_waitcnt vmcnt(0)" ::: "memory");
        }
    }
    __syncthreads();
}

__device__ __forceinline__ float hg_lb(const Ctx& c, int l, int col) {
    if (l == 0) return 0.f;
    const float z0 = INP(c, 8)[col], z1 = INP(c, 8)[512 + col], m = fmaxf(z0, z1), e0 = expf(z0 - m), e1 = expf(z1 - m);
    return e1 / (e0 + e1);
}
__device__ __forceinline__ void hg_logf(const bf16_t* hf, int row0, int col, float lbv, int k, int rg, LAS float* bL, LAS float* seg, float (&kk)[16]) {
    float run = 0.f;
#pragma unroll
    for (int j = 0; j < 16; ++j) { const int s = rg * 16 + j; const float f = bf2f(hf[(size_t)(row0 + s) * 512 + col]);
        const float ex = expf(-f), sg = 1.f / (1.f + ex);
        const float lf = (lbv == 0.f) ? -log1pf(ex) : logf(lbv + (1.f - lbv) * sg);
        kk[j] = (1.f - lbv) * ex * sg; run += lf; bL[s * 129 + k] = run; }
    seg[rg * 128 + k] = run;
}
__device__ __forceinline__ void hg_load_vT(const bf16_t* hv, int row0, int col, int k, int rg, LAS bf16_t* vT) {
    unsigned w[8];
#pragma unroll
    for (int j = 0; j < 8; ++j) { const unsigned lo = hv[(size_t)(row0 + rg * 16 + 2 * j) * 512 + col], hi = hv[(size_t)(row0 + rg * 16 + 2 * j + 1) * 512 + col]; w[j] = lo | (hi << 16); }
    LAS u32x4* d = (LAS u32x4*)(vT + k * 72 + rg * 16);
    d[0] = (u32x4){w[0], w[1], w[2], w[3]}; d[1] = (u32x4){w[4], w[5], w[6], w[7]};
}
constexpr int HG1_KDT = 35072, HG1_VT = 53504;
__device__ __forceinline__ void phase_hg1(const Ctx& c, int l) {
    LAS float* bL = (LAS float*)c.lds; LAS float* seg = bL + 64 * 129;
    LAS bf16_t* kdT = (LAS bf16_t*)(c.lds + HG1_KDT); LAS bf16_t* vT = (LAS bf16_t*)(c.lds + HG1_VT);
    const bf16_t* hf = (const bf16_t*)(c.ws + R_HQ) + (size_t)TOK * 512; const bf16_t* hv = hf + (size_t)TOK * 512;
    bf16_t* hst = (bf16_t*)(c.ws + R_HST); float* hgd = (float*)(c.ws + WS_HGD);
    const int k = c.tid & 127, rg = c.tid >> 7, r = c.lane & 15, q = c.lane >> 4;
    for (int unit = c.bid; unit < 1024; unit += c.G) {
        const int b = unit >> 9, n = (unit >> 2) & 127, h = unit & 3, row0 = b * SEQ + n * 64, col = h * 128 + k;
        const float lbv = hg_lb(c, l, col);
        float kk[16];
        hg_logf(hf, row0, col, lbv, k, rg, bL, seg, kk);
        hg_load_vT(hv, row0, col, k, rg, vT);
        __syncthreads();
        float pre = 0.f;
        for (int s = 0; s < rg; ++s) pre += seg[s * 128 + k];
        const float blast = (seg[k] + seg[128 + k]) + (seg[256 + k] + seg[384 + k]);
        unsigned w[8];
#pragma unroll
        for (int j = 0; j < 8; ++j) { const int s = rg * 16 + 2 * j;
            const float b0 = bL[s * 129 + k] + pre, b1 = bL[(s + 1) * 129 + k] + pre;
            w[j] = pk2(kk[2 * j] * expf(blast - b0), kk[2 * j + 1] * expf(blast - b1)); }
        { LAS u32x4* d = (LAS u32x4*)(kdT + k * 72 + rg * 16); d[0] = (u32x4){w[0], w[1], w[2], w[3]}; d[1] = (u32x4){w[4], w[5], w[6], w[7]}; }
        if (rg == 0) hgd[unit * 128 + k] = expf(blast);
        __syncthreads();
        f32x4 acc[1][8];
#pragma unroll
        for (int nt = 0; nt < 8; ++nt) acc[0][nt] = (f32x4){0.f, 0.f, 0.f, 0.f};
        wave_mma<1, 8, 2>(acc, vT + (16 * c.wave) * 72, 72, kdT, 72, c.lane);
        bf16_t* dst = hst + (size_t)unit * 16384;
#pragma unroll
        for (int nt = 0; nt < 8; ++nt)
#pragma unroll
            for (int j = 0; j < 4; ++j) dst[(16 * c.wave + 4 * q + j) * 128 + nt * 16 + r] = (bf16_t)f2bf(acc[0][nt][j]);
        __syncthreads();
    }
}
__device__ __forceinline__ void phase_hg2(const Ctx& c) {
    bf16_t* hst = (bf16_t*)(c.ws + R_HST); const float* hgd = (const float*)(c.ws + WS_HGD);
    for (int idx = c.bid * NTHREADS + c.tid; idx < 65536; idx += c.G * NTHREADS) {
        const int bh = idx >> 13, e2 = idx & 8191, b = bh >> 2, h = bh & 3, kc = (e2 * 2) & 127;
        float s0 = 0.f, s1 = 0.f;
        for (int n0 = 0; n0 < 128; n0 += 8) {
            unsigned u[8]; f32x2 d[8];
#pragma unroll
            for (int i = 0; i < 8; ++i) { const int unit = (b * 128 + n0 + i) * 4 + h; u[i] = ((const unsigned*)(hst + (size_t)unit * 16384))[e2]; d[i] = *(const f32x2*)(hgd + unit * 128 + kc); }
#pragma unroll
            for (int i = 0; i < 8; ++i) { const int unit = (b * 128 + n0 + i) * 4 + h; ((unsigned*)(hst + (size_t)unit * 16384))[e2] = pk2(s0, s1);
                s0 = d[i][0] * s0 + bflo(u[i]); s1 = d[i][1] * s1 + bfhi(u[i]); }
        }
    }
}
constexpr int HG3_QD = 35072, HG3_ST = 52480, HG3_QT = 87296, HG3_KT = 104704, HG3_P = 122112, HG3_VT = 131328;
static_assert(HG3_VT + 128 * 72 * 2 <= LDS_BYTES, "hg3 LDS map");
__device__ __forceinline__ void phase_hg3(const Ctx& c, int l) {
    LAS float* bL = (LAS float*)c.lds; LAS float* seg = bL + 64 * 129;
    LAS bf16_t* qd = (LAS bf16_t*)(c.lds + HG3_QD); LAS bf16_t* ST = (LAS bf16_t*)(c.lds + HG3_ST); LAS bf16_t* qt = (LAS bf16_t*)(c.lds + HG3_QT);
    LAS bf16_t* kt = (LAS bf16_t*)(c.lds + HG3_KT); LAS bf16_t* P = (LAS bf16_t*)(c.lds + HG3_P); LAS bf16_t* vT = (LAS bf16_t*)(c.lds + HG3_VT);
    const bf16_t* hq = (const bf16_t*)(c.ws + R_HQ); const bf16_t* hf = hq + (size_t)TOK * 512; const bf16_t* hv = hf + (size_t)TOK * 512; const bf16_t* hg = hv + (size_t)TOK * 512;
    const bf16_t* hst = (const bf16_t*)(c.ws + R_HST); bf16_t* ya = (bf16_t*)(c.ws + WS_Y);
    const float* gnorm = INP(c, 9) + l * 512;
    const int k = c.tid & 127, rg = c.tid >> 7, r = c.lane & 15, q = c.lane >> 4, w = c.wave;
    for (int unit = c.bid; unit < 1024; unit += c.G) {
        const int b = unit >> 9, n = (unit >> 2) & 127, h = unit & 3, row0 = b * SEQ + n * 64, col = h * 128 + k;
        const float lbv = hg_lb(c, l, col);
        float kk[16];
        hg_logf(hf, row0, col, lbv, k, rg, bL, seg, kk);
        hg_load_vT(hv, row0, col, k, rg, vT);
#pragma unroll
        for (int i = 0; i < 4; ++i) { const int id = c.tid + NTHREADS * i, v = id >> 4, cc = id & 15;
            *(LAS u32x4*)(ST + v * 136 + cc * 8) = *(const u32x4*)(hst + (size_t)unit * 16384 + v * 128 + cc * 8); }
        __syncthreads();
        float pre = 0.f;
        for (int s = 0; s < rg; ++s) pre += seg[s * 128 + k];
        const float bref = bL[31 * 129 + k] + seg[k];
#pragma unroll
        for (int j = 0; j < 16; ++j) { const int s = rg * 16 + j; const float bv = bL[s * 129 + k] + pre;
            const float qf = siluf(bf2f(hq[(size_t)(row0 + s) * 512 + col])) * 0.08838834764831845f;
            qd[s * 136 + k] = (bf16_t)f2bf(qf * expf(bv));
            qt[s * 136 + k] = (bf16_t)f2bf(qf * expf(fminf(bv - bref, 80.f)));
            kt[s * 136 + k] = (bf16_t)f2bf(kk[j] * expf(fminf(bref - bv, 80.f))); }
        __syncthreads();
        {
            f32x4 a2[1][2] = {{(f32x4){0.f, 0.f, 0.f, 0.f}, (f32x4){0.f, 0.f, 0.f, 0.f}}};
            wave_mma<1, 2, 4>(a2, qt + (16 * (w >> 1)) * 136, 136, kt + (32 * (w & 1)) * 136, 136, c.lane);
#pragma unroll
            for (int nt = 0; nt < 2; ++nt)
#pragma unroll
                for (int j = 0; j < 4; ++j) { const int t = 16 * (w >> 1) + 4 * q + j, s = 32 * (w & 1) + nt * 16 + r; P[t * 72 + s] = (bf16_t)f2bf(s <= t ? a2[0][nt][j] : 0.f); }
        }
        __syncthreads();
        {
            f32x4 a4[1][4];
#pragma unroll
            for (int nt = 0; nt < 4; ++nt) a4[0][nt] = (f32x4){0.f, 0.f, 0.f, 0.f};
            wave_mma<1, 4, 4>(a4, qd + (16 * (w >> 1)) * 136, 136, ST + (64 * (w & 1)) * 136, 136, c.lane);
            wave_mma<1, 4, 2>(a4, P + (16 * (w >> 1)) * 72, 72, vT + (64 * (w & 1)) * 72, 72, c.lane);
#pragma unroll
            for (int nt = 0; nt < 4; ++nt)
#pragma unroll
                for (int j = 0; j < 4; ++j) bL[(16 * (w >> 1) + 4 * q + j) * 129 + 64 * (w & 1) + nt * 16 + r] = a4[0][nt][j];
        }
        __syncthreads();
        {
            const int t = c.tid >> 3, v0 = (c.tid & 7) * 16; float o[16]; float ss = 0.f;
#pragma unroll
            for (int e = 0; e < 16; ++e) { o[e] = bL[t * 129 + v0 + e]; ss += o[e] * o[e]; }
            ss += __shfl_xor(ss, 1); ss += __shfl_xor(ss, 2); ss += __shfl_xor(ss, 4);
            const float rs = 1.f / sqrtf(ss * (1.f / 128.f) + NORM_EPS);
            const bf16_t* gp = hg + (size_t)(row0 + t) * 512 + h * 128 + v0; const u32x4 g0 = *(const u32x4*)gp, g1 = *(const u32x4*)(gp + 8);
            const unsigned gw[8] = {g0.x, g0.y, g0.z, g0.w, g1.x, g1.y, g1.z, g1.w}; unsigned ow[8];
#pragma unroll
            for (int e = 0; e < 8; ++e) { const float ga = bflo(gw[e]), gb = bfhi(gw[e]);
                ow[e] = pk2(o[2 * e] * rs * gnorm[h * 128 + v0 + 2 * e] * siluf(ga), o[2 * e + 1] * rs * gnorm[h * 128 + v0 + 2 * e + 1] * siluf(gb)); }
            bf16_t* yp = ya + (size_t)(row0 + t) * 512 + h * 128 + v0;
            *(u32x4*)yp = (u32x4){ow[0], ow[1], ow[2], ow[3]}; *(u32x4*)(yp + 8) = (u32x4){ow[4], ow[5], ow[6], ow[7]};
        }
        __syncthreads();
    }
}

__device__ __forceinline__ void phase_s5scan(const Ctx& c) {
    const int idx = c.bid * NTHREADS + c.tid;
    if (idx >= 4096) return;
    const int b = idx >> 11, g = (idx >> 6) & 31, p = idx & 63;
    const float* a32 = (const float*)(c.ws + WS_A32) + (g * 64 + p) * 2; const float ar = a32[0], ai = a32[1];
    bf16_t* s5A = (bf16_t*)(c.ws + R_S5A); const float* E = (const float*)(c.ws + WS_S5E);
    float xr = 0.f, xi = 0.f;
    for (int n0 = 0; n0 < 256; n0 += 8) {
        float er[8], ei[8];
#pragma unroll
        for (int i = 0; i < 8; ++i) { const size_t row = (size_t)g * 512 + b * 256 + n0 + i; er[i] = E[row * 128 + p]; ei[i] = E[row * 128 + 64 + p]; }
#pragma unroll
        for (int i = 0; i < 8; ++i) { const size_t row = (size_t)g * 512 + b * 256 + n0 + i; s5A[row * 640 + p] = (bf16_t)f2bf(xr); s5A[row * 640 + 64 + p] = (bf16_t)f2bf(xi);
            const float nr = ar * xr - ai * xi + er[i], ni = ar * xi + ai * xr + ei[i]; xr = nr; xi = ni; }
    }
}

constexpr int AT_K = 17408, AT_VT = 69632, AT_S = 120832;
static_assert(AT_S + 32 * 196 * 4 <= LDS_BYTES, "attention LDS map");
__device__ __forceinline__ float wave_max(float v) {
#pragma unroll
    for (int o = 1; o < 64; o <<= 1) v = fmaxf(v, __shfl_xor(v, o));
    return v;
}
__device__ __forceinline__ void attn_stage_rope(LAS bf16_t* dst, const bf16_t* src, const f32x2* rope_b, int first, int nrows, int sh, int res, int tid) {
    for (int id = tid; id < nrows * 16; id += NTHREADS) {
        const int row = id >> 4, cc = id & 15, idx = first + row; u32x4 v = (u32x4){0u, 0u, 0u, 0u};
        if (idx >= 0) { const int tok = (idx << sh) + res; const bf16_t* rp = src + (size_t)tok * 128;
            v = *(const u32x4*)(rp + cc * 8);
            if (cc < 4) { const u32x4 pv = *(const u32x4*)(rp + (cc ^ 2) * 8); const f32x4* cs = (const f32x4*)(rope_b + (size_t)tok * 16 + 8 * (cc & 1));
                const unsigned vw[4] = {v.x, v.y, v.z, v.w}, pw[4] = {pv.x, pv.y, pv.z, pv.w}; unsigned ow[4];
#pragma unroll
                for (int e = 0; e < 4; ++e) { const f32x4 t = cs[e];
                    const float x0 = bflo(vw[e]), x1 = bfhi(vw[e]), y0 = bflo(pw[e]), y1 = bfhi(pw[e]);
                    float o0, o1;
                    if (cc < 2) { o0 = x0 * t[0] - y0 * t[1]; o1 = x1 * t[2] - y1 * t[3]; }
                    else        { o0 = x0 * t[0] + y0 * t[1]; o1 = x1 * t[2] + y1 * t[3]; }
                    ow[e] = pk2(o0, o1); }
                v = (u32x4){ow[0], ow[1], ow[2], ow[3]}; } }
        *(LAS u32x4*)(dst + row * 136 + cc * 8) = v; }
}
__device__ __forceinline__ void phase_attn(const Ctx& c) {
    LAS bf16_t* Qs = (LAS bf16_t*)c.lds; LAS bf16_t* Ks = (LAS bf16_t*)(c.lds + AT_K); LAS bf16_t* Vt = (LAS bf16_t*)(c.lds + AT_VT); LAS float* S = (LAS float*)(c.lds + AT_S);
    bf16_t* qkv = (bf16_t*)(c.ws + R_QKV); float* lse = (float*)(c.ws + WS_LSE); const f32x2* rope = (const f32x2*)(c.ws + WS_ROPE);
    const int r = c.lane & 15, q = c.lane >> 4, w = c.wave;
    for (int unit = c.bid; unit < 3072; unit += c.G) {
        const int bh = unit >> 7, u7 = unit & 127, b = bh / 12, h = bh % 12, sh = 2 * (h >> 2), per = 128 >> sh, res = u7 / per, jb = u7 % per;
        const int i0 = 64 * jb, j0 = i0 - 128;
        bf16_t* qb = qkv + (size_t)bh * SEQ * 128; const bf16_t* kb = qkv + QKV_WHICH + (size_t)bh * SEQ * 128; const bf16_t* vb = qkv + 2 * QKV_WHICH + (size_t)bh * SEQ * 128;
        const f32x2* rope_b = rope + (size_t)b * SEQ * 16;
        attn_stage_rope(Qs, qb, rope_b, i0, 64, sh, res, c.tid);
        attn_stage_rope(Ks, kb, rope_b, j0, 192, sh, res, c.tid);
#pragma unroll
        for (int ps = 0; ps < 3; ++ps)
#pragma unroll
            for (int hf = 0; hf < 2; ++hf) { const int kk = ps * 64 + c.lane, cc = w + 8 * hf, idx = j0 + kk; u32x4 v = (u32x4){0u, 0u, 0u, 0u};
                if (idx >= 0) v = *(const u32x4*)(vb + (size_t)((idx << sh) + res) * 128 + cc * 8);
                const unsigned vw[4] = {v.x, v.y, v.z, v.w};
#pragma unroll
                for (int e = 0; e < 4; ++e) { Vt[(cc * 8 + 2 * e) * 200 + kk] = (bf16_t)(vw[e] & 0xffffu); Vt[(cc * 8 + 2 * e + 1) * 200 + kk] = (bf16_t)(vw[e] >> 16); } }
        __syncthreads();
#pragma unroll 1
        for (int hq = 0; hq < 2; ++hq) {
            {
                f32x4 a3[1][3];
#pragma unroll
                for (int nt = 0; nt < 3; ++nt) a3[0][nt] = (f32x4){0.f, 0.f, 0.f, 0.f};
                wave_mma<1, 3, 4>(a3, Qs + (32 * hq + 16 * (w & 1)) * 136, 136, Ks + (48 * (w >> 1)) * 136, 136, c.lane);
#pragma unroll
                for (int nt = 0; nt < 3; ++nt)
#pragma unroll
                    for (int j = 0; j < 4; ++j) { const int t = 16 * (w & 1) + 4 * q + j, kk = 48 * (w >> 1) + nt * 16 + r, i = i0 + 32 * hq + t, jn = j0 + kk;
                        const bool ok = (jn >= 0) && (jn <= i) && (i - jn <= 128);
                        S[t * 196 + kk] = ok ? a3[0][nt][j] * 0.08838834764831845f : -1e30f; }
            }
            __syncthreads();
#pragma unroll
            for (int rr = 0; rr < 4; ++rr) { const int t = 4 * w + rr; LAS float* sr = S + t * 196;
                const float s0 = sr[c.lane], s1 = sr[64 + c.lane], s2 = sr[128 + c.lane];
                const float m = wave_max(fmaxf(s0, fmaxf(s1, s2)));
                const float e0 = __expf(s0 - m), e1 = __expf(s1 - m), e2 = __expf(s2 - m);
                const float sum = wave_sum(e0 + e1 + e2), inv = 1.f / sum;
                LAS bf16_t* pr = (LAS bf16_t*)sr;
                pr[c.lane] = (bf16_t)f2bf(e0 * inv); pr[64 + c.lane] = (bf16_t)f2bf(e1 * inv); pr[128 + c.lane] = (bf16_t)f2bf(e2 * inv);
                if (c.lane == 0) lse[(size_t)bh * SEQ + (((i0 + 32 * hq + t) << sh) + res)] = m + logf(sum); }
            __syncthreads();
            {
                f32x4 a2[1][2] = {{(f32x4){0.f, 0.f, 0.f, 0.f}, (f32x4){0.f, 0.f, 0.f, 0.f}}};
                wave_mma<1, 2, 6>(a2, (LAS bf16_t*)S + (16 * (w & 1)) * 392, 392, Vt + (32 * (w >> 1)) * 200, 200, c.lane);
#pragma unroll
                for (int nt = 0; nt < 2; ++nt)
#pragma unroll
                    for (int j = 0; j < 4; ++j) { const int t = 16 * (w & 1) + 4 * q + j, dim = 32 * (w >> 1) + nt * 16 + r, tok = ((i0 + 32 * hq + t) << sh) + res;
                        qb[(size_t)tok * 128 + dim] = (bf16_t)f2bf(a2[0][nt][j]); }
            }
            __syncthreads();
        }
    }
}
__device__ __forceinline__ void phase_attn_merge(const Ctx& c) {
    const bf16_t* qkv = (const bf16_t*)(c.ws + R_QKV); const float* lse = (const float*)(c.ws + WS_LSE); bf16_t* yd = (bf16_t*)(c.ws + WS_Y) + (size_t)3 * TOK * 512;
    for (int id = c.bid * NTHREADS + c.tid; id < TOK * 64; id += c.G * NTHREADS) {
        const int row = id >> 6, hp = (id >> 4) & 3, cc = id & 15, b = row >> 13, t = row & 8191;
        float lw[3]; u32x4 ov[3];
#pragma unroll
        for (int g = 0; g < 3; ++g) { const int bh = b * 12 + g * 4 + hp; lw[g] = lse[(size_t)bh * SEQ + t]; ov[g] = *(const u32x4*)(qkv + ((size_t)bh * SEQ + t) * 128 + cc * 8); }
        const float m = fmaxf(lw[0], fmaxf(lw[1], lw[2])); float e[3], s = 0.f;
#pragma unroll
        for (int g = 0; g < 3; ++g) { e[g] = __expf(lw[g] - m); s += e[g]; }
        const float inv = 1.f / s; float o[8];
#pragma unroll
        for (int i = 0; i < 8; ++i) o[i] = 0.f;
#pragma unroll
        for (int g = 0; g < 3; ++g) { const float wg = e[g] * inv; const unsigned vw[4] = {ov[g].x, ov[g].y, ov[g].z, ov[g].w};
#pragma unroll
            for (int i = 0; i < 4; ++i) { o[2 * i] += wg * bflo(vw[i]); o[2 * i + 1] += wg * bfhi(vw[i]); } }
        *(u32x4*)(yd + (size_t)row * 512 + hp * 128 + cc * 8) = (u32x4){pk2(o[0], o[1]), pk2(o[2], o[3]), pk2(o[4], o[5]), pk2(o[6], o[7])};
    }
}

#ifndef MK_REP
#define MK_REP -1
#endif
constexpr int XB_LDS_OFF = 151040;
constexpr int PH_PER_LAYER = 15, PH_SEQ = PH_PER_LAYER + (MK_REP >= 0 ? 1 : 0), N_PHASES = NLAYER * PH_SEQ + 1;
#ifndef MK_MASK
#define MK_MASK 0xFFFFF
#endif
#ifndef MK_CG_SYNC
#define MK_CG_SYNC 0
#endif
#ifndef MK_SPLIT
#define MK_SPLIT 0
#endif

template <class Epi> __device__ __forceinline__ void run_gemm(const Ctx& c, const bf16_t* A, int lda, const bf16_t* Bt, int ldb, int K, int N, const Epi& E) {
    pg8::Gemm g{A, Bt, lda, ldb, K}; pg8::StaticOrder S; S.init(TOK, N, c.G, c.bid, lda, ldb);
    int t_ = c.tid; asm volatile("" : "+v"(t_));
    pg8::gemm_phase<Epi, pg8::StaticOrder, true, true>(c.lds, g, S, E, t_);
}

__global__ void __launch_bounds__(NTHREADS, 2) hgpm_fwd(Args args) {
    extern __shared__ __attribute__((aligned(16))) unsigned char lds_raw[];
    Ctx c; c.lds = (LAS unsigned char*)lds_raw; c.G = gridDim.x; c.bid = blockIdx.x; c.in = args.in;
    volatile LAS unsigned* xb_st = (volatile LAS unsigned*)(c.lds + XB_LDS_OFF);
    if (threadIdx.x < 4) xb_st[threadIdx.x] = 0u;
    __syncthreads();
    XcdBarrier bar = xcd_barrier_post((unsigned*)(args.ws + WS_CTL), xb_st);

    for (int ph = args.ph_lo; ph < args.ph_hi; ++ph) {
        const int l = ph / PH_SEQ, pi_ = ph % PH_SEQ, p = (MK_REP >= 0 && pi_ > MK_REP) ? pi_ - 1 : pi_;
        { int t_ = threadIdx.x; asm volatile("" : "+v"(t_)); c.tid = t_; c.lane = t_ & 63; c.wave = __builtin_amdgcn_readfirstlane(t_ >> 6); }
        { int z_ = 0; asm volatile("" : "+s"(z_)); c.zo = z_; c.ws = args.ws + z_; c.out = args.out + z_; }
        unsigned char* ws = c.ws;
        bf16_t* XN = (bf16_t*)(ws + WS_XN); bf16_t* Y = (bf16_t*)(ws + WS_Y); bf16_t* MERGED = (bf16_t*)(ws + WS_MERGED); bf16_t* Z = MERGED;
        bf16_t* HBUF = (bf16_t*)(ws + R_HBUF); bf16_t* BALL = (bf16_t*)(ws + R_BALL); bf16_t* S5A = (bf16_t*)(ws + R_S5A);
        float* SSQ = (float*)(ws + WS_SSQ);
        float* ssq_b = SSQ + (size_t)(3 * l) * TOK; float* ssq_c = ssq_b + TOK; float* ssq_d = ssq_c + TOK;
        const float* ssq_a = (l == 0) ? SSQ + (size_t)6 * TOK : SSQ + (size_t)(3 * l - 1) * TOK;
        if (ph == N_PHASES - 1) { phase_final_norm(c, c.out, INP(c, 29), SSQ + (size_t)(3 * NLAYER - 1) * TOK); }
        else switch (p) {
        case 0: phase_wprep(c, l); if (l == 0) phase_norm_in(c, INP(c, 0), XN, SSQ + (size_t)6 * TOK); break;
        case 1: run_gemm(c, XN, DM, (const bf16_t*)(ws + W_GU1), DM, DM, 2 * DFF, pg8::EpiGated<0>{HBUF, DFF, ssq_a}); break;
        case 13: run_gemm(c, XN, DM, (const bf16_t*)(ws + W_GU2), DM, DM, 2 * DFF, pg8::EpiGated<0>{HBUF, DFF, ssq_c}); break;
        case 2: run_gemm(c, HBUF, DFF, (const bf16_t*)(ws + W_D1), DFF, DFF, DM, pg8::EpiResid{l == 0 ? INP(c, 0) : c.out, c.out, 0.5f, XN, ssq_b}); break;
        case 14: run_gemm(c, HBUF, DFF, (const bf16_t*)(ws + W_D2), DFF, DFF, DM, pg8::EpiResid{c.out, c.out, 0.5f, XN, ssq_d}); break;
        case 3: run_gemm(c, XN, DM, (const bf16_t*)(ws + W_C1), DM, DM, 3584, pg8::EpiC1{(bf16_t*)(ws + R_HQ), S5A, (bf16_t*)(ws + R_CONV), ssq_b}); break;
        case 4: { pg8::Gemm g{S5A, (const bf16_t*)(ws + W_S5E), 640, 512, 512}; pg8::S5eOrder S{c.G, c.bid};
                  pg8::gemm_phase<pg8::EpiS5e, pg8::S5eOrder, true, true>(c.lds, g, S, pg8::EpiS5e{(float*)(ws + WS_S5E)}, c.tid);
                  phase_hg1(c, l); phase_conv(c, l); } break;
        case 5: phase_hg2(c); phase_s5scan(c); break;
        case 6: { pg8::Gemm g{S5A, (const bf16_t*)(ws + W_S5M), 640, 640, 640}; pg8::S5mOrder S{c.G, c.bid};
                  pg8::gemm_phase<pg8::EpiS5m, pg8::S5mOrder, true, true>(c.lds, g, S, pg8::EpiS5m{S5A, INP(c, 17) + l * 512, Z}, c.tid);
                  phase_hg3(c, l); } break;
        case 7: run_gemm(c, Z, 512, (const bf16_t*)(ws + W_GLU), 512, 512, 1024, pg8::EpiGated<1>{Y + (size_t)TOK * 512, 512, nullptr});
                run_gemm(c, XN, DM, (const bf16_t*)(ws + W_C2), DM, DM, 4608, pg8::EpiC2{(bf16_t*)(ws + R_QKV), ssq_b}); break;
        case 8: phase_attn(c); break;
        case 9: phase_attn_merge(c); break;
        case 10: { pg8::Gemm g{Y, (const bf16_t*)(ws + W_BR), 512, 512, 512}; pg8::BranchOrder S; S.init(c.G, c.bid);
                   pg8::gemm_phase<pg8::EpiBranch, pg8::BranchOrder, true, true>(c.lds, g, S, pg8::EpiBranch{BALL}, c.tid); } break;
        case 11: run_gemm(c, XN, DM, (const bf16_t*)(ws + W_GATE), DM, DM, 4096, pg8::EpiGateMerge{BALL, MERGED, ssq_b}); break;
        case 12: run_gemm(c, MERGED, DM, (const bf16_t*)(ws + W_OUT), DM, DM, DM, pg8::EpiResid{c.out, c.out, 1.0f, XN, ssq_c}); break;
        }
        if (ph + 1 < args.ph_hi) {
#if MK_CG_SYNC
            __syncthreads(); cg::this_grid().sync();
#else
            xcd_barrier(bar);
#endif
        }
    }
}

extern "C" void kernel_launch(void* const* d_in, const int* in_sizes, int n_in, void* d_out, int out_size, void* d_ws, size_t ws_size, hipStream_t stream) {
    static int grid = 0;
    if (grid == 0) {
        if (n_in != 30 || in_sizes[0] != TOK * DM || out_size != TOK * DM || ws_size < WS_END) {
            fprintf(stderr, "kernel_launch: unexpected problem: n_in %d, in0 %d, out %d, ws %zu (need %zu)\n", n_in, n_in > 0 ? in_sizes[0] : -1, out_size, ws_size, (size_t)WS_END); grid = -1; return; }
        int dev = 0, cus = 0, per_cu = 0;
        if (hipGetDevice(&dev) != hipSuccess || hipDeviceGetAttribute(&cus, hipDeviceAttributeMultiprocessorCount, dev) != hipSuccess) { fprintf(stderr, "kernel_launch: device query failed\n"); grid = -1; return; }
        if (hipFuncSetAttribute((const void*)hgpm_fwd, hipFuncAttributeMaxDynamicSharedMemorySize, LDS_BYTES) != hipSuccess) { fprintf(stderr, "kernel_launch: hipFuncSetAttribute failed\n"); grid = -1; return; }
        if (hipOccupancyMaxActiveBlocksPerMultiprocessor(&per_cu, (const void*)hgpm_fwd, NTHREADS, LDS_BYTES) != hipSuccess || per_cu < 1) { fprintf(stderr, "kernel_launch: occupancy query says %d blocks per CU\n", per_cu); (void)hipGetLastError(); grid = -1; return; }
        grid = cus * 1;
    }
    if (grid < 0) return;
    (void)hipMemsetAsync((char*)d_ws + WS_CTL, 0, 1 * MiB, stream);
    Args a{};
    for (int i = 0; i < 30; ++i) a.in[i] = (const float*)d_in[i];
    a.out = (float*)d_out; a.ws = (unsigned char*)d_ws;
#if MK_SPLIT
    for (int ph = 0; ph < N_PHASES; ++ph) { a.ph_lo = ph; a.ph_hi = ph + 1; hipLaunchKernelGGL(hgpm_fwd, dim3(grid), dim3(NTHREADS), LDS_BYTES, stream, a); }
#else
    a.ph_lo = 0; a.ph_hi = N_PHASES;
    void* kargs[] = {&a};
    const hipError_t e = hipLaunchCooperativeKernel((const void*)hgpm_fwd, dim3(grid), dim3(NTHREADS), kargs, LDS_BYTES, stream);
    if (e != hipSuccess) fprintf(stderr, "kernel_launch: cooperative launch failed: %s (grid %d)\n", hipGetErrorString(e), grid);
#endif
}
```

```cpp
#include <hip/hip_runtime.h>
#include <hip/hip_cooperative_groups.h>
#include <cstdio>
#include <cstdint>
namespace cg = cooperative_groups;

#define LAS __attribute__((address_space(3)))
typedef unsigned short bf16_t;
typedef short bf16x8 __attribute__((ext_vector_type(8)));
typedef float f32x4 __attribute__((ext_vector_type(4)));
typedef float f32x2 __attribute__((ext_vector_type(2)));
typedef unsigned u32x4 __attribute__((ext_vector_type(4)));
typedef unsigned u32x2 __attribute__((ext_vector_type(2)));

constexpr int BATCH = 2, SEQ = 8192, TOK = BATCH * SEQ, DM = 1024, DFF = 2816, NLAYER = 2, INW = 12288;
constexpr float NORM_EPS = 1e-6f;

__device__ __forceinline__ unsigned f2bf(float f) { unsigned u = __builtin_bit_cast(unsigned, f); return (u + 0x7fffu + ((u >> 16) & 1u)) >> 16; }
__device__ __forceinline__ float bf2f(unsigned b) { return __builtin_bit_cast(float, b << 16); }
__device__ __forceinline__ unsigned pk2(float lo, float hi) { return f2bf(lo) | (f2bf(hi) << 16); }
__device__ __forceinline__ float bflo(unsigned w) { return __builtin_bit_cast(float, w << 16); }
__device__ __forceinline__ float bfhi(unsigned w) { return __builtin_bit_cast(float, w & 0xffff0000u); }
__device__ __forceinline__ float sigm(float x) { return 1.f / (1.f + __expf(-x)); }
__device__ __forceinline__ float siluf(float x) { return x / (1.f + __expf(-x)); }
__device__ __forceinline__ float gelu_tanh(float x) { const float y = 0.7978845608028654f * (x + 0.044715f * x * x * x); const float t = 1.f - 2.f / (1.f + __expf(2.f * y)); return 0.5f * x * (1.f + t); }
__device__ __forceinline__ float wave_sum(float v) {
#pragma unroll
    for (int o = 1; o < 64; o <<= 1) v += __shfl_xor(v, o);
    return v;
}
#define LDS_WAIT() asm volatile("s_waitcnt lgkmcnt(0)" ::: "memory")

namespace pg8 {
#define PG8_LAS __attribute__((address_space(3)))
constexpr int BM = 256, BK = 64, HALF = 128, HTB = HALF * BK * 2  , STAGE_BYTES = 8 * HTB, NXCD = 8, WGM = 8;

__host__ __device__ __forceinline__ int lds_byte(int r, int c) { const int st = (r >> 4) * 2 + (c >> 5), rr = r & 15, cc = c & 31, ob = rr * 64 + cc * 2; return st * 1024 + (ob ^ (((ob >> 9) & 1) << 5)); }
__host__ __device__ __forceinline__ void stage_rc(int b, int& R, int& C) { const int st = b / 1024, sb = b % 1024, swz = sb ^ (((sb >> 9) & 1) << 5); R = (st >> 1) * 16 + swz / 64; C = (st & 1) * 32 + (swz % 64) / 2; }
__host__ __device__ __forceinline__ int perm32(int rho) { const int n = rho >> 4, i = rho & 15; return 8 * (i >> 2) + 4 * n + (i & 3); }

struct Unit { int pm, pn, grp; size_t aoff, boff; };
struct Gemm { const bf16_t* A; const bf16_t* Bt; int lda, ldb, K; };

struct StaticOrder {
    int nM, nN, nwg, G, c, lda, ldb;
    __device__ __forceinline__ void init(int M, int N, int G_, int c_, int lda_, int ldb_) { nM = M / BM; nN = N / BM; nwg = nM * nN; G = G_; c = c_; lda = lda_; ldb = ldb_; }
    __device__ __forceinline__ bool next(int i, Unit& u) const {
        const long L = (long)i * G + c; if (L >= nwg) return false;
        int wgid = (int)L; { const int q = nwg / NXCD, r = nwg % NXCD, xcd = wgid % NXCD, off = wgid / NXCD; wgid = (xcd < r ? xcd * (q + 1) : r * (q + 1) + (xcd - r) * q) + off; }
        const int nig = WGM * nN, gid = wgid / nig, fm = gid * WGM, gsz = (nM - fm) < WGM ? (nM - fm) : WGM;
        u.pm = fm + ((wgid % nig) % gsz); u.pn = (wgid % nig) / gsz; u.grp = 0;
        u.aoff = (size_t)u.pm * 256 * lda * 2; u.boff = (size_t)u.pn * 256 * ldb * 2; return true;
    }
    __device__ __forceinline__ void a_ready(const Unit&) const {}
    __device__ __forceinline__ void done(const Unit&) const {}
};
struct BranchOrder {
    StaticOrder so;
    __device__ __forceinline__ void init(int G_, int c_) { so.init(TOK, 1024, G_, c_, 512, 512); }
    __device__ __forceinline__ bool next(int i, Unit& u) const {
        const long L = (long)i * so.G + so.c; if (L >= 1024) return false;
        const int k = (int)(L >> 8); StaticOrder s2 = so; s2.G = 256; s2.c = (int)(L & 255);
        if (!s2.next(0, u)) return false;
        u.grp = k; u.aoff += (size_t)k * TOK * 512 * 2; u.boff += (size_t)k * 1024 * 512 * 2; return true;
    }
    __device__ __forceinline__ void a_ready(const Unit&) const {}
    __device__ __forceinline__ void done(const Unit&) const {}
};
struct S5eOrder {
    int G, c;
    __device__ __forceinline__ bool next(int i, Unit& u) const {
        const long L = (long)i * G + c; if (L >= 64) return false;
        const int g = (int)L >> 1, pm = (int)L & 1; u.pm = pm; u.pn = 0; u.grp = g;
        u.aoff = ((size_t)(g * 512 + pm * 256) * 640 + 128) * 2; u.boff = (size_t)g * 256 * 512 * 2; return true;
    }
    __device__ __forceinline__ void a_ready(const Unit&) const {}
    __device__ __forceinline__ void done(const Unit&) const {}
};
struct S5mOrder {
    int G, c;
    __device__ __forceinline__ bool next(int i, Unit& u) const {
        const long L = (long)i * G + c; if (L >= 128) return false;
        const int g = (int)L >> 2, pm = ((int)L >> 1) & 1, pn = (int)L & 1; u.pm = pm; u.pn = pn; u.grp = g;
        u.aoff = (size_t)(g * 512 + pm * 256) * 640 * 2; u.boff = (size_t)(g * 512 + pn * 256) * 640 * 2; return true;
    }
    __device__ __forceinline__ void a_ready(const Unit&) const {}
    __device__ __forceinline__ void done(const Unit&) const {}
};

typedef __bf16 bf16x2_t __attribute__((ext_vector_type(2)));
__device__ __forceinline__ unsigned cvt_pk_bf16(float lo, float hi) { const f32x2 v = {lo, hi}; const bf16x2_t b = __builtin_convertvector(v, bf16x2_t); return __builtin_bit_cast(unsigned, b); }
__device__ __forceinline__ u32x4 pack8(const f32x4& v0, const f32x4& v1) { u32x4 w; w.x = cvt_pk_bf16(v0[0], v0[1]); w.y = cvt_pk_bf16(v0[2], v0[3]); w.z = cvt_pk_bf16(v1[0], v1[1]); w.w = cvt_pk_bf16(v1[2], v1[3]); return w; }

template <int MODE> struct EpiGated {
    static constexpr bool PERM = true, AFTER_DRAIN = false;
    bf16_t* O; int ldo; const float* ssq;
    __device__ __forceinline__ void operator()(const f32x4 (&acc)[2][2][4][2], const Unit& u, int wr, int wc, int fr, int fq) const {
        const int row0 = u.pm * BM + wr * 64 + fr, col0 = u.pn * 128 + wc * 32 + 8 * fq;
#pragma unroll
        for (int ai = 0; ai < 2; ++ai)
#pragma unroll
            for (int m = 0; m < 4; ++m) { const int row = row0 + ai * HALF + m * 16; bf16_t* rowp = O + (size_t)row * ldo + col0;
                const float rs = ssq ? rsqrtf(ssq[row] * (1.f / DM) + NORM_EPS) : 1.f;
                f32x4 v[2];
#pragma unroll
                for (int n = 0; n < 2; ++n)
#pragma unroll
                    for (int j = 0; j < 4; ++j) { const float a = acc[ai][0][m][n][j] * rs, b = acc[ai][1][m][n][j] * rs; v[n][j] = (MODE == 0) ? siluf(a) * b : a * sigm(b); }
                *(u32x4*)rowp = pack8(v[0], v[1]); asm volatile("" ::: "memory"); }
    }
};
struct EpiResid {
    static constexpr bool PERM = false, AFTER_DRAIN = false;
    const float* base; float* out; float scale; bf16_t* xn; float* ssq;
    __device__ __forceinline__ void operator()(const f32x4 (&acc)[2][2][4][2], const Unit& u, int wr, int wc, int fr, int fq) const {
        const int row0 = u.pm * BM + wr * 64 + fr, col0 = u.pn * BM + wc * 32 + 4 * fq;
#pragma unroll
        for (int ai = 0; ai < 2; ++ai)
#pragma unroll
            for (int m = 0; m < 4; ++m) { const int row = row0 + ai * HALF + m * 16; const size_t off = (size_t)row * DM + col0; float ss = 0.f;
#pragma unroll
                for (int bj = 0; bj < 2; ++bj)
#pragma unroll
                    for (int n = 0; n < 2; ++n) { const size_t o = off + bj * HALF + n * 16; const f32x4 b = *(const f32x4*)(base + o); const f32x4 v = b + scale * acc[ai][bj][m][n];
                        *(f32x4*)(out + o) = v; ss += (v[0] * v[0] + v[1] * v[1]) + (v[2] * v[2] + v[3] * v[3]);
                        u32x2 w; w.x = cvt_pk_bf16(v[0], v[1]); w.y = cvt_pk_bf16(v[2], v[3]); *(u32x2*)(xn + o) = w; }
                ss += __shfl_xor(ss, 16); ss += __shfl_xor(ss, 32);
                if (fq == 0) atomicAdd(ssq + row, ss);
                asm volatile("" ::: "memory"); }
    }
};
struct EpiC1 {
    static constexpr bool PERM = true, AFTER_DRAIN = false;
    bf16_t* hq; bf16_t* s5A; bf16_t* convin; const float* ssq;
    __device__ __forceinline__ void operator()(const f32x4 (&acc)[2][2][4][2], const Unit& u, int wr, int wc, int fr, int fq) const {
        const int pn = u.pn, rowb = u.pm * BM + wr * 64 + fr, cl = wc * 32 + 8 * fq;
        bf16_t* p0; int sAI, sM1, sM0, sBJ;
        if (pn < 8) { p0 = hq + (size_t)(pn >> 1) * TOK * 512 + (size_t)rowb * 512 + (pn & 1) * 256 + cl; sAI = 128 * 512; sM1 = 32 * 512; sM0 = 16 * 512; sBJ = 128; }
        else if (pn < 10) { const int c5 = (pn - 8) * 256 + cl, g = c5 >> 4, ch = c5 & 15;
            p0 = s5A + ((size_t)(g * 512 + u.pm * 8 + 2 * wr) * 640 + 128 + fr * 16 + ch); sAI = 4 * 640; sM1 = 640; sM0 = 256; sBJ = 8 * 512 * 640; }
        else { p0 = convin + (size_t)rowb * 1024 + (pn - 10) * 256 + cl; sAI = 128 * 1024; sM1 = 32 * 1024; sM0 = 16 * 1024; sBJ = 128; }
#pragma unroll
        for (int ai = 0; ai < 2; ++ai)
#pragma unroll
            for (int m = 0; m < 4; ++m) { const float rs = rsqrtf(ssq[rowb + ai * HALF + m * 16] * (1.f / DM) + NORM_EPS);
#pragma unroll
                for (int bj = 0; bj < 2; ++bj)
                    *(u32x4*)(p0 + (size_t)(ai * sAI + (m >> 1) * sM1 + (m & 1) * sM0 + bj * sBJ)) = pack8(acc[ai][bj][m][0] * rs, acc[ai][bj][m][1] * rs);
                asm volatile("" ::: "memory"); }
    }
};
struct EpiC2 {
    static constexpr bool PERM = true, AFTER_DRAIN = false;
    bf16_t* qkv; const float* ssq;
    __device__ __forceinline__ void operator()(const f32x4 (&acc)[2][2][4][2], const Unit& u, int wr, int wc, int fr, int fq) const {
        const int which = u.pn / 6, hp = u.pn % 6, rowt = u.pm * BM, b = rowt >> 13, t0 = (rowt & 8191) + wr * 64 + fr;
        bf16_t* p0 = qkv + ((size_t)(which * 24 + b * 12 + 2 * hp) * SEQ + t0) * 128 + wc * 32 + 8 * fq;
#pragma unroll
        for (int ai = 0; ai < 2; ++ai)
#pragma unroll
            for (int m = 0; m < 4; ++m) { const float rs = rsqrtf(ssq[rowt + wr * 64 + fr + ai * HALF + m * 16] * (1.f / DM) + NORM_EPS);
#pragma unroll
                for (int bj = 0; bj < 2; ++bj)
                    *(u32x4*)(p0 + (size_t)bj * SEQ * 128 + (size_t)(ai * HALF + m * 16) * 128) = pack8(acc[ai][bj][m][0] * rs, acc[ai][bj][m][1] * rs);
                asm volatile("" ::: "memory"); }
    }
};
struct EpiS5e {
    static constexpr bool PERM = false, AFTER_DRAIN = false;
    float* E;
    __device__ __forceinline__ void operator()(const f32x4 (&acc)[2][2][4][2], const Unit& u, int wr, int wc, int fr, int fq) const {
        const int row0 = u.pm * BM + wr * 64 + fr, col0 = wc * 32 + 4 * fq;
#pragma unroll
        for (int ai = 0; ai < 2; ++ai)
#pragma unroll
            for (int m = 0; m < 4; ++m) { float* rowp = E + (size_t)(u.grp * 512 + row0 + ai * HALF + m * 16) * 128 + col0;
#pragma unroll
                for (int n = 0; n < 2; ++n) *(f32x4*)(rowp + n * 16) = acc[ai][0][m][n]; }
    }
};
struct EpiS5m {
    static constexpr bool PERM = true, AFTER_DRAIN = false;
    const bf16_t* s5A; const float* dskip; bf16_t* Z;
    __device__ __forceinline__ void operator()(const f32x4 (&acc)[2][2][4][2], const Unit& u, int wr, int wc, int fr, int fq) const {
        const int g = u.grp, chunk0 = u.pm * BM + wr * 64 + fr, c0 = 8 * (fq & 1), t0 = u.pn * 16 + 2 * wc + (fq >> 1);
        const f32x4 d0 = *(const f32x4*)(dskip + g * 16 + c0), d1 = *(const f32x4*)(dskip + g * 16 + c0 + 4);
        const bf16_t* up = s5A + (size_t)(g * 512 + chunk0) * 640 + 128 + t0 * 16 + c0;
        bf16_t* zp = Z + (size_t)(chunk0 * 32 + t0) * 512 + g * 16 + c0;
#pragma unroll
        for (int ai = 0; ai < 2; ++ai)
#pragma unroll
            for (int m = 0; m < 4; ++m) {
#pragma unroll
                for (int bj = 0; bj < 2; ++bj) {
                    const u32x4 uu = *(const u32x4*)(up + (size_t)(ai * HALF + m * 16) * 640 + bj * 128);
                    f32x4 v0 = acc[ai][bj][m][0], v1 = acc[ai][bj][m][1];
                    v0[0] += d0[0] * bflo(uu.x); v0[1] += d0[1] * bfhi(uu.x); v0[2] += d0[2] * bflo(uu.y); v0[3] += d0[3] * bfhi(uu.y);
                    v1[0] += d1[0] * bflo(uu.z); v1[1] += d1[1] * bfhi(uu.z); v1[2] += d1[2] * bflo(uu.w); v1[3] += d1[3] * bfhi(uu.w);
#pragma unroll
                    for (int j = 0; j < 4; ++j) { v0[j] = gelu_tanh(v0[j]); v1[j] = gelu_tanh(v1[j]); }
                    *(u32x4*)(zp + (size_t)(ai * HALF + m * 16) * 32 * 512 + bj * 8 * 512) = pack8(v0, v1); }
                asm volatile("" ::: "memory"); }
    }
};
struct EpiBranch {
    static constexpr bool PERM = true, AFTER_DRAIN = false;
    bf16_t* Ball;
    __device__ __forceinline__ void operator()(const f32x4 (&acc)[2][2][4][2], const Unit& u, int wr, int wc, int fr, int fq) const {
        const int row0 = u.pm * BM + wr * 64 + fr, col0 = u.grp * 1024 + u.pn * BM + wc * 32 + 8 * fq;
#pragma unroll
        for (int ai = 0; ai < 2; ++ai)
#pragma unroll
            for (int m = 0; m < 4; ++m) { bf16_t* rowp = Ball + (size_t)(row0 + ai * HALF + m * 16) * 4096 + col0;
#pragma unroll
                for (int bj = 0; bj < 2; ++bj) *(u32x4*)(rowp + bj * HALF) = pack8(acc[ai][bj][m][0], acc[ai][bj][m][1]); }
    }
};
struct EpiGateMerge {
    static constexpr bool PERM = false, AFTER_DRAIN = false;
    const bf16_t* Ball; bf16_t* merged; const float* ssq;
    __device__ __forceinline__ void operator()(const f32x4 (&acc)[2][2][4][2], const Unit& u, int wr, int wc, int fr, int fq) const {
        const int row0 = u.pm * BM + wr * 64 + fr, mc = u.pn * 64 + wc * 16 + 4 * fq;
#pragma unroll
        for (int ai = 0; ai < 2; ++ai)
#pragma unroll
            for (int m = 0; m < 4; ++m) { const int row = row0 + ai * HALF + m * 16; const bf16_t* bp = Ball + (size_t)row * 4096 + mc;
                const float rs = rsqrtf(ssq[row] * (1.f / DM) + NORM_EPS);
                f32x4 s = {0.f, 0.f, 0.f, 0.f};
#pragma unroll
                for (int bj = 0; bj < 2; ++bj)
#pragma unroll
                    for (int n = 0; n < 2; ++n) { const u32x2 bv = *(const u32x2*)(bp + (2 * bj + n) * 1024); const f32x4 gt = acc[ai][bj][m][n] * rs;
                        s[0] += sigm(gt[0]) * bflo(bv.x); s[1] += sigm(gt[1]) * bfhi(bv.x); s[2] += sigm(gt[2]) * bflo(bv.y); s[3] += sigm(gt[3]) * bfhi(bv.y); }
                u32x2 w; w.x = cvt_pk_bf16(s[0], s[1]); w.y = cvt_pk_bf16(s[2], s[3]);
                *(u32x2*)(merged + (size_t)row * DM + mc) = w; }
    }
};

template <class Epi, class Sched, bool ALIGN_EPI = false, bool SP2 = false>
__device__ __forceinline__ void gemm_phase(PG8_LAS unsigned char* lds, const Gemm g, const Sched& S, const Epi& E, int tid_opaque) {
    const int tid = tid_opaque, wid = __builtin_amdgcn_readfirstlane(tid >> 6), lane = tid & 63, wr = wid >> 2, wc = wid & 3, fr = lane & 15, fq = lane >> 4;
    const int K = g.K, nt = K / BK, lda = g.lda, ldb = g.ldb;
    unsigned voffA[2], voffB[2];
#pragma unroll
    for (int i = 0; i < 2; ++i) { int R, C; stage_rc(tid * 16 + i * 8192, R, C); const int Rb = Epi::PERM ? ((R & ~31) + perm32(R & 31)) : R;
        voffA[i] = (unsigned)(R * lda + C) * 2u; voffB[i] = (unsigned)(Rb * ldb + C) * 2u; }
    const size_t kstep = (size_t)(BK * 2);
    const size_t hstepA = (size_t)HALF * lda * 2, hstepB = (size_t)HALF * ldb * 2;

    const unsigned ldsw = (unsigned)wid * 1024u;
    const int aoff = lds_byte(wr * 64 + fr, fq * 8), boff = lds_byte(wc * 32 + fr, fq * 8);
#define PG8_SA(b, h) (((b) * 2 + (h)) * HTB)
#define PG8_SB(b, h) ((4 + (b) * 2 + (h)) * HTB)
#define PG8_STAGE(bufoff, gbase, voff) do { _Pragma("unroll") for (int _i = 0; _i < 2; ++_i) \
        __builtin_amdgcn_global_load_lds((const unsigned*)((const char*)(gbase) + (voff)[_i]), (PG8_LAS unsigned*)(lds + (bufoff) + ldsw + _i * 8192), 16, 0, 0); } while (0)
#define PG8_LDA(dst, b, h) do { _Pragma("unroll") for (int m = 0; m < 4; ++m) _Pragma("unroll") for (int k = 0; k < 2; ++k) dst[m][k] = *(const PG8_LAS bf16x8*)(lds + PG8_SA(b, h) + aoff + m * 2048 + k * 1024); } while (0)
#define PG8_LDB(dst, b, h) do { _Pragma("unroll") for (int n = 0; n < 2; ++n) _Pragma("unroll") for (int k = 0; k < 2; ++k) dst[n][k] = *(const PG8_LAS bf16x8*)(lds + PG8_SB(b, h) + boff + n * 2048 + k * 1024); } while (0)
#define PG8_MMA(ai, bj, At, Bt) do { __builtin_amdgcn_s_setprio(1); _Pragma("unroll") for (int m = 0; m < 4; ++m) _Pragma("unroll") for (int n = 0; n < 2; ++n) _Pragma("unroll") for (int k = 0; k < 2; ++k) \
        acc[ai][bj][m][n] = __builtin_amdgcn_mfma_f32_16x16x32_bf16(Bt[n][k], At[m][k], acc[ai][bj][m][n], 0, 0, 0); __builtin_amdgcn_s_setprio(0); } while (0)
#define PG8_WAIT_V(n) asm volatile("s_waitcnt vmcnt(" #n ")" ::: "memory")
#define PG8_WAIT_L(n) asm volatile("s_waitcnt lgkmcnt(" #n ")" ::: "memory")
#define PG8_BAR __builtin_amdgcn_s_barrier()
#define PG8_SCHED __builtin_amdgcn_sched_barrier(0)
    Unit cur, nxt; int ui = 0;
    if (!S.next(0, cur)) return;
    f32x4 acc[2][2][4][2];
#pragma unroll
    for (int a = 0; a < 2; ++a)
#pragma unroll
        for (int b = 0; b < 2; ++b)
#pragma unroll
            for (int m = 0; m < 4; ++m)
#pragma unroll
                for (int n = 0; n < 2; ++n) acc[a][b][m][n] = (f32x4){0.f, 0.f, 0.f, 0.f};
    bf16x8 At[4][2], B0[2][2], B1[2][2];
    const char* cA = (const char*)g.A + cur.aoff; const char* cB = (const char*)g.Bt + cur.boff;
    S.a_ready(cur);
    if constexpr (SP2) {
        PG8_STAGE(PG8_SB(0, 0), cB, voffB); PG8_STAGE(PG8_SB(0, 1), cB + hstepB, voffB); PG8_STAGE(PG8_SA(0, 0), cA, voffA); PG8_STAGE(PG8_SA(0, 1), cA + hstepA, voffA);
        if (wr == 1) PG8_BAR;
        PG8_WAIT_V(2); PG8_BAR;
        PG8_STAGE(PG8_SB(1, 0), cB + kstep, voffB); PG8_STAGE(PG8_SA(1, 0), cA + kstep, voffA); PG8_STAGE(PG8_SB(1, 1), cB + hstepB + kstep, voffB);
        PG8_WAIT_V(6); PG8_BAR;
    } else {
        PG8_STAGE(PG8_SB(0, 0), cB, voffB); PG8_STAGE(PG8_SA(0, 0), cA, voffA); PG8_STAGE(PG8_SB(0, 1), cB + hstepB, voffB); PG8_STAGE(PG8_SA(0, 1), cA + hstepA, voffA);
        if (wr == 1) PG8_BAR;
        PG8_WAIT_V(4); PG8_BAR;
        PG8_STAGE(PG8_SB(1, 0), cB + kstep, voffB); PG8_STAGE(PG8_SA(1, 0), cA + kstep, voffA); PG8_STAGE(PG8_SB(1, 1), cB + hstepB + kstep, voffB);
        PG8_WAIT_V(6); PG8_BAR;
    }
    for (;;) {
        const bool has_next = S.next(ui + 1, nxt);
        const char* nA = has_next ? (const char*)g.A + nxt.aoff : cA; const char* nB = has_next ? (const char*)g.Bt + nxt.boff : cB;
        for (int t = 0; t < nt; t += 2) {
            const bool last = (t == nt - 2);
            const char* a1 = cA + (size_t)(t + 1) * kstep;
            const char* a2 = last ? nA : cA + (size_t)(t + 2) * kstep; const char* b2 = last ? nB : cB + (size_t)(t + 2) * kstep;
            const char* a3 = a2 + kstep; const char* b3 = b2 + kstep;
            if (last && has_next) S.a_ready(nxt);
            if constexpr (SP2) {
            PG8_LDB(B0, 0, 0); PG8_LDB(B1, 0, 1); PG8_SCHED; PG8_LDA(At, 0, 0); PG8_STAGE(PG8_SA(1, 1), a1 + hstepA, voffA);
            PG8_WAIT_V(8); PG8_WAIT_L(0); PG8_BAR; PG8_MMA(0, 0, At, B0); PG8_MMA(0, 1, At, B1); PG8_BAR; PG8_SCHED;
            PG8_LDA(At, 0, 1); PG8_STAGE(PG8_SB(0, 0), b2, voffB); PG8_STAGE(PG8_SB(0, 1), b2 + hstepB, voffB); PG8_STAGE(PG8_SA(0, 0), a2, voffA);
            PG8_WAIT_V(8); PG8_WAIT_L(0); PG8_BAR; PG8_MMA(1, 0, At, B0); PG8_MMA(1, 1, At, B1); PG8_BAR; PG8_SCHED;
            PG8_LDB(B0, 1, 0); PG8_LDB(B1, 1, 1); PG8_SCHED; PG8_LDA(At, 1, 0); PG8_STAGE(PG8_SA(0, 1), a2 + hstepA, voffA);
            PG8_WAIT_V(8); PG8_WAIT_L(0); PG8_BAR; PG8_MMA(0, 0, At, B0); PG8_MMA(0, 1, At, B1); PG8_BAR; PG8_SCHED;
            PG8_LDA(At, 1, 1); PG8_STAGE(PG8_SB(1, 0), b3, voffB); PG8_STAGE(PG8_SB(1, 1), b3 + hstepB, voffB); PG8_STAGE(PG8_SA(1, 0), a3, voffA);
            PG8_WAIT_V(8); PG8_WAIT_L(0); PG8_BAR; PG8_MMA(1, 0, At, B0); PG8_MMA(1, 1, At, B1); PG8_BAR; PG8_SCHED;
            } else {
            PG8_LDB(B0, 0, 0); PG8_SCHED; PG8_LDA(At, 0, 0); PG8_STAGE(PG8_SA(1, 1), a1 + hstepA, voffA);
            PG8_WAIT_L(8); PG8_BAR; PG8_WAIT_L(0); PG8_MMA(0, 0, At, B0); PG8_BAR; PG8_SCHED;
            PG8_LDB(B1, 0, 1); PG8_STAGE(PG8_SB(0, 0), b2, voffB);
            PG8_BAR; PG8_WAIT_L(0); PG8_MMA(0, 1, At, B1); PG8_BAR;
            PG8_LDA(At, 0, 1); PG8_STAGE(PG8_SA(0, 0), a2, voffA);
            PG8_BAR; PG8_WAIT_L(0); PG8_MMA(1, 0, At, B0); PG8_BAR; PG8_SCHED;
            PG8_STAGE(PG8_SB(0, 1), b2 + hstepB, voffB);
            PG8_WAIT_V(6); PG8_BAR; PG8_MMA(1, 1, At, B1); PG8_BAR;
            PG8_LDB(B0, 1, 0); PG8_SCHED; PG8_LDA(At, 1, 0); PG8_STAGE(PG8_SA(0, 1), a2 + hstepA, voffA);
            PG8_WAIT_L(8); PG8_BAR; PG8_WAIT_L(0); PG8_MMA(0, 0, At, B0); PG8_BAR; PG8_SCHED;
            PG8_LDB(B1, 1, 1); PG8_STAGE(PG8_SB(1, 0), b3, voffB);
            PG8_BAR; PG8_WAIT_L(0); PG8_MMA(0, 1, At, B1); PG8_BAR;
            PG8_LDA(At, 1, 1); PG8_STAGE(PG8_SA(1, 0), a3, voffA);
            PG8_BAR; PG8_WAIT_L(0); PG8_MMA(1, 0, At, B0); PG8_BAR; PG8_SCHED;
            PG8_STAGE(PG8_SB(1, 1), b3 + hstepB, voffB);
            PG8_WAIT_V(6); PG8_BAR; PG8_MMA(1, 1, At, B1); PG8_BAR;
            }
        }
        if constexpr (ALIGN_EPI) { if (wr == 0) PG8_BAR; }
        if constexpr (!Epi::AFTER_DRAIN) { int fr_ = fr, fq_ = fq; asm volatile("" : "+v"(fr_), "+v"(fq_)); E(acc, cur, wr, wc, fr_, fq_); S.done(cur); }
        if (!has_next) break;
#pragma unroll
        for (int a = 0; a < 2; ++a)
#pragma unroll
            for (int b = 0; b < 2; ++b)
#pragma unroll
                for (int m = 0; m < 4; ++m)
#pragma unroll
                    for (int n = 0; n < 2; ++n) acc[a][b][m][n] = (f32x4){0.f, 0.f, 0.f, 0.f};
        cur = nxt; cA = nA; cB = nB; ++ui;
        if constexpr (ALIGN_EPI) { if (wr == 1) PG8_BAR; }
    }
    PG8_WAIT_V(0);
    if constexpr (!ALIGN_EPI) { if (wr == 0) PG8_BAR; }
    PG8_BAR;
    if constexpr (Epi::AFTER_DRAIN) { E.fused(acc, cur, wr, wc, fr, fq, lds, wid, lane); S.done(cur); }
#undef PG8_SA
#undef PG8_SB
#undef PG8_STAGE
#undef PG8_LDA
#undef PG8_LDB
#undef PG8_MMA
#undef PG8_WAIT_V
#undef PG8_WAIT_L
#undef PG8_BAR
#undef PG8_SCHED
}

}

constexpr size_t MiB = 1u << 20;
constexpr size_t WS_CTL = 0;
constexpr size_t WS_SSQ = 64 * 1024;
constexpr size_t WS_ROPE = 1 * MiB;
constexpr size_t WS_LSE = 3 * MiB;
constexpr size_t WS_HGD = 4 * MiB;
constexpr size_t WS_A32 = WS_HGD + 768 * 1024;
constexpr size_t WS_S5E = 5 * MiB;
constexpr size_t WS_W = 13 * MiB;
constexpr size_t W_GU1 = WS_W, W_D1 = W_GU1 + 11 * MiB, W_GU2 = W_D1 + 11 * MiB / 2, W_D2 = W_GU2 + 11 * MiB;
constexpr size_t W_C1 = WS_W + 33 * MiB, W_C2 = W_C1 + 7 * MiB, W_GATE = W_C2 + 9 * MiB, W_BR = W_GATE + 8 * MiB, W_OUT = W_BR + 4 * MiB, W_GLU = W_OUT + 2 * MiB;
constexpr size_t W_S5M = W_GLU + 1 * MiB, W_S5E = W_S5M + 20 * MiB;
constexpr size_t WS_XN = 105 * MiB;
constexpr size_t WS_Y = 137 * MiB;
constexpr size_t WS_MERGED = 201 * MiB;
constexpr size_t WS_R = 233 * MiB;
constexpr size_t R_HQ = WS_R, R_S5A = WS_R + 64 * MiB, R_CONV = WS_R + 84 * MiB, R_HST = WS_R + 116 * MiB;
constexpr size_t R_QKV = WS_R, R_HBUF = WS_R, R_BALL = WS_R;
constexpr size_t WS_END = 381 * MiB;
static_assert(W_S5E + 8 * MiB <= WS_XN && W_D2 + 11 * MiB / 2 <= W_C1, "weight map");
constexpr size_t QKV_WHICH = (size_t)24 * SEQ * 128;

constexpr int LDS_BYTES = 151552;
constexpr int NWAVES = 8, NTHREADS = 512;
constexpr int XB_LDS_OFF = 151040;

struct Args { const float* in[30]; float* out; unsigned char* ws; int ph_lo, ph_hi; };

struct Ctx {
    LAS unsigned char* lds; int tid, lane, wave, G, bid, zo;
    const float* const* in; float* out; unsigned char* ws;
};
#define INP(c, k) ((c).in[(k) + (c).zo])

template <int MT, int NT, int KT>
__device__ __forceinline__ void wave_mma(f32x4 (&acc)[MT][NT], const LAS bf16_t* A, int lda, const LAS bf16_t* Bt, int ldb, int lane) {
    const int r = lane & 15, q = lane >> 4;
#pragma unroll
    for (int kk = 0; kk < KT; ++kk) {
        bf16x8 a[MT], b[NT];
#pragma unroll
        for (int mt = 0; mt < MT; ++mt) a[mt] = *(const LAS bf16x8*)(A + (mt * 16 + r) * lda + kk * 32 + q * 8);
#pragma unroll
        for (int nt = 0; nt < NT; ++nt) b[nt] = *(const LAS bf16x8*)(Bt + (nt * 16 + r) * ldb + kk * 32 + q * 8);
#pragma unroll
        for (int mt = 0; mt < MT; ++mt)
#pragma unroll
            for (int nt = 0; nt < NT; ++nt) acc[mt][nt] = __builtin_amdgcn_mfma_f32_16x16x32_bf16(a[mt], b[nt], acc[mt][nt], 0, 0, 0);
    }
}

__device__ __forceinline__ int rowmap(int kind, int n) {
    if (kind == 0) return n;
    if (kind == 1) return 256 * (n >> 7) + (n & 127);
    if (kind == 2) return 256 * (n >> 7) + 128 + (n & 127);
    const int k = n >> 10, mcol = n & 1023, pn = mcol >> 6, ml = mcol & 63, wc = ml >> 4, fq = (ml & 15) >> 2, i = ml & 3;
    return pn * 256 + 128 * (k >> 1) + 32 * wc + 16 * (k & 1) + 4 * fq + i;
}
__device__ __forceinline__ void transpose_item(const float* W, int ldw, int col0, int K, int Ncols, bf16_t* dst, const float* gain, int kind, LAS float* scr, int item, int lane) {
    const int nblk = Ncols / 32, kb = item / nblk, nb = item % nblk, k0 = 64 * kb, n0 = 32 * nb;
    float v[32];
#pragma unroll
    for (int i = 0; i < 32; ++i) v[i] = W[(size_t)(k0 + 2 * i + (lane >> 5)) * ldw + col0 + n0 + (lane & 31)];
    if (gain) {
#pragma unroll
        for (int i = 0; i < 32; ++i) v[i] *= gain[k0 + 2 * i + (lane >> 5)]; }
#pragma unroll
    for (int i = 0; i < 32; ++i) scr[(2 * i + (lane >> 5)) * 33 + (lane & 31)] = v[i];
    LDS_WAIT(); asm volatile("" ::: "memory");
    const int c = lane & 7;
#pragma unroll
    for (int j = 0; j < 4; ++j) { const int n = (lane >> 3) + 8 * j; const LAS float* s = scr + (8 * c) * 33 + n;
        u32x4 o; o.x = pk2(s[0 * 33], s[1 * 33]); o.y = pk2(s[2 * 33], s[3 * 33]); o.z = pk2(s[4 * 33], s[5 * 33]); o.w = pk2(s[6 * 33], s[7 * 33]);
        *(u32x4*)(dst + (size_t)rowmap(kind, n0 + n) * K + k0 + 8 * c) = o; }
    LDS_WAIT(); asm volatile("" ::: "memory");
}

__device__ __forceinline__ void s5_tables(const Ctx& c, int l, int g, int part) {
    LAS float* pwr = (LAS float*)c.lds; LAS float* pwi = pwr + 2112; LAS float* bbr = pwi + 2112; LAS float* bbi = bbr + 1024;
    LAS float* crT = bbi + 1024; LAS float* ciT = crT + 1024; LAS float* Kj = ciT + 1024;
    const int lg = l * 32 + g, tid = c.tid;
    const float* a_re = INP(c, 10) + lg * 64; const float* a_im = INP(c, 11) + lg * 64; const float* log_dt = INP(c, 12) + lg;
    const float* b_re = INP(c, 13) + (size_t)lg * 1024; const float* b_im = INP(c, 14) + (size_t)lg * 1024;
    const float* c_re = INP(c, 15) + (size_t)lg * 1024; const float* c_im = INP(c, 16) + (size_t)lg * 1024;
    if (tid < 64) {
        const int p = tid; const float dtf = expf(log_dt[0]), arf = a_re[p], aif = a_im[p], magf = expf(arf * dtf);
        const double ar = arf, ai = aif, abr = (double)(magf * cosf(aif * dtf)), abi = (double)(magf * sinf(aif * dtf)), den = ar * ar + ai * ai;
        const double zr = ((abr - 1.0) * ar + abi * ai) / den, zi = (abi * ar - (abr - 1.0) * ai) / den;
        double pr = 1.0, pi = 0.0;
        for (int j = 0; j <= 32; ++j) { pwr[p * 33 + j] = (float)pr; pwi[p * 33 + j] = (float)pi; const double nr = pr * abr - pi * abi, ni = pr * abi + pi * abr; pr = nr; pi = ni; }
        if (part == 0) { float* a32 = (float*)(c.ws + WS_A32) + (g * 64 + p) * 2; a32[0] = pwr[p * 33 + 32]; a32[1] = pwi[p * 33 + 32]; }
        for (int k = 0; k < 16; ++k) { const double br = b_re[p * 16 + k], bi = b_im[p * 16 + k]; bbr[p * 16 + k] = (float)(zr * br - zi * bi); bbi[p * 16 + k] = (float)(zr * bi + zi * br); }
    }
    for (int i = tid; i < 1024; i += NTHREADS) { const int cc = i >> 6, p = i & 63; crT[p * 16 + cc] = c_re[i]; ciT[p * 16 + cc] = c_im[i]; }
    __syncthreads();
    {
        const int j = tid >> 4, c2 = tid & 15; float acc[16];
#pragma unroll
        for (int cc = 0; cc < 16; ++cc) acc[cc] = 0.f;
        for (int p = 0; p < 64; ++p) { const float ar = pwr[p * 33 + j], ai = pwi[p * 33 + j], br = bbr[p * 16 + c2], bi = bbi[p * 16 + c2];
            const float xr = ar * br - ai * bi, xi = ar * bi + ai * br;
#pragma unroll
            for (int q4 = 0; q4 < 4; ++q4) { const f32x4 cr4 = *(const LAS f32x4*)(crT + p * 16 + 4 * q4), ci4 = *(const LAS f32x4*)(ciT + p * 16 + 4 * q4);
#pragma unroll
                for (int e = 0; e < 4; ++e) acc[4 * q4 + e] += cr4[e] * xr - ci4[e] * xi; } }
#pragma unroll
        for (int cc = 0; cc < 16; ++cc) Kj[j * 256 + cc * 16 + c2] = acc[cc];
    }
    __syncthreads();
    bf16_t* dm = (bf16_t*)(c.ws + W_S5M) + (size_t)g * 512 * 640;
    for (int ch = tid; ch < 64 * 80; ch += NTHREADS) { const int row = part * 64 + ch / 80, cch = ch % 80, t = row >> 4, cc = row & 15, col0 = cch * 8; float v[8];
        if (col0 < 64) {
#pragma unroll
            for (int e = 0; e < 8; ++e) { const int p = col0 + e; v[e] = crT[p * 16 + cc] * pwr[p * 33 + t + 1] - ciT[p * 16 + cc] * pwi[p * 33 + t + 1]; }
        } else if (col0 < 128) {
#pragma unroll
            for (int e = 0; e < 8; ++e) { const int p = col0 - 64 + e; v[e] = -(crT[p * 16 + cc] * pwi[p * 33 + t + 1] + ciT[p * 16 + cc] * pwr[p * 33 + t + 1]); }
        } else { const int s = (col0 - 128) >> 4, cb = (col0 - 128) & 15;
#pragma unroll
            for (int e = 0; e < 8; ++e) v[e] = (s <= t) ? Kj[(t - s) * 256 + cc * 16 + cb + e] : 0.f;
        }
        u32x4 o; o.x = pk2(v[0], v[1]); o.y = pk2(v[2], v[3]); o.z = pk2(v[4], v[5]); o.w = pk2(v[6], v[7]);
        *(u32x4*)(dm + (size_t)row * 640 + col0) = o; }
    bf16_t* de = (bf16_t*)(c.ws + W_S5E) + (size_t)g * 256 * 512;
    for (int ch = tid; ch < 32 * 64; ch += NTHREADS) { const int row = part * 32 + (ch >> 6), col0 = (ch & 63) * 8, s = col0 >> 4, cb = col0 & 15; float v[8];
#pragma unroll
        for (int e = 0; e < 8; ++e) {
            if (row < 64) { const int p = row; v[e] = pwr[p * 33 + 31 - s] * bbr[p * 16 + cb + e] - pwi[p * 33 + 31 - s] * bbi[p * 16 + cb + e]; }
            else if (row < 128) { const int p = row - 64; v[e] = pwr[p * 33 + 31 - s] * bbi[p * 16 + cb + e] + pwi[p * 33 + 31 - s] * bbr[p * 16 + cb + e]; }
            else v[e] = 0.f; }
        u32x4 o; o.x = pk2(v[0], v[1]); o.y = pk2(v[2], v[3]); o.z = pk2(v[4], v[5]); o.w = pk2(v[6], v[7]);
        *(u32x4*)(de + (size_t)row * 512 + col0) = o; }
    __syncthreads();
}

__device__ __forceinline__ void phase_wprep(const Ctx& c, int l) {
    for (int u = c.bid; u < 256; u += c.G) s5_tables(c, l, u >> 3, u & 7);
    if (l == 0) {
        const int* pos = (const int*)INP(c, 1); f32x2* rope = (f32x2*)(c.ws + WS_ROPE);
        for (int e = c.bid * NTHREADS + c.tid; e < TOK * 16; e += c.G * NTHREADS) { const int tok = e >> 4, i = e & 15;
            const float ang = (float)pos[tok] * exp2f(-1.1832230355827609f * (float)i); rope[e] = (f32x2){cosf(ang), sinf(ang)}; }
    }
    __syncthreads();
    LAS float* scr = (LAS float*)(c.lds + c.wave * 16384);
    const int gw = c.bid * NWAVES + c.wave, NGW = c.G * NWAVES;
    const float* n1 = INP(c, 2) + l * DM; const float* nm = INP(c, 6) + l * DM; const float* n2 = INP(c, 25) + l * DM;
    const float* wg1 = INP(c, 3) + (size_t)l * DM * DFF; const float* wu1 = INP(c, 4) + (size_t)l * DM * DFF; const float* wd1 = INP(c, 5) + (size_t)l * DFF * DM;
    const float* wg2 = INP(c, 26) + (size_t)l * DM * DFF; const float* wu2 = INP(c, 27) + (size_t)l * DM * DFF; const float* wd2 = INP(c, 28) + (size_t)l * DFF * DM;
    const float* win = INP(c, 7) + (size_t)l * DM * INW; const float* wbr = INP(c, 23) + (size_t)l * 4 * 512 * DM; const float* wout = INP(c, 24) + (size_t)l * DM * DM;
    const float* wglu = INP(c, 18) + (size_t)l * 512 * 1024;
    unsigned char* ws = c.ws;
    for (int it = gw; it < 16384; it += NGW) {
        int r = it;
        if (r < 1408) { transpose_item(wg1, DFF, 0, DM, DFF, (bf16_t*)(ws + W_GU1), n1, 1, scr, r, c.lane); continue; } r -= 1408;
        if (r < 1408) { transpose_item(wu1, DFF, 0, DM, DFF, (bf16_t*)(ws + W_GU1), n1, 2, scr, r, c.lane); continue; } r -= 1408;
        if (r < 1408) { transpose_item(wd1, DM, 0, DFF, DM, (bf16_t*)(ws + W_D1), nullptr, 0, scr, r, c.lane); continue; } r -= 1408;
        if (r < 1408) { transpose_item(wg2, DFF, 0, DM, DFF, (bf16_t*)(ws + W_GU2), n2, 1, scr, r, c.lane); continue; } r -= 1408;
        if (r < 1408) { transpose_item(wu2, DFF, 0, DM, DFF, (bf16_t*)(ws + W_GU2), n2, 2, scr, r, c.lane); continue; } r -= 1408;
        if (r < 1408) { transpose_item(wd2, DM, 0, DFF, DM, (bf16_t*)(ws + W_D2), nullptr, 0, scr, r, c.lane); continue; } r -= 1408;
        if (r < 1792) { transpose_item(win, INW, 0, DM, 3584, (bf16_t*)(ws + W_C1), nm, 0, scr, r, c.lane); continue; } r -= 1792;
        if (r < 2304) { transpose_item(win, INW, 3584, DM, 4608, (bf16_t*)(ws + W_C2), nm, 0, scr, r, c.lane); continue; } r -= 2304;
        if (r < 2048) { transpose_item(win, INW, 8192, DM, 4096, (bf16_t*)(ws + W_GATE), nm, 3, scr, r, c.lane); continue; } r -= 2048;
        if (r < 1024) { const int k = r >> 8; transpose_item(wbr + (size_t)k * 512 * DM, DM, 0, 512, DM, (bf16_t*)(ws + W_BR) + (size_t)k * 1024 * 512, nullptr, 0, scr, r & 255, c.lane); continue; } r -= 1024;
        if (r < 512) { transpose_item(wout, DM, 0, DM, DM, (bf16_t*)(ws + W_OUT), nullptr, 0, scr, r, c.lane); continue; } r -= 512;
        if (r < 128) { transpose_item(wglu, 1024, 0, 512, 512, (bf16_t*)(ws + W_GLU), nullptr, 1, scr, r, c.lane); continue; } r -= 128;
        transpose_item(wglu, 1024, 512, 512, 512, (bf16_t*)(ws + W_GLU), nullptr, 2, scr, r, c.lane);
    }
}

__device__ __forceinline__ void phase_norm_in(const Ctx& c, const float* x, bf16_t* xn, float* ssq) {
    const int gw = c.bid * NWAVES + c.wave, NGW = c.G * NWAVES;
    for (int row = gw; row < TOK; row += NGW) {
        const f32x4* xr = (const f32x4*)(x + (size_t)row * DM) + c.lane; f32x4 v[4]; float s = 0.f;
#pragma unroll
        for (int j = 0; j < 4; ++j) { v[j] = xr[64 * j]; s += (v[j][0] * v[j][0] + v[j][1] * v[j][1]) + (v[j][2] * v[j][2] + v[j][3] * v[j][3]); }
        s = wave_sum(s); if (c.lane == 0) ssq[row] = s;
        u32x2* o = (u32x2*)(xn + (size_t)row * DM) + c.lane;
#pragma unroll
        for (int j = 0; j < 4; ++j) { u32x2 w; w.x = pk2(v[j][0], v[j][1]); w.y = pk2(v[j][2], v[j][3]); o[64 * j] = w; }
    }
}
__device__ __forceinline__ void phase_final_norm(const Ctx& c, float* x, const float* gain, const float* ssq) {
    const int gw = c.bid * NWAVES + c.wave, NGW = c.G * NWAVES;
    for (int row = gw; row < TOK; row += NGW) {
        f32x4* xr = (f32x4*)(x + (size_t)row * DM) + c.lane; const float rs = rsqrtf(ssq[row] * (1.f / DM) + NORM_EPS);
#pragma unroll
        for (int j = 0; j < 4; ++j) { const f32x4 gn = ((const f32x4*)gain)[c.lane + 64 * j]; xr[64 * j] = xr[64 * j] * rs * gn; }
    }
}

constexpr int CV_OB = 62 * 512 * 4, CV_ST = CV_OB + 8 * 512 * 4;
static_assert(CV_ST + 64 <= XB_LDS_OFF, "conv LDS map");
__device__ __forceinline__ void phase_conv(const Ctx& c, int l) {
    LAS float* z = (LAS float*)c.lds; LAS float* ob = (LAS float*)(c.lds + CV_OB); LAS float* st = (LAS float*)(c.lds + CV_ST);
    const bf16_t* cin = (const bf16_t*)(c.ws + R_CONV); bf16_t* yc = (bf16_t*)(c.ws + WS_Y) + (size_t)2 * TOK * 512;
    const int ch = c.tid;
    const float* cw = INP(c, 19) + (size_t)l * 31 * 512; const float cb = INP(c, 20)[l * 512 + ch], lg = INP(c, 21)[l * 512 + ch], lb = INP(c, 22)[l * 512 + ch];
    float w[31];
#pragma unroll
    for (int j = 0; j < 31; ++j) w[j] = cw[j * 512 + ch];
    for (int unit = c.bid; unit < TOK / 32; unit += c.G) {
        const int b = unit >> 8, t0 = (unit & 255) * 32;
        {
            u32x4 av[8], bv[8];
#pragma unroll
            for (int i = 0; i < 8; ++i) { const int id = c.tid + NTHREADS * i, r = id >> 6, cc = id & 63, t = t0 - 30 + r;
                av[i] = (u32x4){0u, 0u, 0u, 0u}; bv[i] = av[i];
                if (r < 62 && t >= 0) { const bf16_t* rp = cin + (size_t)(b * SEQ + t) * 1024 + cc * 8; av[i] = *(const u32x4*)rp; bv[i] = *(const u32x4*)(rp + 512); } }
#pragma unroll
            for (int i = 0; i < 8; ++i) { const int id = c.tid + NTHREADS * i, r = id >> 6, cc = id & 63;
                if (r < 62) { const unsigned aw[4] = {av[i].x, av[i].y, av[i].z, av[i].w}, bw[4] = {bv[i].x, bv[i].y, bv[i].z, bv[i].w}; f32x4 z0, z1;
                    z0[0] = bflo(aw[0]) * sigm(bflo(bw[0])); z0[1] = bfhi(aw[0]) * sigm(bfhi(bw[0])); z0[2] = bflo(aw[1]) * sigm(bflo(bw[1])); z0[3] = bfhi(aw[1]) * sigm(bfhi(bw[1]));
                    z1[0] = bflo(aw[2]) * sigm(bflo(bw[2])); z1[1] = bfhi(aw[2]) * sigm(bfhi(bw[2])); z1[2] = bflo(aw[3]) * sigm(bflo(bw[3])); z1[3] = bfhi(aw[3]) * sigm(bfhi(bw[3]));
                    *(LAS f32x4*)(z + r * 512 + cc * 8) = z0; *(LAS f32x4*)(z + r * 512 + cc * 8 + 4) = z1; } }
        }
        __syncthreads();
#pragma unroll 1
        for (int blk = 0; blk < 4; ++blk) {
            float zr[38];
#pragma unroll
            for (int i = 0; i < 38; ++i) zr[i] = z[(blk * 8 + i) * 512 + ch];
            float o[8];
#pragma unroll
            for (int tt = 0; tt < 8; ++tt) { float a = cb;
#pragma unroll
                for (int j = 0; j < 31; ++j) a += w[j] * zr[tt + j];
                o[tt] = a; ob[tt * 512 + ch] = a; }
            __syncthreads();
            {
                float s1 = 0.f, s2 = 0.f;
#pragma unroll
                for (int j = 0; j < 8; ++j) { const float v = ob[c.wave * 512 + c.lane + 64 * j]; s1 += v; s2 += v * v; }
                s1 = wave_sum(s1); s2 = wave_sum(s2);
                const float mean = s1 * (1.f / 512.f), var = fmaxf(s2 * (1.f / 512.f) - mean * mean, 0.f);
                if (c.lane == 0) { st[c.wave * 2] = mean; st[c.wave * 2 + 1] = rsqrtf(var + NORM_EPS); }
            }
            __syncthreads();
#pragma unroll
            for (int tt = 0; tt < 8; ++tt) { const float y = (o[tt] - st[tt * 2]) * st[tt * 2 + 1] * lg + lb;
                yc[(size_t)(b * SEQ + t0 + blk * 8 + tt) * 512 + ch] = (bf16_t)f2bf(siluf(y)); }
        }
        __syncthreads();
    }
}
#define XB_TMO      128
#define XB_XCNT(j)  (256  + 64 * (j))
#define XB_XSUB(j)  (1280 + 64 * (j))
#define XB_XGEN(j)  (2304 + 64 * (j))
#define XB_TOP      3328
#define XB_TOPGEN   3392
#define XCD_BAR_WORDS 3456
#define XB_SPIN_CAP (1u << 18)

__device__ __forceinline__ unsigned xb_ld(unsigned* p)              { return __hip_atomic_load(p, __ATOMIC_RELAXED, __HIP_MEMORY_SCOPE_AGENT); }
__device__ __forceinline__ unsigned xb_add(unsigned* p, unsigned v) { return __hip_atomic_fetch_add(p, v, __ATOMIC_RELAXED, __HIP_MEMORY_SCOPE_AGENT); }
__device__ __forceinline__ unsigned xb_xcc_id() { return (unsigned)__builtin_amdgcn_s_getreg((3 << 11) | 20) & 0xFu; }
#define XB_SPIN(cond, bar) do { unsigned _sp = 0; while (cond) { __builtin_amdgcn_s_sleep(1); \
    if ((++_sp & 255u) == 0u) { if (xb_ld(&(bar)[XB_TMO])) break; if (_sp > XB_SPIN_CAP) { atomicAdd(&(bar)[XB_TMO], 1u); break; } } } } while (0)

struct XcdBarrier {
    unsigned* bar; unsigned x;
    volatile LAS unsigned* st;
};

__device__ __forceinline__ XcdBarrier xcd_barrier_post(unsigned* bar, volatile LAS unsigned* st) {
    XcdBarrier b; b.bar = bar; b.x = xb_xcc_id(); b.st = st;
    if (threadIdx.x == 0) (void)xb_add(&bar[XB_XCNT(b.x)], 1u);
    return b;
}
__device__ __forceinline__ void xcd_barrier_complete(unsigned* bar, unsigned x, unsigned& nloc, unsigned& nx) {
    const unsigned G = gridDim.x * gridDim.y * gridDim.z;
    unsigned sum, cnt, mine, sp = 0u;
    for (;;) {
        sum = 0u; cnt = 0u; mine = 0u;
#pragma unroll
        for (unsigned j = 0; j < 16; ++j) { const unsigned c = xb_ld(&bar[XB_XCNT(j)]); sum += c; cnt += (c > 0u) ? 1u : 0u; mine = (j == x) ? c : mine; }
        if (sum == G) break;
        __builtin_amdgcn_s_sleep(1);
        if ((++sp & 255u) == 0u) { if (xb_ld(&bar[XB_TMO])) break; if (sp > XB_SPIN_CAP) { atomicAdd(&bar[XB_TMO], 1u); break; } }
    }
    nloc = mine > 0u ? mine : 1u; nx = cnt > 0u ? cnt : 1u;
}

__device__ __forceinline__ void xcd_barrier(const XcdBarrier& b) {
    asm volatile("s_waitcnt vmcnt(0)" ::: "memory");
    __syncthreads();
    if (threadIdx.x == 0) {
        unsigned* bar = b.bar;
        __builtin_amdgcn_s_waitcnt(0);
        unsigned nloc = b.st[0], nx = b.st[1];
        if (nloc == 0u) { xcd_barrier_complete(bar, b.x, nloc, nx); b.st[0] = nloc; b.st[1] = nx; }
        const unsigned old = xb_add(&bar[XB_XSUB(b.x)], 1u);
        const unsigned gen = old / nloc;
        if (old + 1u == (gen + 1u) * nloc) {
            __builtin_amdgcn_fence(__ATOMIC_RELEASE, "agent");
            asm volatile("s_waitcnt vmcnt(0)" ::: "memory");
            const unsigned og = xb_add(&bar[XB_TOP], 1u);
            const unsigned tg = og / nx;
            if (og + 1u == (tg + 1u) * nx) xb_add(&bar[XB_TOPGEN], 1u);
            else XB_SPIN(xb_ld(&bar[XB_TOPGEN]) == tg, bar);
            __builtin_amdgcn_fence(__ATOMIC_ACQUIRE, "agent");
            xb_add(&bar[XB_XGEN(b.x)], 1u);
            asm volatile("s_waitcnt vmcnt(0)" ::: "memory");
        } else {
            XB_SPIN(xb_ld(&bar[XB_XGEN(b.x)]) == gen, bar);
            __builtin_amdgcn_fence(__ATOMIC_ACQUIRE, "agent");
            asm volatile("s_waitcnt vmcnt(0)" ::: "memory");
        }
    }
    __syncthreads();
}

__device__ __forceinline__ float hg_lb(const Ctx& c, int l, int col) {
    if (l == 0) return 0.f;
    const float z0 = INP(c, 8)[col], z1 = INP(c, 8)[512 + col], m = fmaxf(z0, z1), e0 = expf(z0 - m), e1 = expf(z1 - m);
    return e1 / (e0 + e1);
}
__device__ __forceinline__ unsigned short bf1(float x) { return (unsigned short)(pg8::cvt_pk_bf16(x, x) & 0xffffu); }
__device__ __forceinline__ void hg_stage_tile(const bf16_t* src, int row0, int h, LAS bf16_t* dst, int tid) {
#pragma unroll
    for (int i = 0; i < 2; ++i) { const int id = tid + NTHREADS * i, s = id >> 4, cc = id & 15;
        *(LAS u32x4*)(dst + s * 136 + cc * 8) = *(const u32x4*)(src + (size_t)(row0 + s) * 512 + h * 128 + cc * 8); }
}
__device__ __forceinline__ void hg_logf(const LAS bf16_t* fr, float lbv, int k, int rg, LAS float* bL, LAS float* seg, float (&kk)[16]) {
    float run = 0.f;
#pragma unroll
    for (int j = 0; j < 16; ++j) { const int s = rg * 16 + j; const float f = bf2f(fr[s * 136 + k]);
        const float ex = __expf(-f), sg = __builtin_amdgcn_rcpf(1.f + ex);
        const float lf = __logf(lbv + (1.f - lbv) * sg);
        kk[j] = (1.f - lbv) * ex * sg; run += lf; bL[s * 129 + k] = run; }
    seg[rg * 128 + k] = run;
}
__device__ __forceinline__ void hg_load_vT(const bf16_t* hv, int row0, int h, LAS bf16_t* vT, int wave, int lane) {
    u32x4 v[2];
#pragma unroll
    for (int i = 0; i < 2; ++i) v[i] = *(const u32x4*)(hv + (size_t)(row0 + lane) * 512 + h * 128 + (wave + 8 * i) * 8);
#pragma unroll
    for (int i = 0; i < 2; ++i) { const int cc = wave + 8 * i; const unsigned vw[4] = {v[i].x, v[i].y, v[i].z, v[i].w};
#pragma unroll
        for (int e = 0; e < 4; ++e) { vT[(cc * 8 + 2 * e) * 72 + lane] = (bf16_t)(vw[e] & 0xffffu); vT[(cc * 8 + 2 * e + 1) * 72 + lane] = (bf16_t)(vw[e] >> 16); } }
}
constexpr int HG1_KDT = 35072, HG1_VT = 53504, HG1_FR = 71936;
__device__ __forceinline__ void phase_hg1(const Ctx& c, int l) {
    LAS float* bL = (LAS float*)c.lds; LAS float* seg = bL + 64 * 129;
    LAS bf16_t* kdT = (LAS bf16_t*)(c.lds + HG1_KDT); LAS bf16_t* vT = (LAS bf16_t*)(c.lds + HG1_VT); LAS bf16_t* fr = (LAS bf16_t*)(c.lds + HG1_FR);
    const bf16_t* hf = (const bf16_t*)(c.ws + R_HQ) + (size_t)TOK * 512; const bf16_t* hv = hf + (size_t)TOK * 512;
    bf16_t* hst = (bf16_t*)(c.ws + R_HST); float* hgd = (float*)(c.ws + WS_HGD);
    const int k = c.tid & 127, rg = c.tid >> 7, r = c.lane & 15, q = c.lane >> 4;
    for (int unit = c.bid; unit < 1024; unit += c.G) {
        const int b = unit >> 9, n = (unit >> 2) & 127, h = unit & 3, row0 = b * SEQ + n * 64, col = h * 128 + k;
        const float lbv = hg_lb(c, l, col);
        float kk[16];
        hg_stage_tile(hf, row0, h, fr, c.tid);
        hg_load_vT(hv, row0, h, vT, c.wave, c.lane);
        __syncthreads();
        hg_logf(fr, lbv, k, rg, bL, seg, kk);
        __syncthreads();
        float pre = 0.f;
        for (int s = 0; s < rg; ++s) pre += seg[s * 128 + k];
        const float blast = (seg[k] + seg[128 + k]) + (seg[256 + k] + seg[384 + k]);
        unsigned w[8];
#pragma unroll
        for (int j = 0; j < 8; ++j) { const int s = rg * 16 + 2 * j;
            const float b0 = bL[s * 129 + k] + pre, b1 = bL[(s + 1) * 129 + k] + pre;
            w[j] = pg8::cvt_pk_bf16(kk[2 * j] * __expf(blast - b0), kk[2 * j + 1] * __expf(blast - b1)); }
        { LAS u32x4* d = (LAS u32x4*)(kdT + k * 72 + rg * 16); d[0] = (u32x4){w[0], w[1], w[2], w[3]}; d[1] = (u32x4){w[4], w[5], w[6], w[7]}; }
        if (rg == 0) hgd[unit * 128 + k] = __expf(blast);
        __syncthreads();
        f32x4 acc[1][8];
#pragma unroll
        for (int nt = 0; nt < 8; ++nt) acc[0][nt] = (f32x4){0.f, 0.f, 0.f, 0.f};
        wave_mma<1, 8, 2>(acc, vT + (16 * c.wave) * 72, 72, kdT, 72, c.lane);
        bf16_t* dst = hst + (size_t)unit * 16384;
#pragma unroll
        for (int nt = 0; nt < 8; ++nt)
#pragma unroll
            for (int j = 0; j < 4; ++j) dst[(16 * c.wave + 4 * q + j) * 128 + nt * 16 + r] = bf1(acc[0][nt][j]);
        __syncthreads();
    }
}
__device__ __forceinline__ void phase_hg2(const Ctx& c) {
    bf16_t* hst = (bf16_t*)(c.ws + R_HST); const float* hgd = (const float*)(c.ws + WS_HGD);
    for (int idx = c.bid * NTHREADS + c.tid; idx < 65536; idx += c.G * NTHREADS) {
        const int bh = idx >> 13, e2 = idx & 8191, b = bh >> 2, h = bh & 3, kc = (e2 * 2) & 127;
        float s0 = 0.f, s1 = 0.f;
        for (int n0 = 0; n0 < 128; n0 += 16) {
            unsigned u[16]; f32x2 d[16];
#pragma unroll
            for (int i = 0; i < 16; ++i) { const int unit = (b * 128 + n0 + i) * 4 + h; u[i] = ((const unsigned*)(hst + (size_t)unit * 16384))[e2]; d[i] = *(const f32x2*)(hgd + unit * 128 + kc); }
#pragma unroll
            for (int i = 0; i < 16; ++i) { const int unit = (b * 128 + n0 + i) * 4 + h; ((unsigned*)(hst + (size_t)unit * 16384))[e2] = pk2(s0, s1);
                s0 = d[i][0] * s0 + bflo(u[i]); s1 = d[i][1] * s1 + bfhi(u[i]); }
        }
    }
}
constexpr int HG3_QD = 35072, HG3_ST = 52480, HG3_QT = 87296, HG3_KT = 104704, HG3_P = 122112, HG3_VT = 131328;
static_assert(HG3_VT + 128 * 72 * 2 <= LDS_BYTES, "hg3 LDS map");
__device__ __forceinline__ void phase_hg3(const Ctx& c, int l) {
    LAS float* bL = (LAS float*)c.lds; LAS float* seg = bL + 64 * 129;
    LAS bf16_t* qd = (LAS bf16_t*)(c.lds + HG3_QD); LAS bf16_t* ST = (LAS bf16_t*)(c.lds + HG3_ST); LAS bf16_t* qt = (LAS bf16_t*)(c.lds + HG3_QT);
    LAS bf16_t* kt = (LAS bf16_t*)(c.lds + HG3_KT); LAS bf16_t* P = (LAS bf16_t*)(c.lds + HG3_P); LAS bf16_t* vT = (LAS bf16_t*)(c.lds + HG3_VT);
    const bf16_t* hq = (const bf16_t*)(c.ws + R_HQ); const bf16_t* hf = hq + (size_t)TOK * 512; const bf16_t* hv = hf + (size_t)TOK * 512; const bf16_t* hg = hv + (size_t)TOK * 512;
    const bf16_t* hst = (const bf16_t*)(c.ws + R_HST); bf16_t* ya = (bf16_t*)(c.ws + WS_Y);
    const float* gnorm = INP(c, 9) + l * 512;
    const int k = c.tid & 127, rg = c.tid >> 7, r = c.lane & 15, q = c.lane >> 4, w = c.wave;
    for (int unit = c.bid; unit < 1024; unit += c.G) {
        const int b = unit >> 9, n = (unit >> 2) & 127, h = unit & 3, row0 = b * SEQ + n * 64, col = h * 128 + k;
        const float lbv = hg_lb(c, l, col);
        float kk[16];
        hg_stage_tile(hf, row0, h, qt, c.tid);
        hg_stage_tile(hq, row0, h, kt, c.tid);
        hg_load_vT(hv, row0, h, vT, c.wave, c.lane);
#pragma unroll
        for (int i = 0; i < 4; ++i) { const int id = c.tid + NTHREADS * i, v = id >> 4, cc = id & 15;
            *(LAS u32x4*)(ST + v * 136 + cc * 8) = *(const u32x4*)(hst + (size_t)unit * 16384 + v * 128 + cc * 8); }
        __syncthreads();
        hg_logf(qt, lbv, k, rg, bL, seg, kk);
        __syncthreads();
        float pre = 0.f;
        for (int s = 0; s < rg; ++s) pre += seg[s * 128 + k];
        const float bref = bL[31 * 129 + k] + seg[k];
#pragma unroll
        for (int j = 0; j < 16; ++j) { const int s = rg * 16 + j; const float bv = bL[s * 129 + k] + pre;
            const float qf = siluf(bf2f(kt[s * 136 + k])) * 0.08838834764831845f;
            qd[s * 136 + k] = bf1(qf * __expf(bv));
            qt[s * 136 + k] = bf1(qf * __expf(fminf(bv - bref, 80.f)));
            kt[s * 136 + k] = bf1(kk[j] * __expf(fminf(bref - bv, 80.f))); }
        __syncthreads();
        {
            f32x4 a2[1][2] = {{(f32x4){0.f, 0.f, 0.f, 0.f}, (f32x4){0.f, 0.f, 0.f, 0.f}}};
            wave_mma<1, 2, 4>(a2, qt + (16 * (w >> 1)) * 136, 136, kt + (32 * (w & 1)) * 136, 136, c.lane);
#pragma unroll
            for (int nt = 0; nt < 2; ++nt)
#pragma unroll
                for (int j = 0; j < 4; ++j) { const int t = 16 * (w >> 1) + 4 * q + j, s = 32 * (w & 1) + nt * 16 + r; P[t * 72 + s] = bf1(s <= t ? a2[0][nt][j] : 0.f); }
        }
        __syncthreads();
        {
            f32x4 a4[1][4];
#pragma unroll
            for (int nt = 0; nt < 4; ++nt) a4[0][nt] = (f32x4){0.f, 0.f, 0.f, 0.f};
            wave_mma<1, 4, 4>(a4, qd + (16 * (w >> 1)) * 136, 136, ST + (64 * (w & 1)) * 136, 136, c.lane);
            wave_mma<1, 4, 2>(a4, P + (16 * (w >> 1)) * 72, 72, vT + (64 * (w & 1)) * 72, 72, c.lane);
#pragma unroll
            for (int nt = 0; nt < 4; ++nt)
#pragma unroll
                for (int j = 0; j < 4; ++j) bL[(16 * (w >> 1) + 4 * q + j) * 129 + 64 * (w & 1) + nt * 16 + r] = a4[0][nt][j];
        }
        __syncthreads();
        {
            const int t = c.tid >> 3, v0 = (c.tid & 7) * 16; float o[16]; float ss = 0.f;
#pragma unroll
            for (int e = 0; e < 16; ++e) { o[e] = bL[t * 129 + v0 + e]; ss += o[e] * o[e]; }
            ss += __shfl_xor(ss, 1); ss += __shfl_xor(ss, 2); ss += __shfl_xor(ss, 4);
            const float rs = 1.f / sqrtf(ss * (1.f / 128.f) + NORM_EPS);
            const bf16_t* gp = hg + (size_t)(row0 + t) * 512 + h * 128 + v0; const u32x4 g0 = *(const u32x4*)gp, g1 = *(const u32x4*)(gp + 8);
            const unsigned gw[8] = {g0.x, g0.y, g0.z, g0.w, g1.x, g1.y, g1.z, g1.w}; unsigned ow[8];
#pragma unroll
            for (int e = 0; e < 8; ++e) { const float ga = bflo(gw[e]), gb = bfhi(gw[e]);
                ow[e] = pg8::cvt_pk_bf16(o[2 * e] * rs * gnorm[h * 128 + v0 + 2 * e] * siluf(ga), o[2 * e + 1] * rs * gnorm[h * 128 + v0 + 2 * e + 1] * siluf(gb)); }
            bf16_t* yp = ya + (size_t)(row0 + t) * 512 + h * 128 + v0;
            *(u32x4*)yp = (u32x4){ow[0], ow[1], ow[2], ow[3]}; *(u32x4*)(yp + 8) = (u32x4){ow[4], ow[5], ow[6], ow[7]};
        }
        __syncthreads();
    }
}

__device__ __forceinline__ void phase_s5scan(const Ctx& c) {
    const int idx = c.bid * NTHREADS + c.tid;
    if (idx >= 4096) return;
    const int b = idx >> 11, g = (idx >> 6) & 31, p = idx & 63;
    const float* a32 = (const float*)(c.ws + WS_A32) + (g * 64 + p) * 2; const float ar = a32[0], ai = a32[1];
    bf16_t* s5A = (bf16_t*)(c.ws + R_S5A); const float* E = (const float*)(c.ws + WS_S5E);
    float xr = 0.f, xi = 0.f;
    for (int n0 = 0; n0 < 256; n0 += 32) {
        float er[32], ei[32];
#pragma unroll
        for (int i = 0; i < 32; ++i) { const size_t row = (size_t)g * 512 + b * 256 + n0 + i; er[i] = E[row * 128 + p]; ei[i] = E[row * 128 + 64 + p]; }
#pragma unroll
        for (int i = 0; i < 32; ++i) { const size_t row = (size_t)g * 512 + b * 256 + n0 + i; s5A[row * 640 + p] = (bf16_t)f2bf(xr); s5A[row * 640 + 64 + p] = (bf16_t)f2bf(xi);
            const float nr = ar * xr - ai * xi + er[i], ni = ar * xi + ai * xr + ei[i]; xr = nr; xi = ni; }
    }
}

constexpr int AT_K = 17408, AT_VT = 69632, AT_S = 120832;
static_assert(AT_S + 32 * 196 * 4 <= LDS_BYTES, "attention LDS map");
__device__ __forceinline__ float wave_max(float v) {
#pragma unroll
    for (int o = 1; o < 64; o <<= 1) v = fmaxf(v, __shfl_xor(v, o));
    return v;
}
__device__ __forceinline__ void attn_stage_rope(LAS bf16_t* dst, const bf16_t* src, const f32x2* rope_b, int first, int nrows, int sh, int res, int tid) {
    for (int id = tid; id < nrows * 16; id += NTHREADS) {
        const int row = id >> 4, cc = id & 15, idx = first + row; u32x4 v = (u32x4){0u, 0u, 0u, 0u};
        if (idx >= 0) { const int tok = (idx << sh) + res; const bf16_t* rp = src + (size_t)tok * 128;
            v = *(const u32x4*)(rp + cc * 8);
            if (cc < 4) { const u32x4 pv = *(const u32x4*)(rp + (cc ^ 2) * 8); const f32x4* cs = (const f32x4*)(rope_b + (size_t)tok * 16 + 8 * (cc & 1));
                const unsigned vw[4] = {v.x, v.y, v.z, v.w}, pw[4] = {pv.x, pv.y, pv.z, pv.w}; unsigned ow[4];
#pragma unroll
                for (int e = 0; e < 4; ++e) { const f32x4 t = cs[e];
                    const float x0 = bflo(vw[e]), x1 = bfhi(vw[e]), y0 = bflo(pw[e]), y1 = bfhi(pw[e]);
                    float o0, o1;
                    if (cc < 2) { o0 = x0 * t[0] - y0 * t[1]; o1 = x1 * t[2] - y1 * t[3]; }
                    else        { o0 = x0 * t[0] + y0 * t[1]; o1 = x1 * t[2] + y1 * t[3]; }
                    ow[e] = pk2(o0, o1); }
                v = (u32x4){ow[0], ow[1], ow[2], ow[3]}; } }
        *(LAS u32x4*)(dst + row * 136 + cc * 8) = v; }
}
__device__ __forceinline__ void phase_attn(const Ctx& c) {
    LAS bf16_t* Qs = (LAS bf16_t*)c.lds; LAS bf16_t* Ks = (LAS bf16_t*)(c.lds + AT_K); LAS bf16_t* Vt = (LAS bf16_t*)(c.lds + AT_VT); LAS float* S = (LAS float*)(c.lds + AT_S);
    bf16_t* qkv = (bf16_t*)(c.ws + R_QKV); float* lse = (float*)(c.ws + WS_LSE); const f32x2* rope = (const f32x2*)(c.ws + WS_ROPE);
    const int r = c.lane & 15, q = c.lane >> 4, w = c.wave;
    for (int unit = c.bid; unit < 3072; unit += c.G) {
        const int bh = unit >> 7, u7 = unit & 127, b = bh / 12, h = bh % 12, sh = 2 * (h >> 2), per = 128 >> sh, res = u7 / per, jb = u7 % per;
        const int i0 = 64 * jb, j0 = i0 - 128;
        bf16_t* qb = qkv + (size_t)bh * SEQ * 128; const bf16_t* kb = qkv + QKV_WHICH + (size_t)bh * SEQ * 128; const bf16_t* vb = qkv + 2 * QKV_WHICH + (size_t)bh * SEQ * 128;
        const f32x2* rope_b = rope + (size_t)b * SEQ * 16;
        attn_stage_rope(Qs, qb, rope_b, i0, 64, sh, res, c.tid);
        attn_stage_rope(Ks, kb, rope_b, j0, 192, sh, res, c.tid);
#pragma unroll
        for (int ps = 0; ps < 3; ++ps)
#pragma unroll
            for (int hf = 0; hf < 2; ++hf) { const int kk = ps * 64 + c.lane, cc = w + 8 * hf, idx = j0 + kk; u32x4 v = (u32x4){0u, 0u, 0u, 0u};
                if (idx >= 0) v = *(const u32x4*)(vb + (size_t)((idx << sh) + res) * 128 + cc * 8);
                const unsigned vw[4] = {v.x, v.y, v.z, v.w};
#pragma unroll
                for (int e = 0; e < 4; ++e) { Vt[(cc * 8 + 2 * e) * 200 + kk] = (bf16_t)(vw[e] & 0xffffu); Vt[(cc * 8 + 2 * e + 1) * 200 + kk] = (bf16_t)(vw[e] >> 16); } }
        __syncthreads();
#pragma unroll 1
        for (int hq = 0; hq < 2; ++hq) {
            {
                f32x4 a3[1][3];
#pragma unroll
                for (int nt = 0; nt < 3; ++nt) a3[0][nt] = (f32x4){0.f, 0.f, 0.f, 0.f};
                wave_mma<1, 3, 4>(a3, Qs + (32 * hq + 16 * (w & 1)) * 136, 136, Ks + (48 * (w >> 1)) * 136, 136, c.lane);
#pragma unroll
                for (int nt = 0; nt < 3; ++nt)
#pragma unroll
                    for (int j = 0; j < 4; ++j) { const int t = 16 * (w & 1) + 4 * q + j, kk = 48 * (w >> 1) + nt * 16 + r, i = i0 + 32 * hq + t, jn = j0 + kk;
                        const bool ok = (jn >= 0) && (jn <= i) && (i - jn <= 128);
                        S[t * 196 + kk] = ok ? a3[0][nt][j] * 0.08838834764831845f : -1e30f; }
            }
            __syncthreads();
#pragma unroll
            for (int rr = 0; rr < 4; ++rr) { const int t = 4 * w + rr; LAS float* sr = S + t * 196;
                const float s0 = sr[c.lane], s1 = sr[64 + c.lane], s2 = sr[128 + c.lane];
                const float m = wave_max(fmaxf(s0, fmaxf(s1, s2)));
                const float e0 = __expf(s0 - m), e1 = __expf(s1 - m), e2 = __expf(s2 - m);
                const float sum = wave_sum(e0 + e1 + e2), inv = 1.f / sum;
                LAS bf16_t* pr = (LAS bf16_t*)sr;
                pr[c.lane] = (bf16_t)f2bf(e0 * inv); pr[64 + c.lane] = (bf16_t)f2bf(e1 * inv); pr[128 + c.lane] = (bf16_t)f2bf(e2 * inv);
                if (c.lane == 0) lse[(size_t)bh * SEQ + (((i0 + 32 * hq + t) << sh) + res)] = m + logf(sum); }
            __syncthreads();
            {
                f32x4 a2[1][2] = {{(f32x4){0.f, 0.f, 0.f, 0.f}, (f32x4){0.f, 0.f, 0.f, 0.f}}};
                wave_mma<1, 2, 6>(a2, (LAS bf16_t*)S + (16 * (w & 1)) * 392, 392, Vt + (32 * (w >> 1)) * 200, 200, c.lane);
#pragma unroll
                for (int nt = 0; nt < 2; ++nt)
#pragma unroll
                    for (int j = 0; j < 4; ++j) { const int t = 16 * (w & 1) + 4 * q + j, dim = 32 * (w >> 1) + nt * 16 + r, tok = ((i0 + 32 * hq + t) << sh) + res;
                        qb[(size_t)tok * 128 + dim] = (bf16_t)f2bf(a2[0][nt][j]); }
            }
            __syncthreads();
        }
    }
}
__device__ __forceinline__ void phase_attn_merge(const Ctx& c) {
    const bf16_t* qkv = (const bf16_t*)(c.ws + R_QKV); const float* lse = (const float*)(c.ws + WS_LSE); bf16_t* yd = (bf16_t*)(c.ws + WS_Y) + (size_t)3 * TOK * 512;
    for (int id = c.bid * NTHREADS + c.tid; id < TOK * 64; id += c.G * NTHREADS) {
        const int row = id >> 6, hp = (id >> 4) & 3, cc = id & 15, b = row >> 13, t = row & 8191;
        float lw[3]; u32x4 ov[3];
#pragma unroll
        for (int g = 0; g < 3; ++g) { const int bh = b * 12 + g * 4 + hp; lw[g] = lse[(size_t)bh * SEQ + t]; ov[g] = *(const u32x4*)(qkv + ((size_t)bh * SEQ + t) * 128 + cc * 8); }
        const float m = fmaxf(lw[0], fmaxf(lw[1], lw[2])); float e[3], s = 0.f;
#pragma unroll
        for (int g = 0; g < 3; ++g) { e[g] = __expf(lw[g] - m); s += e[g]; }
        const float inv = 1.f / s; float o[8];
#pragma unroll
        for (int i = 0; i < 8; ++i) o[i] = 0.f;
#pragma unroll
        for (int g = 0; g < 3; ++g) { const float wg = e[g] * inv; const unsigned vw[4] = {ov[g].x, ov[g].y, ov[g].z, ov[g].w};
#pragma unroll
            for (int i = 0; i < 4; ++i) { o[2 * i] += wg * bflo(vw[i]); o[2 * i + 1] += wg * bfhi(vw[i]); } }
        *(u32x4*)(yd + (size_t)row * 512 + hp * 128 + cc * 8) = (u32x4){pk2(o[0], o[1]), pk2(o[2], o[3]), pk2(o[4], o[5]), pk2(o[6], o[7])};
    }
}

#ifndef MK_REP
#define MK_REP -1
#endif
constexpr int PH_PER_LAYER = 15, PH_SEQ = PH_PER_LAYER + (MK_REP >= 0 ? 1 : 0), N_PHASES = NLAYER * PH_SEQ + 1;
#ifndef MK_MASK
#define MK_MASK 0xFFFFF
#endif
#ifndef MK_CG_SYNC
#define MK_CG_SYNC 0
#endif
#ifndef MK_SPLIT
#define MK_SPLIT 0
#endif

template <class Epi> __device__ __forceinline__ void run_gemm(const Ctx& c, const bf16_t* A, int lda, const bf16_t* Bt, int ldb, int K, int N, const Epi& E) {
    pg8::Gemm g{A, Bt, lda, ldb, K}; pg8::StaticOrder S; S.init(TOK, N, c.G, c.bid, lda, ldb);
    int t_ = c.tid; asm volatile("" : "+v"(t_));
    pg8::gemm_phase<Epi, pg8::StaticOrder, true, true>(c.lds, g, S, E, t_);
}

__global__ void __launch_bounds__(NTHREADS, 2) hgpm_fwd(Args args) {
    extern __shared__ __attribute__((aligned(16))) unsigned char lds_raw[];
    Ctx c; c.lds = (LAS unsigned char*)lds_raw; c.G = gridDim.x; c.bid = blockIdx.x; c.in = args.in;
    volatile LAS unsigned* xb_st = (volatile LAS unsigned*)(c.lds + XB_LDS_OFF);
    if (threadIdx.x < 4) xb_st[threadIdx.x] = 0u;
    __syncthreads();
    XcdBarrier bar = xcd_barrier_post((unsigned*)(args.ws + WS_CTL), xb_st);

    for (int ph = args.ph_lo; ph < args.ph_hi; ++ph) {
        const int l = ph / PH_SEQ, pi_ = ph % PH_SEQ, p = (MK_REP >= 0 && pi_ > MK_REP) ? pi_ - 1 : pi_;
        { int t_ = threadIdx.x; asm volatile("" : "+v"(t_)); c.tid = t_; c.lane = t_ & 63; c.wave = __builtin_amdgcn_readfirstlane(t_ >> 6); }
        { int z_ = 0; asm volatile("" : "+s"(z_)); c.zo = z_; c.ws = args.ws + z_; c.out = args.out + z_; }
        unsigned char* ws = c.ws;
        bf16_t* XN = (bf16_t*)(ws + WS_XN); bf16_t* Y = (bf16_t*)(ws + WS_Y); bf16_t* MERGED = (bf16_t*)(ws + WS_MERGED); bf16_t* Z = MERGED;
        bf16_t* HBUF = (bf16_t*)(ws + R_HBUF); bf16_t* BALL = (bf16_t*)(ws + R_BALL); bf16_t* S5A = (bf16_t*)(ws + R_S5A);
        float* SSQ = (float*)(ws + WS_SSQ);
        float* ssq_b = SSQ + (size_t)(3 * l) * TOK; float* ssq_c = ssq_b + TOK; float* ssq_d = ssq_c + TOK;
        const float* ssq_a = (l == 0) ? SSQ + (size_t)6 * TOK : SSQ + (size_t)(3 * l - 1) * TOK;
        if (ph == N_PHASES - 1) { phase_final_norm(c, c.out, INP(c, 29), SSQ + (size_t)(3 * NLAYER - 1) * TOK); }
        else switch (p) {
        case 0: phase_wprep(c, l); if (l == 0) phase_norm_in(c, INP(c, 0), XN, SSQ + (size_t)6 * TOK); break;
        case 1: run_gemm(c, XN, DM, (const bf16_t*)(ws + W_GU1), DM, DM, 2 * DFF, pg8::EpiGated<0>{HBUF, DFF, ssq_a}); break;
        case 13: run_gemm(c, XN, DM, (const bf16_t*)(ws + W_GU2), DM, DM, 2 * DFF, pg8::EpiGated<0>{HBUF, DFF, ssq_c}); break;
        case 2: run_gemm(c, HBUF, DFF, (const bf16_t*)(ws + W_D1), DFF, DFF, DM, pg8::EpiResid{l == 0 ? INP(c, 0) : c.out, c.out, 0.5f, XN, ssq_b}); break;
        case 14: run_gemm(c, HBUF, DFF, (const bf16_t*)(ws + W_D2), DFF, DFF, DM, pg8::EpiResid{c.out, c.out, 0.5f, XN, ssq_d}); break;
        case 3: run_gemm(c, XN, DM, (const bf16_t*)(ws + W_C1), DM, DM, 3584, pg8::EpiC1{(bf16_t*)(ws + R_HQ), S5A, (bf16_t*)(ws + R_CONV), ssq_b}); break;
        case 4: { pg8::Gemm g{S5A, (const bf16_t*)(ws + W_S5E), 640, 512, 512}; pg8::S5eOrder S{c.G, c.bid};
                  pg8::gemm_phase<pg8::EpiS5e, pg8::S5eOrder, true, true>(c.lds, g, S, pg8::EpiS5e{(float*)(ws + WS_S5E)}, c.tid);
                  phase_hg1(c, l); phase_conv(c, l); } break;
        case 5: phase_hg2(c); phase_s5scan(c); break;
        case 6: { pg8::Gemm g{S5A, (const bf16_t*)(ws + W_S5M), 640, 640, 640}; pg8::S5mOrder S{c.G, c.bid};
                  pg8::gemm_phase<pg8::EpiS5m, pg8::S5mOrder, true, true>(c.lds, g, S, pg8::EpiS5m{S5A, INP(c, 17) + l * 512, Z}, c.tid);
                  phase_hg3(c, l); } break;
        case 7: run_gemm(c, Z, 512, (const bf16_t*)(ws + W_GLU), 512, 512, 1024, pg8::EpiGated<1>{Y + (size_t)TOK * 512, 512, nullptr});
                run_gemm(c, XN, DM, (const bf16_t*)(ws + W_C2), DM, DM, 4608, pg8::EpiC2{(bf16_t*)(ws + R_QKV), ssq_b}); break;
        case 8: phase_attn(c); break;
        case 9: phase_attn_merge(c); break;
        case 10: { pg8::Gemm g{Y, (const bf16_t*)(ws + W_BR), 512, 512, 512}; pg8::BranchOrder S; S.init(c.G, c.bid);
                   pg8::gemm_phase<pg8::EpiBranch, pg8::BranchOrder, true, true>(c.lds, g, S, pg8::EpiBranch{BALL}, c.tid); } break;
        case 11: run_gemm(c, XN, DM, (const bf16_t*)(ws + W_GATE), DM, DM, 4096, pg8::EpiGateMerge{BALL, MERGED, ssq_b}); break;
        case 12: run_gemm(c, MERGED, DM, (const bf16_t*)(ws + W_OUT), DM, DM, DM, pg8::EpiResid{c.out, c.out, 1.0f, XN, ssq_c}); break;
        }
        if (ph + 1 < args.ph_hi) {
#if MK_CG_SYNC
            __syncthreads(); cg::this_grid().sync();
#else
            xcd_barrier(bar);
#endif
        }
    }
}

extern "C" void kernel_launch(void* const* d_in, const int* in_sizes, int n_in, void* d_out, int out_size, void* d_ws, size_t ws_size, hipStream_t stream) {
    static int grid = 0;
    if (grid == 0) {
        if (n_in != 30 || in_sizes[0] != TOK * DM || out_size != TOK * DM || ws_size < WS_END) {
            fprintf(stderr, "kernel_launch: unexpected problem: n_in %d, in0 %d, out %d, ws %zu (need %zu)\n", n_in, n_in > 0 ? in_sizes[0] : -1, out_size, ws_size, (size_t)WS_END); grid = -1; return; }
        int dev = 0, cus = 0, per_cu = 0;
        if (hipGetDevice(&dev) != hipSuccess || hipDeviceGetAttribute(&cus, hipDeviceAttributeMultiprocessorCount, dev) != hipSuccess) { fprintf(stderr, "kernel_launch: device query failed\n"); grid = -1; return; }
        if (hipFuncSetAttribute((const void*)hgpm_fwd, hipFuncAttributeMaxDynamicSharedMemorySize, LDS_BYTES) != hipSuccess) { fprintf(stderr, "kernel_launch: hipFuncSetAttribute failed\n"); grid = -1; return; }
        if (hipOccupancyMaxActiveBlocksPerMultiprocessor(&per_cu, (const void*)hgpm_fwd, NTHREADS, LDS_BYTES) != hipSuccess || per_cu < 1) { fprintf(stderr, "kernel_launch: occupancy query says %d blocks per CU\n", per_cu); (void)hipGetLastError(); grid = -1; return; }
        grid = cus * 1;
    }
    if (grid < 0) return;
    (void)hipMemsetAsync((char*)d_ws + WS_CTL, 0, 1 * MiB, stream);
    Args a{};
    for (int i = 0; i < 30; ++i) a.in[i] = (const float*)d_in[i];
    a.out = (float*)d_out; a.ws = (unsigned char*)d_ws;
#if MK_SPLIT
    for (int ph = 0; ph < N_PHASES; ++ph) { a.ph_lo = ph; a.ph_hi = ph + 1; hipLaunchKernelGGL(hgpm_fwd, dim3(grid), dim3(NTHREADS), LDS_BYTES, stream, a); }
#else
    a.ph_lo = 0; a.ph_hi = N_PHASES;
    void* kargs[] = {&a};
    const hipError_t e = hipLaunchCooperativeKernel((const void*)hgpm_fwd, dim3(grid), dim3(NTHREADS), kargs, LDS_BYTES, stream);
    if (e != hipSuccess) fprintf(stderr, "kernel_launch: cooperative launch failed: %s (grid %d)\n", hipGetErrorString(e), grid);
#endif
}
```

```cpp
#include <hip/hip_runtime.h>
#include <hip/hip_cooperative_groups.h>
#include <cstdio>
#include <cstdint>
namespace cg = cooperative_groups;

#define LAS __attribute__((address_space(3)))
typedef unsigned short bf16_t;
typedef short bf16x8 __attribute__((ext_vector_type(8)));
typedef float f32x4 __attribute__((ext_vector_type(4)));
typedef float f32x2 __attribute__((ext_vector_type(2)));
typedef unsigned u32x4 __attribute__((ext_vector_type(4)));
typedef unsigned u32x2 __attribute__((ext_vector_type(2)));

constexpr int BATCH = 2, SEQ = 8192, TOK = BATCH * SEQ, DM = 1024, DFF = 2816, NLAYER = 2, INW = 12288;
constexpr float NORM_EPS = 1e-6f;

__device__ __forceinline__ unsigned f2bf(float f) { unsigned u = __builtin_bit_cast(unsigned, f); return (u + 0x7fffu + ((u >> 16) & 1u)) >> 16; }
__device__ __forceinline__ float bf2f(unsigned b) { return __builtin_bit_cast(float, b << 16); }
__device__ __forceinline__ unsigned pk2(float lo, float hi) { return f2bf(lo) | (f2bf(hi) << 16); }
__device__ __forceinline__ float bflo(unsigned w) { return __builtin_bit_cast(float, w << 16); }
__device__ __forceinline__ float bfhi(unsigned w) { return __builtin_bit_cast(float, w & 0xffff0000u); }
__device__ __forceinline__ float sigm(float x) { return 1.f / (1.f + __expf(-x)); }
__device__ __forceinline__ float siluf(float x) { return x / (1.f + __expf(-x)); }
__device__ __forceinline__ float gelu_tanh(float x) { const float y = 0.7978845608028654f * (x + 0.044715f * x * x * x); const float t = 1.f - 2.f / (1.f + __expf(2.f * y)); return 0.5f * x * (1.f + t); }
__device__ __forceinline__ float wave_sum(float v) {
#pragma unroll
    for (int o = 1; o < 64; o <<= 1) v += __shfl_xor(v, o);
    return v;
}
#define LDS_WAIT() asm volatile("s_waitcnt lgkmcnt(0)" ::: "memory")

namespace pg8 {
#define PG8_LAS __attribute__((address_space(3)))
constexpr int BM = 256, BK = 64, HALF = 128, HTB = HALF * BK * 2  , STAGE_BYTES = 8 * HTB, NXCD = 8, WGM = 8;

__host__ __device__ __forceinline__ int lds_byte(int r, int c) { const int st = (r >> 4) * 2 + (c >> 5), rr = r & 15, cc = c & 31, ob = rr * 64 + cc * 2; return st * 1024 + (ob ^ (((ob >> 9) & 1) << 5)); }
__host__ __device__ __forceinline__ void stage_rc(int b, int& R, int& C) { const int st = b / 1024, sb = b % 1024, swz = sb ^ (((sb >> 9) & 1) << 5); R = (st >> 1) * 16 + swz / 64; C = (st & 1) * 32 + (swz % 64) / 2; }
__host__ __device__ __forceinline__ int perm32(int rho) { const int n = rho >> 4, i = rho & 15; return 8 * (i >> 2) + 4 * n + (i & 3); }

struct Unit { int pm, pn, grp, aux; size_t aoff, boff; };
struct Gemm { const bf16_t* A; const bf16_t* Bt; int lda, ldb, K; };

struct StaticOrder {
    int nM, nN, nwg, G, c, lda, ldb;
    __device__ __forceinline__ void init(int M, int N, int G_, int c_, int lda_, int ldb_) { nM = M / BM; nN = N / BM; nwg = nM * nN; G = G_; c = c_; lda = lda_; ldb = ldb_; }
    __device__ __forceinline__ bool next(int i, Unit& u) const {
        const long L = (long)i * G + c; if (L >= nwg) return false;
        int wgid = (int)L; { const int q = nwg / NXCD, r = nwg % NXCD, xcd = wgid % NXCD, off = wgid / NXCD; wgid = (xcd < r ? xcd * (q + 1) : r * (q + 1) + (xcd - r) * q) + off; }
        const int nig = WGM * nN, gid = wgid / nig, fm = gid * WGM, gsz = (nM - fm) < WGM ? (nM - fm) : WGM;
        u.pm = fm + ((wgid % nig) % gsz); u.pn = (wgid % nig) / gsz; u.grp = 0; u.aux = 0;
        u.aoff = (size_t)u.pm * 256 * lda * 2; u.boff = (size_t)u.pn * 256 * ldb * 2; return true;
    }
    __device__ __forceinline__ void a_ready(const Unit&) const {}
    __device__ __forceinline__ void done(const Unit&) const {}
};
struct BranchOrder {
    StaticOrder so;
    __device__ __forceinline__ void init(int G_, int c_) { so.init(TOK, 1024, G_, c_, 512, 512); }
    __device__ __forceinline__ bool next(int i, Unit& u) const {
        const long L = (long)i * so.G + so.c; if (L >= 1024) return false;
        const int k = (int)(L >> 8); StaticOrder s2 = so; s2.G = 256; s2.c = (int)(L & 255);
        if (!s2.next(0, u)) return false;
        u.grp = k; u.aoff += (size_t)k * TOK * 512 * 2; u.boff += (size_t)k * 1024 * 512 * 2; return true;
    }
    __device__ __forceinline__ void a_ready(const Unit&) const {}
    __device__ __forceinline__ void done(const Unit&) const {}
};
struct S5eOrder {
    int G, c;
    __device__ __forceinline__ bool next(int i, Unit& u) const {
        const long L = (long)i * G + c; if (L >= 64) return false;
        const int g = (int)L >> 1, pm = (int)L & 1; u.pm = pm; u.pn = 0; u.grp = g; u.aux = 0;
        u.aoff = ((size_t)(g * 512 + pm * 256) * 640 + 128) * 2; u.boff = (size_t)g * 256 * 512 * 2; return true;
    }
    __device__ __forceinline__ void a_ready(const Unit&) const {}
    __device__ __forceinline__ void done(const Unit&) const {}
};
struct S5mOrder {
    int G, c;
    __device__ __forceinline__ bool next(int i, Unit& u) const {
        const long L = (long)i * G + c; if (L >= 128) return false;
        const int g = (int)L >> 2, pm = ((int)L >> 1) & 1, pn = (int)L & 1; u.pm = pm; u.pn = pn; u.grp = g; u.aux = 0;
        u.aoff = (size_t)(g * 512 + pm * 256) * 640 * 2; u.boff = (size_t)(g * 512 + pn * 256) * 640 * 2; return true;
    }
    __device__ __forceinline__ void a_ready(const Unit&) const {}
    __device__ __forceinline__ void done(const Unit&) const {}
};

struct VtOrder {
    int gi, idx;
    __device__ __forceinline__ bool next(int i, Unit& u) const {
        if (i > 0 || idx < 0) return false;
        const int sh = 2 * gi, pm = idx & 1, rest = idx >> 1, b = rest >> 5, r5 = rest & 31, pos0 = r5 * 256, res = pos0 >> (13 - sh), idx0 = pos0 & ((8192 >> sh) - 1), tok0 = (idx0 << sh) + res;
        u.pm = pm; u.pn = r5; u.grp = gi | (b << 2); u.aux = pos0;
        u.aoff = (size_t)(3072 + gi * 512 + pm * 256) * 1024 * 2; u.boff = (size_t)(b * SEQ + tok0) * 1024 * 2; return true;
    }
    __device__ __forceinline__ void a_ready(const Unit&) const {}
    __device__ __forceinline__ void done(const Unit&) const {}
};

typedef __bf16 bf16x2_t __attribute__((ext_vector_type(2)));
__device__ __forceinline__ unsigned cvt_pk_bf16(float lo, float hi) { const f32x2 v = {lo, hi}; const bf16x2_t b = __builtin_convertvector(v, bf16x2_t); return __builtin_bit_cast(unsigned, b); }
__device__ __forceinline__ u32x4 pack8(const f32x4& v0, const f32x4& v1) { u32x4 w; w.x = cvt_pk_bf16(v0[0], v0[1]); w.y = cvt_pk_bf16(v0[2], v0[3]); w.z = cvt_pk_bf16(v1[0], v1[1]); w.w = cvt_pk_bf16(v1[2], v1[3]); return w; }

template <int MODE> struct EpiGated {
    static constexpr bool PERM = true, AFTER_DRAIN = false;
    bf16_t* O; int ldo; const float* ssq;
    __device__ __forceinline__ void operator()(const f32x4 (&acc)[2][2][4][2], const Unit& u, int wr, int wc, int fr, int fq) const {
        const int row0 = u.pm * BM + wr * 64 + fr, col0 = u.pn * 128 + wc * 32 + 8 * fq;
#pragma unroll
        for (int ai = 0; ai < 2; ++ai)
#pragma unroll
            for (int m = 0; m < 4; ++m) { const int row = row0 + ai * HALF + m * 16; bf16_t* rowp = O + (size_t)row * ldo + col0;
                const float rs = ssq ? rsqrtf(ssq[row] * (1.f / DM) + NORM_EPS) : 1.f;
                f32x4 v[2];
#pragma unroll
                for (int n = 0; n < 2; ++n)
#pragma unroll
                    for (int j = 0; j < 4; ++j) { const float a = acc[ai][0][m][n][j] * rs, b = acc[ai][1][m][n][j] * rs; v[n][j] = (MODE == 0) ? siluf(a) * b : a * sigm(b); }
                *(u32x4*)rowp = pack8(v[0], v[1]); asm volatile("" ::: "memory"); }
    }
};
struct EpiResid {
    static constexpr bool PERM = false, AFTER_DRAIN = false;
    const float* base; float* out; float scale; bf16_t* xn; float* ssq;
    __device__ __forceinline__ void operator()(const f32x4 (&acc)[2][2][4][2], const Unit& u, int wr, int wc, int fr, int fq) const {
        const int row0 = u.pm * BM + wr * 64 + fr, col0 = u.pn * BM + wc * 32 + 4 * fq;
#pragma unroll
        for (int ai = 0; ai < 2; ++ai)
#pragma unroll
            for (int m = 0; m < 4; ++m) { const int row = row0 + ai * HALF + m * 16; const size_t off = (size_t)row * DM + col0; float ss = 0.f;
#pragma unroll
                for (int bj = 0; bj < 2; ++bj)
#pragma unroll
                    for (int n = 0; n < 2; ++n) { const size_t o = off + bj * HALF + n * 16; const f32x4 b = *(const f32x4*)(base + o); const f32x4 v = b + scale * acc[ai][bj][m][n];
                        *(f32x4*)(out + o) = v; ss += (v[0] * v[0] + v[1] * v[1]) + (v[2] * v[2] + v[3] * v[3]);
                        u32x2 w; w.x = cvt_pk_bf16(v[0], v[1]); w.y = cvt_pk_bf16(v[2], v[3]); *(u32x2*)(xn + o) = w; }
                ss += __shfl_xor(ss, 16); ss += __shfl_xor(ss, 32);
                if (fq == 0) atomicAdd(ssq + row, ss);
                asm volatile("" ::: "memory"); }
    }
};
struct EpiC1 {
    static constexpr bool PERM = true, AFTER_DRAIN = false;
    bf16_t* hq; bf16_t* s5A; bf16_t* convin; const float* ssq;
    __device__ __forceinline__ void operator()(const f32x4 (&acc)[2][2][4][2], const Unit& u, int wr, int wc, int fr, int fq) const {
        const int pn = u.pn, rowb = u.pm * BM + wr * 64 + fr, cl = wc * 32 + 8 * fq;
        bf16_t* p0; int sAI, sM1, sM0, sBJ;
        if (pn < 8) { p0 = hq + (size_t)(pn >> 1) * TOK * 512 + (size_t)rowb * 512 + (pn & 1) * 256 + cl; sAI = 128 * 512; sM1 = 32 * 512; sM0 = 16 * 512; sBJ = 128; }
        else if (pn < 10) { const int c5 = (pn - 8) * 256 + cl, g = c5 >> 4, ch = c5 & 15;
            p0 = s5A + ((size_t)(g * 512 + u.pm * 8 + 2 * wr) * 640 + 128 + fr * 16 + ch); sAI = 4 * 640; sM1 = 640; sM0 = 256; sBJ = 8 * 512 * 640; }
        else { p0 = convin + (size_t)rowb * 1024 + (pn - 10) * 256 + cl; sAI = 128 * 1024; sM1 = 32 * 1024; sM0 = 16 * 1024; sBJ = 128; }
#pragma unroll
        for (int ai = 0; ai < 2; ++ai)
#pragma unroll
            for (int m = 0; m < 4; ++m) { const float rs = rsqrtf(ssq[rowb + ai * HALF + m * 16] * (1.f / DM) + NORM_EPS);
#pragma unroll
                for (int bj = 0; bj < 2; ++bj)
                    *(u32x4*)(p0 + (size_t)(ai * sAI + (m >> 1) * sM1 + (m & 1) * sM0 + bj * sBJ)) = pack8(acc[ai][bj][m][0] * rs, acc[ai][bj][m][1] * rs);
                asm volatile("" ::: "memory"); }
    }
};
struct EpiQK {
    static constexpr bool PERM = true, AFTER_DRAIN = false;
    bf16_t* qkv; const float* ssq; const f32x2* rope;
    __device__ __forceinline__ void operator()(const f32x4 (&acc)[2][2][4][2], const Unit& u, int wr, int wc, int fr, int fq) const {
        const int which = u.pn / 6, hp = u.pn % 6, rowt = u.pm * BM, b = rowt >> 13, t0 = (rowt & 8191) + wr * 64 + fr;
        const float qs = which == 0 ? 0.08838834764831845f : 1.f;
#pragma unroll
        for (int ai = 0; ai < 2; ++ai)
#pragma unroll
            for (int m = 0; m < 4; ++m) { const int t = t0 + ai * HALF + m * 16; const float rs = rsqrtf(ssq[b * SEQ + t] * (1.f / DM) + NORM_EPS) * qs;
                f32x4 cs[4];
                if (wc == 0) { const f32x4* cp = (const f32x4*)(rope + (size_t)(b * SEQ + t) * 16 + 8 * (fq & 1));
#pragma unroll
                    for (int e = 0; e < 4; ++e) cs[e] = cp[e]; }
#pragma unroll
                for (int bj = 0; bj < 2; ++bj) { const int head = 2 * hp + bj, sh = 2 * (head >> 2), pos = ((t & ((1 << sh) - 1)) << (13 - sh)) + (t >> sh);
                    f32x4 v0 = acc[ai][bj][m][0] * rs, v1 = acc[ai][bj][m][1] * rs;
                    if (wc == 0) {
                        f32x4 p0, p1;
#pragma unroll
                        for (int j = 0; j < 4; ++j) { p0[j] = __shfl_xor(v0[j], 32); p1[j] = __shfl_xor(v1[j], 32); }
                        const float sg = fq < 2 ? -1.f : 1.f;
                        v0[0] = v0[0] * cs[0][0] + sg * p0[0] * cs[0][1]; v0[1] = v0[1] * cs[0][2] + sg * p0[1] * cs[0][3];
                        v0[2] = v0[2] * cs[1][0] + sg * p0[2] * cs[1][1]; v0[3] = v0[3] * cs[1][2] + sg * p0[3] * cs[1][3];
                        v1[0] = v1[0] * cs[2][0] + sg * p1[0] * cs[2][1]; v1[1] = v1[1] * cs[2][2] + sg * p1[1] * cs[2][3];
                        v1[2] = v1[2] * cs[3][0] + sg * p1[2] * cs[3][1]; v1[3] = v1[3] * cs[3][2] + sg * p1[3] * cs[3][3]; }
                    *(u32x4*)(qkv + ((size_t)(which * 24 + b * 12 + head) * SEQ + pos) * 128 + wc * 32 + 8 * fq) = pack8(v0, v1); }
                asm volatile("" ::: "memory"); }
    }
};
struct EpiVt {
    static constexpr bool PERM = true, AFTER_DRAIN = false;
    bf16_t* vt;
    __device__ __forceinline__ void operator()(const f32x4 (&acc)[2][2][4][2], const Unit& u, int wr, int wc, int fr, int fq) const {
        const int gi = u.grp & 3, b = u.grp >> 2;
        bf16_t* p0 = vt + ((size_t)(b * 12 + 4 * gi + 2 * u.pm) * 128 + wr * 64 + fr) * SEQ + u.aux + wc * 32 + 8 * fq;
#pragma unroll
        for (int ai = 0; ai < 2; ++ai)
#pragma unroll
            for (int m = 0; m < 4; ++m) {
#pragma unroll
                for (int bj = 0; bj < 2; ++bj)
                    *(u32x4*)(p0 + (size_t)(ai * HALF + m * 16) * SEQ + bj * HALF) = pack8(acc[ai][bj][m][0], acc[ai][bj][m][1]);
                asm volatile("" ::: "memory"); }
    }
};
struct EpiS5e {
    static constexpr bool PERM = false, AFTER_DRAIN = false;
    float* E;
    __device__ __forceinline__ void operator()(const f32x4 (&acc)[2][2][4][2], const Unit& u, int wr, int wc, int fr, int fq) const {
        const int row0 = u.pm * BM + wr * 64 + fr, col0 = wc * 32 + 4 * fq;
#pragma unroll
        for (int ai = 0; ai < 2; ++ai)
#pragma unroll
            for (int m = 0; m < 4; ++m) { float* rowp = E + (size_t)(u.grp * 512 + row0 + ai * HALF + m * 16) * 128 + col0;
#pragma unroll
                for (int n = 0; n < 2; ++n) *(f32x4*)(rowp + n * 16) = acc[ai][0][m][n]; }
    }
};
struct EpiS5m {
    static constexpr bool PERM = true, AFTER_DRAIN = false;
    const bf16_t* s5A; const float* dskip; bf16_t* Z;
    __device__ __forceinline__ void operator()(const f32x4 (&acc)[2][2][4][2], const Unit& u, int wr, int wc, int fr, int fq) const {
        const int g = u.grp, chunk0 = u.pm * BM + wr * 64 + fr, c0 = 8 * (fq & 1), t0 = u.pn * 16 + 2 * wc + (fq >> 1);
        const f32x4 d0 = *(const f32x4*)(dskip + g * 16 + c0), d1 = *(const f32x4*)(dskip + g * 16 + c0 + 4);
        const bf16_t* up = s5A + (size_t)(g * 512 + chunk0) * 640 + 128 + t0 * 16 + c0;
        bf16_t* zp = Z + (size_t)(chunk0 * 32 + t0) * 512 + g * 16 + c0;
#pragma unroll
        for (int ai = 0; ai < 2; ++ai)
#pragma unroll
            for (int m = 0; m < 4; ++m) {
#pragma unroll
                for (int bj = 0; bj < 2; ++bj) {
                    const u32x4 uu = *(const u32x4*)(up + (size_t)(ai * HALF + m * 16) * 640 + bj * 128);
                    f32x4 v0 = acc[ai][bj][m][0], v1 = acc[ai][bj][m][1];
                    v0[0] += d0[0] * bflo(uu.x); v0[1] += d0[1] * bfhi(uu.x); v0[2] += d0[2] * bflo(uu.y); v0[3] += d0[3] * bfhi(uu.y);
                    v1[0] += d1[0] * bflo(uu.z); v1[1] += d1[1] * bfhi(uu.z); v1[2] += d1[2] * bflo(uu.w); v1[3] += d1[3] * bfhi(uu.w);
#pragma unroll
                    for (int j = 0; j < 4; ++j) { v0[j] = gelu_tanh(v0[j]); v1[j] = gelu_tanh(v1[j]); }
                    *(u32x4*)(zp + (size_t)(ai * HALF + m * 16) * 32 * 512 + bj * 8 * 512) = pack8(v0, v1); }
                asm volatile("" ::: "memory"); }
    }
};
struct EpiBranch {
    static constexpr bool PERM = true, AFTER_DRAIN = false;
    bf16_t* Ball;
    __device__ __forceinline__ void operator()(const f32x4 (&acc)[2][2][4][2], const Unit& u, int wr, int wc, int fr, int fq) const {
        const int row0 = u.pm * BM + wr * 64 + fr, col0 = u.grp * 1024 + u.pn * BM + wc * 32 + 8 * fq;
#pragma unroll
        for (int ai = 0; ai < 2; ++ai)
#pragma unroll
            for (int m = 0; m < 4; ++m) { bf16_t* rowp = Ball + (size_t)(row0 + ai * HALF + m * 16) * 4096 + col0;
#pragma unroll
                for (int bj = 0; bj < 2; ++bj) *(u32x4*)(rowp + bj * HALF) = pack8(acc[ai][bj][m][0], acc[ai][bj][m][1]); }
    }
};
struct EpiGateMerge {
    static constexpr bool PERM = false, AFTER_DRAIN = false;
    const bf16_t* Ball; bf16_t* merged; const float* ssq;
    __device__ __forceinline__ void operator()(const f32x4 (&acc)[2][2][4][2], const Unit& u, int wr, int wc, int fr, int fq) const {
        const int row0 = u.pm * BM + wr * 64 + fr, mc = u.pn * 64 + wc * 16 + 4 * fq;
#pragma unroll
        for (int ai = 0; ai < 2; ++ai)
#pragma unroll
            for (int m = 0; m < 4; ++m) { const int row = row0 + ai * HALF + m * 16; const bf16_t* bp = Ball + (size_t)row * 4096 + mc;
                const float rs = rsqrtf(ssq[row] * (1.f / DM) + NORM_EPS);
                f32x4 s = {0.f, 0.f, 0.f, 0.f};
#pragma unroll
                for (int bj = 0; bj < 2; ++bj)
#pragma unroll
                    for (int n = 0; n < 2; ++n) { const u32x2 bv = *(const u32x2*)(bp + (2 * bj + n) * 1024); const f32x4 gt = acc[ai][bj][m][n] * rs;
                        s[0] += sigm(gt[0]) * bflo(bv.x); s[1] += sigm(gt[1]) * bfhi(bv.x); s[2] += sigm(gt[2]) * bflo(bv.y); s[3] += sigm(gt[3]) * bfhi(bv.y); }
                u32x2 w; w.x = cvt_pk_bf16(s[0], s[1]); w.y = cvt_pk_bf16(s[2], s[3]);
                *(u32x2*)(merged + (size_t)row * DM + mc) = w; }
    }
};

template <class Epi, class Sched, bool ALIGN_EPI = false, bool SP2 = false>
__device__ __forceinline__ void gemm_phase(PG8_LAS unsigned char* lds, const Gemm g, const Sched& S, const Epi& E, int tid_opaque) {
    const int tid = tid_opaque, wid = __builtin_amdgcn_readfirstlane(tid >> 6), lane = tid & 63, wr = wid >> 2, wc = wid & 3, fr = lane & 15, fq = lane >> 4;
    const int K = g.K, nt = K / BK, lda = g.lda, ldb = g.ldb;
    unsigned voffA[2], voffB[2];
#pragma unroll
    for (int i = 0; i < 2; ++i) { int R, C; stage_rc(tid * 16 + i * 8192, R, C); const int Rb = Epi::PERM ? ((R & ~31) + perm32(R & 31)) : R;
        voffA[i] = (unsigned)(R * lda + C) * 2u; voffB[i] = (unsigned)(Rb * ldb + C) * 2u; }
    const size_t kstep = (size_t)(BK * 2);
    const size_t hstepA = (size_t)HALF * lda * 2, hstepB = (size_t)HALF * ldb * 2;

    const unsigned ldsw = (unsigned)wid * 1024u;
    const int aoff = lds_byte(wr * 64 + fr, fq * 8), boff = lds_byte(wc * 32 + fr, fq * 8);
#define PG8_SA(b, h) (((b) * 2 + (h)) * HTB)
#define PG8_SB(b, h) ((4 + (b) * 2 + (h)) * HTB)
#define PG8_STAGE(bufoff, gbase, voff) do { _Pragma("unroll") for (int _i = 0; _i < 2; ++_i) \
        __builtin_amdgcn_global_load_lds((const unsigned*)((const char*)(gbase) + (voff)[_i]), (PG8_LAS unsigned*)(lds + (bufoff) + ldsw + _i * 8192), 16, 0, 0); } while (0)
#define PG8_LDA(dst, b, h) do { _Pragma("unroll") for (int m = 0; m < 4; ++m) _Pragma("unroll") for (int k = 0; k < 2; ++k) dst[m][k] = *(const PG8_LAS bf16x8*)(lds + PG8_SA(b, h) + aoff + m * 2048 + k * 1024); } while (0)
#define PG8_LDB(dst, b, h) do { _Pragma("unroll") for (int n = 0; n < 2; ++n) _Pragma("unroll") for (int k = 0; k < 2; ++k) dst[n][k] = *(const PG8_LAS bf16x8*)(lds + PG8_SB(b, h) + boff + n * 2048 + k * 1024); } while (0)
#define PG8_MMA(ai, bj, At, Bt) do { __builtin_amdgcn_s_setprio(1); _Pragma("unroll") for (int m = 0; m < 4; ++m) _Pragma("unroll") for (int n = 0; n < 2; ++n) _Pragma("unroll") for (int k = 0; k < 2; ++k) \
        acc[ai][bj][m][n] = __builtin_amdgcn_mfma_f32_16x16x32_bf16(Bt[n][k], At[m][k], acc[ai][bj][m][n], 0, 0, 0); __builtin_amdgcn_s_setprio(0); } while (0)
#define PG8_WAIT_V(n) asm volatile("s_waitcnt vmcnt(" #n ")" ::: "memory")
#define PG8_WAIT_L(n) asm volatile("s_waitcnt lgkmcnt(" #n ")" ::: "memory")
#define PG8_BAR __builtin_amdgcn_s_barrier()
#define PG8_SCHED __builtin_amdgcn_sched_barrier(0)
    Unit cur, nxt; int ui = 0;
    if (!S.next(0, cur)) return;
    f32x4 acc[2][2][4][2];
#pragma unroll
    for (int a = 0; a < 2; ++a)
#pragma unroll
        for (int b = 0; b < 2; ++b)
#pragma unroll
            for (int m = 0; m < 4; ++m)
#pragma unroll
                for (int n = 0; n < 2; ++n) acc[a][b][m][n] = (f32x4){0.f, 0.f, 0.f, 0.f};
    bf16x8 At[4][2], B0[2][2], B1[2][2];
    const char* cA = (const char*)g.A + cur.aoff; const char* cB = (const char*)g.Bt + cur.boff;
    S.a_ready(cur);
    if constexpr (SP2) {
        PG8_STAGE(PG8_SB(0, 0), cB, voffB); PG8_STAGE(PG8_SB(0, 1), cB + hstepB, voffB); PG8_STAGE(PG8_SA(0, 0), cA, voffA); PG8_STAGE(PG8_SA(0, 1), cA + hstepA, voffA);
        if (wr == 1) PG8_BAR;
        PG8_WAIT_V(2); PG8_BAR;
        PG8_STAGE(PG8_SB(1, 0), cB + kstep, voffB); PG8_STAGE(PG8_SA(1, 0), cA + kstep, voffA); PG8_STAGE(PG8_SB(1, 1), cB + hstepB + kstep, voffB);
        PG8_WAIT_V(6); PG8_BAR;
    } else {
        PG8_STAGE(PG8_SB(0, 0), cB, voffB); PG8_STAGE(PG8_SA(0, 0), cA, voffA); PG8_STAGE(PG8_SB(0, 1), cB + hstepB, voffB); PG8_STAGE(PG8_SA(0, 1), cA + hstepA, voffA);
        if (wr == 1) PG8_BAR;
        PG8_WAIT_V(4); PG8_BAR;
        PG8_STAGE(PG8_SB(1, 0), cB + kstep, voffB); PG8_STAGE(PG8_SA(1, 0), cA + kstep, voffA); PG8_STAGE(PG8_SB(1, 1), cB + hstepB + kstep, voffB);
        PG8_WAIT_V(6); PG8_BAR;
    }
    for (;;) {
        const bool has_next = S.next(ui + 1, nxt);
        const char* nA = has_next ? (const char*)g.A + nxt.aoff : cA; const char* nB = has_next ? (const char*)g.Bt + nxt.boff : cB;
        for (int t = 0; t < nt; t += 2) {
            const bool last = (t == nt - 2);
            const char* a1 = cA + (size_t)(t + 1) * kstep;
            const char* a2 = last ? nA : cA + (size_t)(t + 2) * kstep; const char* b2 = last ? nB : cB + (size_t)(t + 2) * kstep;
            const char* a3 = a2 + kstep; const char* b3 = b2 + kstep;
            if (last && has_next) S.a_ready(nxt);
            if constexpr (SP2) {
            PG8_LDB(B0, 0, 0); PG8_LDB(B1, 0, 1); PG8_SCHED; PG8_LDA(At, 0, 0); PG8_STAGE(PG8_SA(1, 1), a1 + hstepA, voffA);
            PG8_WAIT_V(8); PG8_WAIT_L(0); PG8_BAR; PG8_MMA(0, 0, At, B0); PG8_MMA(0, 1, At, B1); PG8_BAR; PG8_SCHED;
            PG8_LDA(At, 0, 1); PG8_STAGE(PG8_SB(0, 0), b2, voffB); PG8_STAGE(PG8_SB(0, 1), b2 + hstepB, voffB); PG8_STAGE(PG8_SA(0, 0), a2, voffA);
            PG8_WAIT_V(8); PG8_WAIT_L(0); PG8_BAR; PG8_MMA(1, 0, At, B0); PG8_MMA(1, 1, At, B1); PG8_BAR; PG8_SCHED;
            PG8_LDB(B0, 1, 0); PG8_LDB(B1, 1, 1); PG8_SCHED; PG8_LDA(At, 1, 0); PG8_STAGE(PG8_SA(0, 1), a2 + hstepA, voffA);
            PG8_WAIT_V(8); PG8_WAIT_L(0); PG8_BAR; PG8_MMA(0, 0, At, B0); PG8_MMA(0, 1, At, B1); PG8_BAR; PG8_SCHED;
            PG8_LDA(At, 1, 1); PG8_STAGE(PG8_SB(1, 0), b3, voffB); PG8_STAGE(PG8_SB(1, 1), b3 + hstepB, voffB); PG8_STAGE(PG8_SA(1, 0), a3, voffA);
            PG8_WAIT_V(8); PG8_WAIT_L(0); PG8_BAR; PG8_MMA(1, 0, At, B0); PG8_MMA(1, 1, At, B1); PG8_BAR; PG8_SCHED;
            } else {
            PG8_LDB(B0, 0, 0); PG8_SCHED; PG8_LDA(At, 0, 0); PG8_STAGE(PG8_SA(1, 1), a1 + hstepA, voffA);
            PG8_WAIT_L(8); PG8_BAR; PG8_WAIT_L(0); PG8_MMA(0, 0, At, B0); PG8_BAR; PG8_SCHED;
            PG8_LDB(B1, 0, 1); PG8_STAGE(PG8_SB(0, 0), b2, voffB);
            PG8_BAR; PG8_WAIT_L(0); PG8_MMA(0, 1, At, B1); PG8_BAR;
            PG8_LDA(At, 0, 1); PG8_STAGE(PG8_SA(0, 0), a2, voffA);
            PG8_BAR; PG8_WAIT_L(0); PG8_MMA(1, 0, At, B0); PG8_BAR; PG8_SCHED;
            PG8_STAGE(PG8_SB(0, 1), b2 + hstepB, voffB);
            PG8_WAIT_V(6); PG8_BAR; PG8_MMA(1, 1, At, B1); PG8_BAR;
            PG8_LDB(B0, 1, 0); PG8_SCHED; PG8_LDA(At, 1, 0); PG8_STAGE(PG8_SA(0, 1), a2 + hstepA, voffA);
            PG8_WAIT_L(8); PG8_BAR; PG8_WAIT_L(0); PG8_MMA(0, 0, At, B0); PG8_BAR; PG8_SCHED;
            PG8_LDB(B1, 1, 1); PG8_STAGE(PG8_SB(1, 0), b3, voffB);
            PG8_BAR; PG8_WAIT_L(0); PG8_MMA(0, 1, At, B1); PG8_BAR;
            PG8_LDA(At, 1, 1); PG8_STAGE(PG8_SA(1, 0), a3, voffA);
            PG8_BAR; PG8_WAIT_L(0); PG8_MMA(1, 0, At, B0); PG8_BAR; PG8_SCHED;
            PG8_STAGE(PG8_SB(1, 1), b3 + hstepB, voffB);
            PG8_WAIT_V(6); PG8_BAR; PG8_MMA(1, 1, At, B1); PG8_BAR;
            }
        }
        if constexpr (ALIGN_EPI) { if (wr == 0) PG8_BAR; }
        if constexpr (!Epi::AFTER_DRAIN) { int fr_ = fr, fq_ = fq; asm volatile("" : "+v"(fr_), "+v"(fq_)); E(acc, cur, wr, wc, fr_, fq_); S.done(cur); }
        if (!has_next) break;
#pragma unroll
        for (int a = 0; a < 2; ++a)
#pragma unroll
            for (int b = 0; b < 2; ++b)
#pragma unroll
                for (int m = 0; m < 4; ++m)
#pragma unroll
                    for (int n = 0; n < 2; ++n) acc[a][b][m][n] = (f32x4){0.f, 0.f, 0.f, 0.f};
        cur = nxt; cA = nA; cB = nB; ++ui;
        if constexpr (ALIGN_EPI) { if (wr == 1) PG8_BAR; }
    }
    PG8_WAIT_V(0);
    if constexpr (!ALIGN_EPI) { if (wr == 0) PG8_BAR; }
    PG8_BAR;
    if constexpr (Epi::AFTER_DRAIN) { E.fused(acc, cur, wr, wc, fr, fq, lds, wid, lane); S.done(cur); }
#undef PG8_SA
#undef PG8_SB
#undef PG8_STAGE
#undef PG8_LDA
#undef PG8_LDB
#undef PG8_MMA
#undef PG8_WAIT_V
#undef PG8_WAIT_L
#undef PG8_BAR
#undef PG8_SCHED
}

}

constexpr size_t MiB = 1u << 20;
constexpr size_t WS_CTL = 0;
constexpr size_t WS_SSQ = 64 * 1024;
constexpr size_t WS_ROPE = 1 * MiB;
constexpr size_t WS_LSE = 3 * MiB;
constexpr size_t WS_HGD = 4 * MiB;
constexpr size_t WS_A32 = WS_HGD + 768 * 1024;
constexpr size_t WS_S5E = 5 * MiB;
constexpr size_t WS_W = 13 * MiB;
constexpr size_t W_GU1 = WS_W, W_D1 = W_GU1 + 11 * MiB, W_GU2 = W_D1 + 11 * MiB / 2, W_D2 = W_GU2 + 11 * MiB;
constexpr size_t W_C1 = WS_W + 33 * MiB, W_C2 = W_C1 + 7 * MiB, W_GATE = W_C2 + 9 * MiB, W_BR = W_GATE + 8 * MiB, W_OUT = W_BR + 4 * MiB, W_GLU = W_OUT + 2 * MiB;
constexpr size_t W_S5M = W_GLU + 1 * MiB, W_S5E = W_S5M + 20 * MiB;
constexpr size_t WS_XN = 105 * MiB;
constexpr size_t WS_Y = 137 * MiB;
constexpr size_t WS_MERGED = 201 * MiB;
constexpr size_t WS_R = 233 * MiB;
constexpr size_t R_HQ = WS_R, R_S5A = WS_R + 64 * MiB, R_CONV = WS_R + 84 * MiB, R_HST = WS_R + 116 * MiB;
constexpr size_t R_QKV = WS_R, R_HBUF = WS_R, R_BALL = WS_R;
constexpr size_t WS_END = 381 * MiB;
static_assert(W_S5E + 8 * MiB <= WS_XN && W_D2 + 11 * MiB / 2 <= W_C1, "weight map");
constexpr size_t QKV_WHICH = (size_t)24 * SEQ * 128;

constexpr int LDS_BYTES = 163840;
constexpr int NWAVES = 8, NTHREADS = 512;
constexpr int XB_LDS_OFF = 163328;

struct Args { const float* in[30]; float* out; unsigned char* ws; int ph_lo, ph_hi; };

struct Ctx {
    LAS unsigned char* lds; int tid, lane, wave, G, bid, zo;
    const float* const* in; float* out; unsigned char* ws;
};
#define INP(c, k) ((c).in[(k) + (c).zo])

template <int MT, int NT, int KT>
__device__ __forceinline__ void wave_mma(f32x4 (&acc)[MT][NT], const LAS bf16_t* A, int lda, const LAS bf16_t* Bt, int ldb, int lane) {
    const int r = lane & 15, q = lane >> 4;
#pragma unroll
    for (int kk = 0; kk < KT; ++kk) {
        bf16x8 a[MT], b[NT];
#pragma unroll
        for (int mt = 0; mt < MT; ++mt) a[mt] = *(const LAS bf16x8*)(A + (mt * 16 + r) * lda + kk * 32 + q * 8);
#pragma unroll
        for (int nt = 0; nt < NT; ++nt) b[nt] = *(const LAS bf16x8*)(Bt + (nt * 16 + r) * ldb + kk * 32 + q * 8);
#pragma unroll
        for (int mt = 0; mt < MT; ++mt)
#pragma unroll
            for (int nt = 0; nt < NT; ++nt) acc[mt][nt] = __builtin_amdgcn_mfma_f32_16x16x32_bf16(a[mt], b[nt], acc[mt][nt], 0, 0, 0);
    }
}

__device__ __forceinline__ int rowmap(int kind, int n) {
    if (kind == 0) return n;
    if (kind == 1) return 256 * (n >> 7) + (n & 127);
    if (kind == 2) return 256 * (n >> 7) + 128 + (n & 127);
    const int k = n >> 10, mcol = n & 1023, pn = mcol >> 6, ml = mcol & 63, wc = ml >> 4, fq = (ml & 15) >> 2, i = ml & 3;
    return pn * 256 + 128 * (k >> 1) + 32 * wc + 16 * (k & 1) + 4 * fq + i;
}
__device__ __forceinline__ void transpose_item(const float* W, int ldw, int col0, int K, int Ncols, bf16_t* dst, const float* gain, int kind, LAS float* scr, int item, int lane) {
    const int nblk = Ncols / 32, kb = item / nblk, nb = item % nblk, k0 = 64 * kb, n0 = 32 * nb;
    float v[32];
#pragma unroll
    for (int i = 0; i < 32; ++i) v[i] = W[(size_t)(k0 + 2 * i + (lane >> 5)) * ldw + col0 + n0 + (lane & 31)];
    if (gain) {
#pragma unroll
        for (int i = 0; i < 32; ++i) v[i] *= gain[k0 + 2 * i + (lane >> 5)]; }
#pragma unroll
    for (int i = 0; i < 32; ++i) scr[(2 * i + (lane >> 5)) * 33 + (lane & 31)] = v[i];
    LDS_WAIT(); asm volatile("" ::: "memory");
    const int c = lane & 7;
#pragma unroll
    for (int j = 0; j < 4; ++j) { const int n = (lane >> 3) + 8 * j; const LAS float* s = scr + (8 * c) * 33 + n;
        u32x4 o; o.x = pk2(s[0 * 33], s[1 * 33]); o.y = pk2(s[2 * 33], s[3 * 33]); o.z = pk2(s[4 * 33], s[5 * 33]); o.w = pk2(s[6 * 33], s[7 * 33]);
        *(u32x4*)(dst + (size_t)rowmap(kind, n0 + n) * K + k0 + 8 * c) = o; }
    LDS_WAIT(); asm volatile("" ::: "memory");
}

__device__ __forceinline__ void s5_tables(const Ctx& c, int l, int g, int part) {
    LAS float* pwr = (LAS float*)c.lds; LAS float* pwi = pwr + 2112; LAS float* bbr = pwi + 2112; LAS float* bbi = bbr + 1024;
    LAS float* crT = bbi + 1024; LAS float* ciT = crT + 1024; LAS float* Kj = ciT + 1024;
    const int lg = l * 32 + g, tid = c.tid;
    const float* a_re = INP(c, 10) + lg * 64; const float* a_im = INP(c, 11) + lg * 64; const float* log_dt = INP(c, 12) + lg;
    const float* b_re = INP(c, 13) + (size_t)lg * 1024; const float* b_im = INP(c, 14) + (size_t)lg * 1024;
    const float* c_re = INP(c, 15) + (size_t)lg * 1024; const float* c_im = INP(c, 16) + (size_t)lg * 1024;
    if (tid < 64) {
        const int p = tid; const float dtf = expf(log_dt[0]), arf = a_re[p], aif = a_im[p], magf = expf(arf * dtf);
        const double ar = arf, ai = aif, abr = (double)(magf * cosf(aif * dtf)), abi = (double)(magf * sinf(aif * dtf)), den = ar * ar + ai * ai;
        const double zr = ((abr - 1.0) * ar + abi * ai) / den, zi = (abi * ar - (abr - 1.0) * ai) / den;
        double pr = 1.0, pi = 0.0;
        for (int j = 0; j <= 32; ++j) { pwr[p * 33 + j] = (float)pr; pwi[p * 33 + j] = (float)pi; const double nr = pr * abr - pi * abi, ni = pr * abi + pi * abr; pr = nr; pi = ni; }
        if (part == 0) { float* a32 = (float*)(c.ws + WS_A32) + (g * 64 + p) * 2; a32[0] = pwr[p * 33 + 32]; a32[1] = pwi[p * 33 + 32]; }
        for (int k = 0; k < 16; ++k) { const double br = b_re[p * 16 + k], bi = b_im[p * 16 + k]; bbr[p * 16 + k] = (float)(zr * br - zi * bi); bbi[p * 16 + k] = (float)(zr * bi + zi * br); }
    }
    for (int i = tid; i < 1024; i += NTHREADS) { const int cc = i >> 6, p = i & 63; crT[p * 16 + cc] = c_re[i]; ciT[p * 16 + cc] = c_im[i]; }
    __syncthreads();
    {
        const int j = tid >> 4, c2 = tid & 15; float acc[16];
#pragma unroll
        for (int cc = 0; cc < 16; ++cc) acc[cc] = 0.f;
        for (int p = 0; p < 64; ++p) { const float ar = pwr[p * 33 + j], ai = pwi[p * 33 + j], br = bbr[p * 16 + c2], bi = bbi[p * 16 + c2];
            const float xr = ar * br - ai * bi, xi = ar * bi + ai * br;
#pragma unroll
            for (int q4 = 0; q4 < 4; ++q4) { const f32x4 cr4 = *(const LAS f32x4*)(crT + p * 16 + 4 * q4), ci4 = *(const LAS f32x4*)(ciT + p * 16 + 4 * q4);
#pragma unroll
                for (int e = 0; e < 4; ++e) acc[4 * q4 + e] += cr4[e] * xr - ci4[e] * xi; } }
#pragma unroll
        for (int cc = 0; cc < 16; ++cc) Kj[j * 256 + cc * 16 + c2] = acc[cc];
    }
    __syncthreads();
    bf16_t* dm = (bf16_t*)(c.ws + W_S5M) + (size_t)g * 512 * 640;
    for (int ch = tid; ch < 64 * 80; ch += NTHREADS) { const int row = part * 64 + ch / 80, cch = ch % 80, t = row >> 4, cc = row & 15, col0 = cch * 8; float v[8];
        if (col0 < 64) {
#pragma unroll
            for (int e = 0; e < 8; ++e) { const int p = col0 + e; v[e] = crT[p * 16 + cc] * pwr[p * 33 + t + 1] - ciT[p * 16 + cc] * pwi[p * 33 + t + 1]; }
        } else if (col0 < 128) {
#pragma unroll
            for (int e = 0; e < 8; ++e) { const int p = col0 - 64 + e; v[e] = -(crT[p * 16 + cc] * pwi[p * 33 + t + 1] + ciT[p * 16 + cc] * pwr[p * 33 + t + 1]); }
        } else { const int s = (col0 - 128) >> 4, cb = (col0 - 128) & 15;
#pragma unroll
            for (int e = 0; e < 8; ++e) v[e] = (s <= t) ? Kj[(t - s) * 256 + cc * 16 + cb + e] : 0.f;
        }
        u32x4 o; o.x = pk2(v[0], v[1]); o.y = pk2(v[2], v[3]); o.z = pk2(v[4], v[5]); o.w = pk2(v[6], v[7]);
        *(u32x4*)(dm + (size_t)row * 640 + col0) = o; }
    bf16_t* de = (bf16_t*)(c.ws + W_S5E) + (size_t)g * 256 * 512;
    for (int ch = tid; ch < 32 * 64; ch += NTHREADS) { const int row = part * 32 + (ch >> 6), col0 = (ch & 63) * 8, s = col0 >> 4, cb = col0 & 15; float v[8];
#pragma unroll
        for (int e = 0; e < 8; ++e) {
            if (row < 64) { const int p = row; v[e] = pwr[p * 33 + 31 - s] * bbr[p * 16 + cb + e] - pwi[p * 33 + 31 - s] * bbi[p * 16 + cb + e]; }
            else if (row < 128) { const int p = row - 64; v[e] = pwr[p * 33 + 31 - s] * bbi[p * 16 + cb + e] + pwi[p * 33 + 31 - s] * bbr[p * 16 + cb + e]; }
            else v[e] = 0.f; }
        u32x4 o; o.x = pk2(v[0], v[1]); o.y = pk2(v[2], v[3]); o.z = pk2(v[4], v[5]); o.w = pk2(v[6], v[7]);
        *(u32x4*)(de + (size_t)row * 512 + col0) = o; }
    __syncthreads();
}

__device__ __forceinline__ void phase_wprep(const Ctx& c, int l) {
    for (int u = c.bid; u < 256; u += c.G) s5_tables(c, l, u >> 3, u & 7);
    if (l == 0) {
        const int* pos = (const int*)INP(c, 1); f32x2* rope = (f32x2*)(c.ws + WS_ROPE);
        for (int e = c.bid * NTHREADS + c.tid; e < TOK * 16; e += c.G * NTHREADS) { const int tok = e >> 4, i = e & 15;
            const float ang = (float)pos[tok] * exp2f(-1.1832230355827609f * (float)i); rope[e] = (f32x2){cosf(ang), sinf(ang)}; }
    }
    __syncthreads();
    LAS float* scr = (LAS float*)(c.lds + c.wave * 16384);
    const int gw = c.bid * NWAVES + c.wave, NGW = c.G * NWAVES;
    const float* n1 = INP(c, 2) + l * DM; const float* nm = INP(c, 6) + l * DM; const float* n2 = INP(c, 25) + l * DM;
    const float* wg1 = INP(c, 3) + (size_t)l * DM * DFF; const float* wu1 = INP(c, 4) + (size_t)l * DM * DFF; const float* wd1 = INP(c, 5) + (size_t)l * DFF * DM;
    const float* wg2 = INP(c, 26) + (size_t)l * DM * DFF; const float* wu2 = INP(c, 27) + (size_t)l * DM * DFF; const float* wd2 = INP(c, 28) + (size_t)l * DFF * DM;
    const float* win = INP(c, 7) + (size_t)l * DM * INW; const float* wbr = INP(c, 23) + (size_t)l * 4 * 512 * DM; const float* wout = INP(c, 24) + (size_t)l * DM * DM;
    const float* wglu = INP(c, 18) + (size_t)l * 512 * 1024;
    unsigned char* ws = c.ws;
    for (int it = gw; it < 16384; it += NGW) {
        int r = it;
        if (r < 1408) { transpose_item(wg1, DFF, 0, DM, DFF, (bf16_t*)(ws + W_GU1), n1, 1, scr, r, c.lane); continue; } r -= 1408;
        if (r < 1408) { transpose_item(wu1, DFF, 0, DM, DFF, (bf16_t*)(ws + W_GU1), n1, 2, scr, r, c.lane); continue; } r -= 1408;
        if (r < 1408) { transpose_item(wd1, DM, 0, DFF, DM, (bf16_t*)(ws + W_D1), nullptr, 0, scr, r, c.lane); continue; } r -= 1408;
        if (r < 1408) { transpose_item(wg2, DFF, 0, DM, DFF, (bf16_t*)(ws + W_GU2), n2, 1, scr, r, c.lane); continue; } r -= 1408;
        if (r < 1408) { transpose_item(wu2, DFF, 0, DM, DFF, (bf16_t*)(ws + W_GU2), n2, 2, scr, r, c.lane); continue; } r -= 1408;
        if (r < 1408) { transpose_item(wd2, DM, 0, DFF, DM, (bf16_t*)(ws + W_D2), nullptr, 0, scr, r, c.lane); continue; } r -= 1408;
        if (r < 1792) { transpose_item(win, INW, 0, DM, 3584, (bf16_t*)(ws + W_C1), nm, 0, scr, r, c.lane); continue; } r -= 1792;
        if (r < 2304) { transpose_item(win, INW, 3584, DM, 4608, (bf16_t*)(ws + W_C2), nm, 0, scr, r, c.lane); continue; } r -= 2304;
        if (r < 2048) { transpose_item(win, INW, 8192, DM, 4096, (bf16_t*)(ws + W_GATE), nm, 3, scr, r, c.lane); continue; } r -= 2048;
        if (r < 1024) { const int k = r >> 8; transpose_item(wbr + (size_t)k * 512 * DM, DM, 0, 512, DM, (bf16_t*)(ws + W_BR) + (size_t)k * 1024 * 512, nullptr, 0, scr, r & 255, c.lane); continue; } r -= 1024;
        if (r < 512) { transpose_item(wout, DM, 0, DM, DM, (bf16_t*)(ws + W_OUT), nullptr, 0, scr, r, c.lane); continue; } r -= 512;
        if (r < 128) { transpose_item(wglu, 1024, 0, 512, 512, (bf16_t*)(ws + W_GLU), nullptr, 1, scr, r, c.lane); continue; } r -= 128;
        transpose_item(wglu, 1024, 512, 512, 512, (bf16_t*)(ws + W_GLU), nullptr, 2, scr, r, c.lane);
    }
}

__device__ __forceinline__ void phase_norm_in(const Ctx& c, const float* x, bf16_t* xn, float* ssq) {
    const int gw = c.bid * NWAVES + c.wave, NGW = c.G * NWAVES;
    for (int row = gw; row < TOK; row += NGW) {
        const f32x4* xr = (const f32x4*)(x + (size_t)row * DM) + c.lane; f32x4 v[4]; float s = 0.f;
#pragma unroll
        for (int j = 0; j < 4; ++j) { v[j] = xr[64 * j]; s += (v[j][0] * v[j][0] + v[j][1] * v[j][1]) + (v[j][2] * v[j][2] + v[j][3] * v[j][3]); }
        s = wave_sum(s); if (c.lane == 0) ssq[row] = s;
        u32x2* o = (u32x2*)(xn + (size_t)row * DM) + c.lane;
#pragma unroll
        for (int j = 0; j < 4; ++j) { u32x2 w; w.x = pk2(v[j][0], v[j][1]); w.y = pk2(v[j][2], v[j][3]); o[64 * j] = w; }
    }
}
__device__ __forceinline__ void phase_final_norm(const Ctx& c, float* x, const float* gain, const float* ssq) {
    const int gw = c.bid * NWAVES + c.wave, NGW = c.G * NWAVES;
    for (int row = gw; row < TOK; row += NGW) {
        f32x4* xr = (f32x4*)(x + (size_t)row * DM) + c.lane; const float rs = rsqrtf(ssq[row] * (1.f / DM) + NORM_EPS);
#pragma unroll
        for (int j = 0; j < 4; ++j) { const f32x4 gn = ((const f32x4*)gain)[c.lane + 64 * j]; xr[64 * j] = xr[64 * j] * rs * gn; }
    }
}

constexpr int CV_OB = 62 * 512 * 4, CV_ST = CV_OB + 8 * 512 * 4;
static_assert(CV_ST + 64 <= XB_LDS_OFF, "conv LDS map");
__device__ __forceinline__ void phase_conv(const Ctx& c, int l) {
    LAS float* z = (LAS float*)c.lds; LAS float* ob = (LAS float*)(c.lds + CV_OB); LAS float* st = (LAS float*)(c.lds + CV_ST);
    const bf16_t* cin = (const bf16_t*)(c.ws + R_CONV); bf16_t* yc = (bf16_t*)(c.ws + WS_Y) + (size_t)2 * TOK * 512;
    const int ch = c.tid;
    const float* cw = INP(c, 19) + (size_t)l * 31 * 512; const float cb = INP(c, 20)[l * 512 + ch], lg = INP(c, 21)[l * 512 + ch], lb = INP(c, 22)[l * 512 + ch];
    float w[31];
#pragma unroll
    for (int j = 0; j < 31; ++j) w[j] = cw[j * 512 + ch];
    for (int unit = c.bid; unit < TOK / 32; unit += c.G) {
        const int b = unit >> 8, t0 = (unit & 255) * 32;
        {
            u32x4 av[8], bv[8];
#pragma unroll
            for (int i = 0; i < 8; ++i) { const int id = c.tid + NTHREADS * i, r = id >> 6, cc = id & 63, t = t0 - 30 + r;
                av[i] = (u32x4){0u, 0u, 0u, 0u}; bv[i] = av[i];
                if (r < 62 && t >= 0) { const bf16_t* rp = cin + (size_t)(b * SEQ + t) * 1024 + cc * 8; av[i] = *(const u32x4*)rp; bv[i] = *(const u32x4*)(rp + 512); } }
#pragma unroll
            for (int i = 0; i < 8; ++i) { const int id = c.tid + NTHREADS * i, r = id >> 6, cc = id & 63;
                if (r < 62) { const unsigned aw[4] = {av[i].x, av[i].y, av[i].z, av[i].w}, bw[4] = {bv[i].x, bv[i].y, bv[i].z, bv[i].w}; f32x4 z0, z1;
                    z0[0] = bflo(aw[0]) * sigm(bflo(bw[0])); z0[1] = bfhi(aw[0]) * sigm(bfhi(bw[0])); z0[2] = bflo(aw[1]) * sigm(bflo(bw[1])); z0[3] = bfhi(aw[1]) * sigm(bfhi(bw[1]));
                    z1[0] = bflo(aw[2]) * sigm(bflo(bw[2])); z1[1] = bfhi(aw[2]) * sigm(bfhi(bw[2])); z1[2] = bflo(aw[3]) * sigm(bflo(bw[3])); z1[3] = bfhi(aw[3]) * sigm(bfhi(bw[3]));
                    *(LAS f32x4*)(z + r * 512 + cc * 8) = z0; *(LAS f32x4*)(z + r * 512 + cc * 8 + 4) = z1; } }
        }
        __syncthreads();
#pragma unroll 1
        for (int blk = 0; blk < 4; ++blk) {
            float zr[38];
#pragma unroll
            for (int i = 0; i < 38; ++i) zr[i] = z[(blk * 8 + i) * 512 + ch];
            float o[8];
#pragma unroll
            for (int tt = 0; tt < 8; ++tt) { float a = cb;
#pragma unroll
                for (int j = 0; j < 31; ++j) a += w[j] * zr[tt + j];
                o[tt] = a; ob[tt * 512 + ch] = a; }
            __syncthreads();
            {
                float s1 = 0.f, s2 = 0.f;
#pragma unroll
                for (int j = 0; j < 8; ++j) { const float v = ob[c.wave * 512 + c.lane + 64 * j]; s1 += v; s2 += v * v; }
                s1 = wave_sum(s1); s2 = wave_sum(s2);
                const float mean = s1 * (1.f / 512.f), var = fmaxf(s2 * (1.f / 512.f) - mean * mean, 0.f);
                if (c.lane == 0) { st[c.wave * 2] = mean; st[c.wave * 2 + 1] = rsqrtf(var + NORM_EPS); }
            }
            __syncthreads();
#pragma unroll
            for (int tt = 0; tt < 8; ++tt) { const float y = (o[tt] - st[tt * 2]) * st[tt * 2 + 1] * lg + lb;
                yc[(size_t)(b * SEQ + t0 + blk * 8 + tt) * 512 + ch] = (bf16_t)f2bf(siluf(y)); }
        }
        __syncthreads();
    }
}
#define XB_TMO      128
#define XB_XCNT(j)  (256  + 64 * (j))
#define XB_XSUB(j)  (1280 + 64 * (j))
#define XB_XGEN(j)  (2304 + 64 * (j))
#define XB_TOP      3328
#define XB_TOPGEN   3392
#define XCD_BAR_WORDS 3456
#define XB_SPIN_CAP (1u << 18)

__device__ __forceinline__ unsigned xb_ld(unsigned* p)              { return __hip_atomic_load(p, __ATOMIC_RELAXED, __HIP_MEMORY_SCOPE_AGENT); }
__device__ __forceinline__ unsigned xb_add(unsigned* p, unsigned v) { return __hip_atomic_fetch_add(p, v, __ATOMIC_RELAXED, __HIP_MEMORY_SCOPE_AGENT); }
__device__ __forceinline__ unsigned xb_xcc_id() { return (unsigned)__builtin_amdgcn_s_getreg((3 << 11) | 20) & 0xFu; }
#define XB_SPIN(cond, bar) do { unsigned _sp = 0; while (cond) { __builtin_amdgcn_s_sleep(1); \
    if ((++_sp & 255u) == 0u) { if (xb_ld(&(bar)[XB_TMO])) break; if (_sp > XB_SPIN_CAP) { atomicAdd(&(bar)[XB_TMO], 1u); break; } } } } while (0)

struct XcdBarrier {
    unsigned* bar; unsigned x;
    volatile LAS unsigned* st;
};

__device__ __forceinline__ XcdBarrier xcd_barrier_post(unsigned* bar, volatile LAS unsigned* st) {
    XcdBarrier b; b.bar = bar; b.x = xb_xcc_id(); b.st = st;
    if (threadIdx.x == 0) (void)xb_add(&bar[XB_XCNT(b.x)], 1u);
    return b;
}
__device__ __forceinline__ void xcd_barrier_complete(unsigned* bar, unsigned x, unsigned& nloc, unsigned& nx) {
    const unsigned G = gridDim.x * gridDim.y * gridDim.z;
    unsigned sum, cnt, mine, sp = 0u;
    for (;;) {
        sum = 0u; cnt = 0u; mine = 0u;
#pragma unroll
        for (unsigned j = 0; j < 16; ++j) { const unsigned c = xb_ld(&bar[XB_XCNT(j)]); sum += c; cnt += (c > 0u) ? 1u : 0u; mine = (j == x) ? c : mine; }
        if (sum == G) break;
        __builtin_amdgcn_s_sleep(1);
        if ((++sp & 255u) == 0u) { if (xb_ld(&bar[XB_TMO])) break; if (sp > XB_SPIN_CAP) { atomicAdd(&bar[XB_TMO], 1u); break; } }
    }
    nloc = mine > 0u ? mine : 1u; nx = cnt > 0u ? cnt : 1u;
}

__device__ __forceinline__ void xcd_barrier(const XcdBarrier& b) {
    asm volatile("s_waitcnt vmcnt(0)" ::: "memory");
    __syncthreads();
    if (threadIdx.x == 0) {
        unsigned* bar = b.bar;
        __builtin_amdgcn_s_waitcnt(0);
        unsigned nloc = b.st[0], nx = b.st[1];
        if (nloc == 0u) { xcd_barrier_complete(bar, b.x, nloc, nx); b.st[0] = nloc; b.st[1] = nx; }
        const unsigned old = xb_add(&bar[XB_XSUB(b.x)], 1u);
        const unsigned gen = old / nloc;
        if (old + 1u == (gen + 1u) * nloc) {
            __builtin_amdgcn_fence(__ATOMIC_RELEASE, "agent");
            asm volatile("s_waitcnt vmcnt(0)" ::: "memory");
            const unsigned og = xb_add(&bar[XB_TOP], 1u);
            const unsigned tg = og / nx;
            if (og + 1u == (tg + 1u) * nx) xb_add(&bar[XB_TOPGEN], 1u);
            else XB_SPIN(xb_ld(&bar[XB_TOPGEN]) == tg, bar);
            __builtin_amdgcn_fence(__ATOMIC_ACQUIRE, "agent");
            xb_add(&bar[XB_XGEN(b.x)], 1u);
            asm volatile("s_waitcnt vmcnt(0)" ::: "memory");
        } else {
            XB_SPIN(xb_ld(&bar[XB_XGEN(b.x)]) == gen, bar);
            __builtin_amdgcn_fence(__ATOMIC_ACQUIRE, "agent");
            asm volatile("s_waitcnt vmcnt(0)" ::: "memory");
        }
    }
    __syncthreads();
}

__device__ __forceinline__ float hg_lb(const Ctx& c, int l, int col) {
    if (l == 0) return 0.f;
    const float z0 = INP(c, 8)[col], z1 = INP(c, 8)[512 + col], m = fmaxf(z0, z1), e0 = expf(z0 - m), e1 = expf(z1 - m);
    return e1 / (e0 + e1);
}
__device__ __forceinline__ unsigned short bf1(float x) { return (unsigned short)(pg8::cvt_pk_bf16(x, x) & 0xffffu); }
__device__ __forceinline__ void hg_stage_tile(const bf16_t* src, int row0, int h, LAS bf16_t* dst, int tid) {
#pragma unroll
    for (int i = 0; i < 2; ++i) { const int id = tid + NTHREADS * i, s = id >> 4, cc = id & 15;
        *(LAS u32x4*)(dst + s * 136 + cc * 8) = *(const u32x4*)(src + (size_t)(row0 + s) * 512 + h * 128 + cc * 8); }
}
__device__ __forceinline__ void hg_logf(const LAS bf16_t* fr, float lbv, int k, int rg, LAS float* bL, LAS float* seg, float (&kk)[16]) {
    float run = 0.f;
#pragma unroll
    for (int j = 0; j < 16; ++j) { const int s = rg * 16 + j; const float f = bf2f(fr[s * 136 + k]);
        const float ex = __expf(-f), sg = __builtin_amdgcn_rcpf(1.f + ex);
        const float lf = __logf(lbv + (1.f - lbv) * sg);
        kk[j] = (1.f - lbv) * ex * sg; run += lf; bL[s * 129 + k] = run; }
    seg[rg * 128 + k] = run;
}
__device__ __forceinline__ void hg_load_vT(const bf16_t* hv, int row0, int h, LAS bf16_t* vT, int wave, int lane) {
    u32x4 v[2];
#pragma unroll
    for (int i = 0; i < 2; ++i) v[i] = *(const u32x4*)(hv + (size_t)(row0 + lane) * 512 + h * 128 + (wave + 8 * i) * 8);
#pragma unroll
    for (int i = 0; i < 2; ++i) { const int cc = wave + 8 * i; const unsigned vw[4] = {v[i].x, v[i].y, v[i].z, v[i].w};
#pragma unroll
        for (int e = 0; e < 4; ++e) { vT[(cc * 8 + 2 * e) * 72 + lane] = (bf16_t)(vw[e] & 0xffffu); vT[(cc * 8 + 2 * e + 1) * 72 + lane] = (bf16_t)(vw[e] >> 16); } }
}
constexpr int HG1_KDT = 35072, HG1_VT = 53504, HG1_FR = 71936;
__device__ __forceinline__ void phase_hg1(const Ctx& c, int l) {
    LAS float* bL = (LAS float*)c.lds; LAS float* seg = bL + 64 * 129;
    LAS bf16_t* kdT = (LAS bf16_t*)(c.lds + HG1_KDT); LAS bf16_t* vT = (LAS bf16_t*)(c.lds + HG1_VT); LAS bf16_t* fr = (LAS bf16_t*)(c.lds + HG1_FR);
    const bf16_t* hf = (const bf16_t*)(c.ws + R_HQ) + (size_t)TOK * 512; const bf16_t* hv = hf + (size_t)TOK * 512;
    bf16_t* hst = (bf16_t*)(c.ws + R_HST); float* hgd = (float*)(c.ws + WS_HGD);
    const int k = c.tid & 127, rg = c.tid >> 7, r = c.lane & 15, q = c.lane >> 4;
    for (int unit = c.bid; unit < 1024; unit += c.G) {
        const int b = unit >> 9, n = (unit >> 2) & 127, h = unit & 3, row0 = b * SEQ + n * 64, col = h * 128 + k;
        const float lbv = hg_lb(c, l, col);
        float kk[16];
        hg_stage_tile(hf, row0, h, fr, c.tid);
        hg_load_vT(hv, row0, h, vT, c.wave, c.lane);
        __syncthreads();
        hg_logf(fr, lbv, k, rg, bL, seg, kk);
        __syncthreads();
        float pre = 0.f;
        for (int s = 0; s < rg; ++s) pre += seg[s * 128 + k];
        const float blast = (seg[k] + seg[128 + k]) + (seg[256 + k] + seg[384 + k]);
        unsigned w[8];
#pragma unroll
        for (int j = 0; j < 8; ++j) { const int s = rg * 16 + 2 * j;
            const float b0 = bL[s * 129 + k] + pre, b1 = bL[(s + 1) * 129 + k] + pre;
            w[j] = pg8::cvt_pk_bf16(kk[2 * j] * __expf(blast - b0), kk[2 * j + 1] * __expf(blast - b1)); }
        { LAS u32x4* d = (LAS u32x4*)(kdT + k * 72 + rg * 16); d[0] = (u32x4){w[0], w[1], w[2], w[3]}; d[1] = (u32x4){w[4], w[5], w[6], w[7]}; }
        if (rg == 0) hgd[unit * 128 + k] = __expf(blast);
        __syncthreads();
        f32x4 acc[1][8];
#pragma unroll
        for (int nt = 0; nt < 8; ++nt) acc[0][nt] = (f32x4){0.f, 0.f, 0.f, 0.f};
        wave_mma<1, 8, 2>(acc, vT + (16 * c.wave) * 72, 72, kdT, 72, c.lane);
        bf16_t* dst = hst + (size_t)unit * 16384;
#pragma unroll
        for (int nt = 0; nt < 8; ++nt)
#pragma unroll
            for (int j = 0; j < 4; ++j) dst[(16 * c.wave + 4 * q + j) * 128 + nt * 16 + r] = bf1(acc[0][nt][j]);
        __syncthreads();
    }
}
__device__ __forceinline__ void phase_hg2(const Ctx& c) {
    bf16_t* hst = (bf16_t*)(c.ws + R_HST); const float* hgd = (const float*)(c.ws + WS_HGD);
    for (int idx = c.bid * NTHREADS + c.tid; idx < 65536; idx += c.G * NTHREADS) {
        const int bh = idx >> 13, e2 = idx & 8191, b = bh >> 2, h = bh & 3, kc = (e2 * 2) & 127;
        float s0 = 0.f, s1 = 0.f;
        for (int n0 = 0; n0 < 128; n0 += 16) {
            unsigned u[16]; f32x2 d[16];
#pragma unroll
            for (int i = 0; i < 16; ++i) { const int unit = (b * 128 + n0 + i) * 4 + h; u[i] = ((const unsigned*)(hst + (size_t)unit * 16384))[e2]; d[i] = *(const f32x2*)(hgd + unit * 128 + kc); }
#pragma unroll
            for (int i = 0; i < 16; ++i) { const int unit = (b * 128 + n0 + i) * 4 + h; ((unsigned*)(hst + (size_t)unit * 16384))[e2] = pk2(s0, s1);
                s0 = d[i][0] * s0 + bflo(u[i]); s1 = d[i][1] * s1 + bfhi(u[i]); }
        }
    }
}
constexpr int HG3_QD = 35072, HG3_ST = 52480, HG3_QT = 87296, HG3_KT = 104704, HG3_P = 122112, HG3_VT = 131328;
static_assert(HG3_VT + 128 * 72 * 2 <= LDS_BYTES, "hg3 LDS map");
__device__ __forceinline__ void phase_hg3(const Ctx& c, int l) {
    LAS float* bL = (LAS float*)c.lds; LAS float* seg = bL + 64 * 129;
    LAS bf16_t* qd = (LAS bf16_t*)(c.lds + HG3_QD); LAS bf16_t* ST = (LAS bf16_t*)(c.lds + HG3_ST); LAS bf16_t* qt = (LAS bf16_t*)(c.lds + HG3_QT);
    LAS bf16_t* kt = (LAS bf16_t*)(c.lds + HG3_KT); LAS bf16_t* P = (LAS bf16_t*)(c.lds + HG3_P); LAS bf16_t* vT = (LAS bf16_t*)(c.lds + HG3_VT);
    const bf16_t* hq = (const bf16_t*)(c.ws + R_HQ); const bf16_t* hf = hq + (size_t)TOK * 512; const bf16_t* hv = hf + (size_t)TOK * 512; const bf16_t* hg = hv + (size_t)TOK * 512;
    const bf16_t* hst = (const bf16_t*)(c.ws + R_HST); bf16_t* ya = (bf16_t*)(c.ws + WS_Y);
    const float* gnorm = INP(c, 9) + l * 512;
    const int k = c.tid & 127, rg = c.tid >> 7, r = c.lane & 15, q = c.lane >> 4, w = c.wave;
    for (int unit = c.bid; unit < 1024; unit += c.G) {
        const int b = unit >> 9, n = (unit >> 2) & 127, h = unit & 3, row0 = b * SEQ + n * 64, col = h * 128 + k;
        const float lbv = hg_lb(c, l, col);
        float kk[16];
        hg_stage_tile(hf, row0, h, qt, c.tid);
        hg_stage_tile(hq, row0, h, kt, c.tid);
        hg_load_vT(hv, row0, h, vT, c.wave, c.lane);
#pragma unroll
        for (int i = 0; i < 4; ++i) { const int id = c.tid + NTHREADS * i, v = id >> 4, cc = id & 15;
            *(LAS u32x4*)(ST + v * 136 + cc * 8) = *(const u32x4*)(hst + (size_t)unit * 16384 + v * 128 + cc * 8); }
        __syncthreads();
        hg_logf(qt, lbv, k, rg, bL, seg, kk);
        __syncthreads();
        float pre = 0.f;
        for (int s = 0; s < rg; ++s) pre += seg[s * 128 + k];
        const float bref = bL[31 * 129 + k] + seg[k];
#pragma unroll
        for (int j = 0; j < 16; ++j) { const int s = rg * 16 + j; const float bv = bL[s * 129 + k] + pre;
            const float qf = siluf(bf2f(kt[s * 136 + k])) * 0.08838834764831845f;
            qd[s * 136 + k] = bf1(qf * __expf(bv));
            qt[s * 136 + k] = bf1(qf * __expf(fminf(bv - bref, 80.f)));
            kt[s * 136 + k] = bf1(kk[j] * __expf(fminf(bref - bv, 80.f))); }
        __syncthreads();
        {
            f32x4 a2[1][2] = {{(f32x4){0.f, 0.f, 0.f, 0.f}, (f32x4){0.f, 0.f, 0.f, 0.f}}};
            wave_mma<1, 2, 4>(a2, qt + (16 * (w >> 1)) * 136, 136, kt + (32 * (w & 1)) * 136, 136, c.lane);
#pragma unroll
            for (int nt = 0; nt < 2; ++nt)
#pragma unroll
                for (int j = 0; j < 4; ++j) { const int t = 16 * (w >> 1) + 4 * q + j, s = 32 * (w & 1) + nt * 16 + r; P[t * 72 + s] = bf1(s <= t ? a2[0][nt][j] : 0.f); }
        }
        __syncthreads();
        {
            f32x4 a4[1][4];
#pragma unroll
            for (int nt = 0; nt < 4; ++nt) a4[0][nt] = (f32x4){0.f, 0.f, 0.f, 0.f};
            wave_mma<1, 4, 4>(a4, qd + (16 * (w >> 1)) * 136, 136, ST + (64 * (w & 1)) * 136, 136, c.lane);
            wave_mma<1, 4, 2>(a4, P + (16 * (w >> 1)) * 72, 72, vT + (64 * (w & 1)) * 72, 72, c.lane);
#pragma unroll
            for (int nt = 0; nt < 4; ++nt)
#pragma unroll
                for (int j = 0; j < 4; ++j) bL[(16 * (w >> 1) + 4 * q + j) * 129 + 64 * (w & 1) + nt * 16 + r] = a4[0][nt][j];
        }
        __syncthreads();
        {
            const int t = c.tid >> 3, v0 = (c.tid & 7) * 16; float o[16]; float ss = 0.f;
#pragma unroll
            for (int e = 0; e < 16; ++e) { o[e] = bL[t * 129 + v0 + e]; ss += o[e] * o[e]; }
            ss += __shfl_xor(ss, 1); ss += __shfl_xor(ss, 2); ss += __shfl_xor(ss, 4);
            const float rs = 1.f / sqrtf(ss * (1.f / 128.f) + NORM_EPS);
            const bf16_t* gp = hg + (size_t)(row0 + t) * 512 + h * 128 + v0; const u32x4 g0 = *(const u32x4*)gp, g1 = *(const u32x4*)(gp + 8);
            const unsigned gw[8] = {g0.x, g0.y, g0.z, g0.w, g1.x, g1.y, g1.z, g1.w}; unsigned ow[8];
#pragma unroll
            for (int e = 0; e < 8; ++e) { const float ga = bflo(gw[e]), gb = bfhi(gw[e]);
                ow[e] = pg8::cvt_pk_bf16(o[2 * e] * rs * gnorm[h * 128 + v0 + 2 * e] * siluf(ga), o[2 * e + 1] * rs * gnorm[h * 128 + v0 + 2 * e + 1] * siluf(gb)); }
            bf16_t* yp = ya + (size_t)(row0 + t) * 512 + h * 128 + v0;
            *(u32x4*)yp = (u32x4){ow[0], ow[1], ow[2], ow[3]}; *(u32x4*)(yp + 8) = (u32x4){ow[4], ow[5], ow[6], ow[7]};
        }
        __syncthreads();
    }
}

__device__ __forceinline__ void phase_s5scan(const Ctx& c) {
    const int idx = c.bid * NTHREADS + c.tid;
    if (idx >= 4096) return;
    const int b = idx >> 11, g = (idx >> 6) & 31, p = idx & 63;
    const float* a32 = (const float*)(c.ws + WS_A32) + (g * 64 + p) * 2; const float ar = a32[0], ai = a32[1];
    bf16_t* s5A = (bf16_t*)(c.ws + R_S5A); const float* E = (const float*)(c.ws + WS_S5E);
    float xr = 0.f, xi = 0.f;
    for (int n0 = 0; n0 < 256; n0 += 32) {
        float er[32], ei[32];
#pragma unroll
        for (int i = 0; i < 32; ++i) { const size_t row = (size_t)g * 512 + b * 256 + n0 + i; er[i] = E[row * 128 + p]; ei[i] = E[row * 128 + 64 + p]; }
#pragma unroll
        for (int i = 0; i < 32; ++i) { const size_t row = (size_t)g * 512 + b * 256 + n0 + i; s5A[row * 640 + p] = (bf16_t)f2bf(xr); s5A[row * 640 + 64 + p] = (bf16_t)f2bf(xi);
            const float nr = ar * xr - ai * xi + er[i], ni = ar * xi + ai * xr + ei[i]; xr = nr; xi = ni; }
    }
}

constexpr int AT_VT = 256 * 136 * 2, AT_P = AT_VT + 128 * 264 * 2, AT_RS = AT_P + 8 * 16 * 72 * 2;
static_assert(AT_RS + 256 * 4 <= XB_LDS_OFF, "attention LDS map");
__device__ __forceinline__ void phase_attn(const Ctx& c, const float* ssq) {
    LAS bf16_t* Ks = (LAS bf16_t*)c.lds; LAS bf16_t* Vts = (LAS bf16_t*)(c.lds + AT_VT); LAS bf16_t* Pw = (LAS bf16_t*)(c.lds + AT_P) + c.wave * (16 * 72); LAS float* rsL = (LAS float*)(c.lds + AT_RS);
    bf16_t* qkv = (bf16_t*)(c.ws + R_QKV); float* lse = (float*)(c.ws + WS_LSE);
    const int r = c.lane & 15, q4 = c.lane >> 4, w = c.wave;
    for (int unit = c.bid; unit < 1536; unit += c.G) {
        const int bh = unit >> 6, pos0 = (unit & 63) * 128, b = bh / 12, h = bh % 12, sh = 2 * (h >> 2), res = pos0 >> (13 - sh), i0 = pos0 & ((8192 >> sh) - 1);
        bf16_t* qb = qkv + (size_t)bh * SEQ * 128; const bf16_t* kb = qkv + QKV_WHICH + (size_t)bh * SEQ * 128; const bf16_t* vb = qkv + 2 * QKV_WHICH + (size_t)bh * SEQ * 128;
        bf16x8 qf[4];
#pragma unroll
        for (int kk = 0; kk < 4; ++kk) qf[kk] = *(const bf16x8*)(qb + (size_t)(pos0 + 16 * w + r) * 128 + kk * 32 + q4 * 8);
        {
            u32x4 kv[8], vv[8];
#pragma unroll
            for (int i = 0; i < 8; ++i) { const int id = c.tid + NTHREADS * i; kv[i] = *(const u32x4*)(kb + ((long)pos0 - 128 + (id >> 4)) * 128 + (id & 15) * 8); }
#pragma unroll
            for (int i = 0; i < 8; ++i) { const int id = c.tid + NTHREADS * i; vv[i] = *(const u32x4*)(vb + (long)(id >> 5) * SEQ + pos0 - 128 + (id & 31) * 8); }
#pragma unroll
            for (int i = 0; i < 8; ++i) { const int id = c.tid + NTHREADS * i; *(LAS u32x4*)(Ks + (id >> 4) * 136 + (id & 15) * 8) = kv[i]; }
#pragma unroll
            for (int i = 0; i < 8; ++i) { const int id = c.tid + NTHREADS * i; *(LAS u32x4*)(Vts + (id >> 5) * 264 + (id & 31) * 8) = vv[i]; }
            if (c.tid < 256) { const int j = i0 - 128 + c.tid; rsL[c.tid] = j >= 0 ? rsqrtf(ssq[b * SEQ + (j << sh) + res] * (1.f / DM) + NORM_EPS) : 0.f; }
        }
        __syncthreads();
        f32x4 s[16];
#pragma unroll
        for (int nt = 0; nt < 16; ++nt) s[nt] = (f32x4){0.f, 0.f, 0.f, 0.f};
#pragma unroll
        for (int kk = 0; kk < 4; ++kk)
#pragma unroll
            for (int nt = 0; nt < 16; ++nt) { const bf16x8 kf = *(const LAS bf16x8*)(Ks + (nt * 16 + r) * 136 + kk * 32 + q4 * 8); s[nt] = __builtin_amdgcn_mfma_f32_16x16x32_bf16(qf[kk], kf, s[nt], 0, 0, 0); }
        float mx[4];
#pragma unroll
        for (int j = 0; j < 4; ++j) { const int qi = 16 * w + 4 * q4 + j; float m = -1e30f;
#pragma unroll
            for (int nt = 0; nt < 16; ++nt) { const int kk = nt * 16 + r; const bool ok = (kk >= qi) && (kk <= qi + 128) && (i0 > 0 || kk >= 128); const float v = ok ? s[nt][j] : -1e30f; s[nt][j] = v; m = fmaxf(m, v); }
            m = fmaxf(m, __shfl_xor(m, 1)); m = fmaxf(m, __shfl_xor(m, 2)); m = fmaxf(m, __shfl_xor(m, 4)); m = fmaxf(m, __shfl_xor(m, 8)); mx[j] = m; }
        float ls[4] = {0.f, 0.f, 0.f, 0.f};
        f32x4 o[8];
#pragma unroll
        for (int dt = 0; dt < 8; ++dt) o[dt] = (f32x4){0.f, 0.f, 0.f, 0.f};
#pragma unroll
        for (int kq = 0; kq < 4; ++kq) {
#pragma unroll
            for (int n4 = 0; n4 < 4; ++n4) { const int nt = 4 * kq + n4; const float rk = rsL[nt * 16 + r];
#pragma unroll
                for (int j = 0; j < 4; ++j) { const float p = __expf(s[nt][j] - mx[j]); ls[j] += p; Pw[(4 * q4 + j) * 72 + n4 * 16 + r] = (bf16_t)(pg8::cvt_pk_bf16(p * rk, 0.f) & 0xffffu); } }
            asm volatile("s_waitcnt lgkmcnt(0)" ::: "memory");
#pragma unroll
            for (int k2 = 0; k2 < 2; ++k2) { const bf16x8 pf = *(const LAS bf16x8*)(Pw + r * 72 + k2 * 32 + q4 * 8);
#pragma unroll
                for (int dt = 0; dt < 8; ++dt) { const bf16x8 vf = *(const LAS bf16x8*)(Vts + (dt * 16 + r) * 264 + kq * 64 + k2 * 32 + q4 * 8); o[dt] = __builtin_amdgcn_mfma_f32_16x16x32_bf16(pf, vf, o[dt], 0, 0, 0); } }
            asm volatile("s_waitcnt lgkmcnt(0)" ::: "memory");
        }
#pragma unroll
        for (int j = 0; j < 4; ++j) { float l = ls[j]; l += __shfl_xor(l, 1); l += __shfl_xor(l, 2); l += __shfl_xor(l, 4); l += __shfl_xor(l, 8);
            const int row = pos0 + 16 * w + 4 * q4 + j; if (r == 0) lse[(size_t)bh * SEQ + row] = mx[j] + __logf(l);
            const float inv = 1.f / l;
#pragma unroll
            for (int dt = 0; dt < 8; ++dt) qb[(size_t)row * 128 + dt * 16 + r] = (bf16_t)(pg8::cvt_pk_bf16(o[dt][j] * inv, 0.f) & 0xffffu); }
        __syncthreads();
    }
}
__device__ __forceinline__ void phase_attn_merge(const Ctx& c) {
    const bf16_t* qkv = (const bf16_t*)(c.ws + R_QKV); const float* lse = (const float*)(c.ws + WS_LSE); bf16_t* yd = (bf16_t*)(c.ws + WS_Y) + (size_t)3 * TOK * 512;
    for (int id = c.bid * NTHREADS + c.tid; id < TOK * 64; id += c.G * NTHREADS) {
        const int row = id >> 6, hp = (id >> 4) & 3, cc = id & 15, b = row >> 13, t = row & 8191;
        float lw[3]; u32x4 ov[3];
#pragma unroll
        for (int g = 0; g < 3; ++g) { const int bh = b * 12 + g * 4 + hp, sh = 2 * g, pos = ((t & ((1 << sh) - 1)) << (13 - sh)) + (t >> sh);
            lw[g] = lse[(size_t)bh * SEQ + pos]; ov[g] = *(const u32x4*)(qkv + ((size_t)bh * SEQ + pos) * 128 + cc * 8); }
        const float m = fmaxf(lw[0], fmaxf(lw[1], lw[2])); float e[3], s = 0.f;
#pragma unroll
        for (int g = 0; g < 3; ++g) { e[g] = __expf(lw[g] - m); s += e[g]; }
        const float inv = 1.f / s; float o[8];
#pragma unroll
        for (int i = 0; i < 8; ++i) o[i] = 0.f;
#pragma unroll
        for (int g = 0; g < 3; ++g) { const float wg = e[g] * inv; const unsigned vw[4] = {ov[g].x, ov[g].y, ov[g].z, ov[g].w};
#pragma unroll
            for (int i = 0; i < 4; ++i) { o[2 * i] += wg * bflo(vw[i]); o[2 * i + 1] += wg * bfhi(vw[i]); } }
        *(u32x4*)(yd + (size_t)row * 512 + hp * 128 + cc * 8) = (u32x4){pk2(o[0], o[1]), pk2(o[2], o[3]), pk2(o[4], o[5]), pk2(o[6], o[7])};
    }
}

#ifndef MK_REP
#define MK_REP -1
#endif
constexpr int PH_PER_LAYER = 15, PH_SEQ = PH_PER_LAYER + (MK_REP >= 0 ? 1 : 0), N_PHASES = NLAYER * PH_SEQ + 1;
#ifndef MK_MASK
#define MK_MASK 0xFFFFF
#endif
#ifndef MK_CG_SYNC
#define MK_CG_SYNC 0
#endif
#ifndef MK_SPLIT
#define MK_SPLIT 0
#endif

template <class Epi> __device__ __forceinline__ void run_gemm(const Ctx& c, const bf16_t* A, int lda, const bf16_t* Bt, int ldb, int K, int N, const Epi& E) {
    pg8::Gemm g{A, Bt, lda, ldb, K}; pg8::StaticOrder S; S.init(TOK, N, c.G, c.bid, lda, ldb);
    int t_ = c.tid; asm volatile("" : "+v"(t_));
    pg8::gemm_phase<Epi, pg8::StaticOrder, true, true>(c.lds, g, S, E, t_);
}

__global__ void __launch_bounds__(NTHREADS, 2) hgpm_fwd(Args args) {
    extern __shared__ __attribute__((aligned(16))) unsigned char lds_raw[];
    Ctx c; c.lds = (LAS unsigned char*)lds_raw; c.G = gridDim.x; c.bid = blockIdx.x; c.in = args.in;
    volatile LAS unsigned* xb_st = (volatile LAS unsigned*)(c.lds + XB_LDS_OFF);
    if (threadIdx.x < 4) xb_st[threadIdx.x] = 0u;
    __syncthreads();
    XcdBarrier bar = xcd_barrier_post((unsigned*)(args.ws + WS_CTL), xb_st);

    for (int ph = args.ph_lo; ph < args.ph_hi; ++ph) {
        const int l = ph / PH_SEQ, pi_ = ph % PH_SEQ, p = (MK_REP >= 0 && pi_ > MK_REP) ? pi_ - 1 : pi_;
        { int t_ = threadIdx.x; asm volatile("" : "+v"(t_)); c.tid = t_; c.lane = t_ & 63; c.wave = __builtin_amdgcn_readfirstlane(t_ >> 6); }
        { int z_ = 0; asm volatile("" : "+s"(z_)); c.zo = z_; c.ws = args.ws + z_; c.out = args.out + z_; }
        unsigned char* ws = c.ws;
        bf16_t* XN = (bf16_t*)(ws + WS_XN); bf16_t* Y = (bf16_t*)(ws + WS_Y); bf16_t* MERGED = (bf16_t*)(ws + WS_MERGED); bf16_t* Z = MERGED;
        bf16_t* HBUF = (bf16_t*)(ws + R_HBUF); bf16_t* BALL = (bf16_t*)(ws + R_BALL); bf16_t* S5A = (bf16_t*)(ws + R_S5A);
        float* SSQ = (float*)(ws + WS_SSQ);
        float* ssq_b = SSQ + (size_t)(3 * l) * TOK; float* ssq_c = ssq_b + TOK; float* ssq_d = ssq_c + TOK;
        const float* ssq_a = (l == 0) ? SSQ + (size_t)6 * TOK : SSQ + (size_t)(3 * l - 1) * TOK;
        if (ph == N_PHASES - 1) { phase_final_norm(c, c.out, INP(c, 29), SSQ + (size_t)(3 * NLAYER - 1) * TOK); }
        else switch (p) {
        case 0: phase_wprep(c, l); if (l == 0) phase_norm_in(c, INP(c, 0), XN, SSQ + (size_t)6 * TOK); break;
        case 1: run_gemm(c, XN, DM, (const bf16_t*)(ws + W_GU1), DM, DM, 2 * DFF, pg8::EpiGated<0>{HBUF, DFF, ssq_a}); break;
        case 13: run_gemm(c, XN, DM, (const bf16_t*)(ws + W_GU2), DM, DM, 2 * DFF, pg8::EpiGated<0>{HBUF, DFF, ssq_c}); break;
        case 2: run_gemm(c, HBUF, DFF, (const bf16_t*)(ws + W_D1), DFF, DFF, DM, pg8::EpiResid{l == 0 ? INP(c, 0) : c.out, c.out, 0.5f, XN, ssq_b}); break;
        case 14: run_gemm(c, HBUF, DFF, (const bf16_t*)(ws + W_D2), DFF, DFF, DM, pg8::EpiResid{c.out, c.out, 0.5f, XN, ssq_d}); break;
        case 3: run_gemm(c, XN, DM, (const bf16_t*)(ws + W_C1), DM, DM, 3584, pg8::EpiC1{(bf16_t*)(ws + R_HQ), S5A, (bf16_t*)(ws + R_CONV), ssq_b}); break;
        case 4: { pg8::Gemm g{S5A, (const bf16_t*)(ws + W_S5E), 640, 512, 512}; pg8::S5eOrder S{c.G, c.bid};
                  pg8::gemm_phase<pg8::EpiS5e, pg8::S5eOrder, true, true>(c.lds, g, S, pg8::EpiS5e{(float*)(ws + WS_S5E)}, c.tid);
                  phase_hg1(c, l); phase_conv(c, l); } break;
        case 5: phase_hg2(c); phase_s5scan(c); break;
        case 6: { pg8::Gemm g{S5A, (const bf16_t*)(ws + W_S5M), 640, 640, 640}; pg8::S5mOrder S{c.G, c.bid};
                  pg8::gemm_phase<pg8::EpiS5m, pg8::S5mOrder, true, true>(c.lds, g, S, pg8::EpiS5m{S5A, INP(c, 17) + l * 512, Z}, c.tid);
                  phase_hg3(c, l); } break;
        case 7: run_gemm(c, Z, 512, (const bf16_t*)(ws + W_GLU), 512, 512, 1024, pg8::EpiGated<1>{Y + (size_t)TOK * 512, 512, nullptr});
                run_gemm(c, XN, DM, (const bf16_t*)(ws + W_C2), DM, DM, 3072, pg8::EpiQK{(bf16_t*)(ws + R_QKV), ssq_b, (const f32x2*)(ws + WS_ROPE)});
                for (int pass = 0; pass < 2; ++pass) {
                    const int gi = pass == 0 ? (c.bid >> 7) : 2, idx = pass == 0 ? (c.bid & 127) : (c.bid < 128 ? c.bid : -1);
                    pg8::Gemm g{(const bf16_t*)(ws + W_C2), XN, DM, DM << (2 * gi), DM}; pg8::VtOrder S{gi, idx};
                    int t_ = c.tid; asm volatile("" : "+v"(t_));
                    pg8::gemm_phase<pg8::EpiVt, pg8::VtOrder, true, true>(c.lds, g, S, pg8::EpiVt{(bf16_t*)(ws + R_QKV) + 2 * QKV_WHICH}, t_); }
                break;
        case 8: phase_attn(c, ssq_b); break;
        case 9: phase_attn_merge(c); break;
        case 10: { pg8::Gemm g{Y, (const bf16_t*)(ws + W_BR), 512, 512, 512}; pg8::BranchOrder S; S.init(c.G, c.bid);
                   pg8::gemm_phase<pg8::EpiBranch, pg8::BranchOrder, true, true>(c.lds, g, S, pg8::EpiBranch{BALL}, c.tid); } break;
        case 11: run_gemm(c, XN, DM, (const bf16_t*)(ws + W_GATE), DM, DM, 4096, pg8::EpiGateMerge{BALL, MERGED, ssq_b}); break;
        case 12: run_gemm(c, MERGED, DM, (const bf16_t*)(ws + W_OUT), DM, DM, DM, pg8::EpiResid{c.out, c.out, 1.0f, XN, ssq_c}); break;
        }
        if (ph + 1 < args.ph_hi) {
#if MK_CG_SYNC
            __syncthreads(); cg::this_grid().sync();
#else
            xcd_barrier(bar);
#endif
        }
    }
}

extern "C" void kernel_launch(void* const* d_in, const int* in_sizes, int n_in, void* d_out, int out_size, void* d_ws, size_t ws_size, hipStream_t stream) {
    static int grid = 0;
    if (grid == 0) {
        if (n_in != 30 || in_sizes[0] != TOK * DM || out_size != TOK * DM || ws_size < WS_END) {
            fprintf(stderr, "kernel_launch: unexpected problem: n_in %d, in0 %d, out %d, ws %zu (need %zu)\n", n_in, n_in > 0 ? in_sizes[0] : -1, out_size, ws_size, (size_t)WS_END); grid = -1; return; }
        int dev = 0, cus = 0, per_cu = 0;
        if (hipGetDevice(&dev) != hipSuccess || hipDeviceGetAttribute(&cus, hipDeviceAttributeMultiprocessorCount, dev) != hipSuccess) { fprintf(stderr, "kernel_launch: device query failed\n"); grid = -1; return; }
        if (hipFuncSetAttribute((const void*)hgpm_fwd, hipFuncAttributeMaxDynamicSharedMemorySize, LDS_BYTES) != hipSuccess) { fprintf(stderr, "kernel_launch: hipFuncSetAttribute failed\n"); grid = -1; return; }
        if (hipOccupancyMaxActiveBlocksPerMultiprocessor(&per_cu, (const void*)hgpm_fwd, NTHREADS, LDS_BYTES) != hipSuccess || per_cu < 1) { fprintf(stderr, "kernel_launch: occupancy query says %d blocks per CU\n", per_cu); (void)hipGetLastError(); grid = -1; return; }
        grid = cus * 1;
    }
    if (grid < 0) return;
    (void)hipMemsetAsync((char*)d_ws + WS_CTL, 0, 1 * MiB, stream);
    Args a{};
    for (int i = 0; i < 30; ++i) a.in[i] = (const float*)d_in[i];
    a.out = (float*)d_out; a.ws = (unsigned char*)d_ws;
#if MK_SPLIT
    for (int ph = 0; ph < N_PHASES; ++ph) { a.ph_lo = ph; a.ph_hi = ph + 1; hipLaunchKernelGGL(hgpm_fwd, dim3(grid), dim3(NTHREADS), LDS_BYTES, stream, a); }
#else
    a.ph_lo = 0; a.ph_hi = N_PHASES;
    void* kargs[] = {&a};
    const hipError_t e = hipLaunchCooperativeKernel((const void*)hgpm_fwd, dim3(grid), dim3(NTHREADS), kargs, LDS_BYTES, stream);
    if (e != hipSuccess) fprintf(stderr, "kernel_launch: cooperative launch failed: %s (grid %d)\n", hipGetErrorString(e), grid);
#endif
}
```

```cpp
#include <hip/hip_runtime.h>
#include <hip/hip_cooperative_groups.h>
#include <cstdio>
#include <cstdint>
namespace cg = cooperative_groups;

#define LAS __attribute__((address_space(3)))
typedef unsigned short bf16_t;
typedef short bf16x8 __attribute__((ext_vector_type(8)));
typedef float f32x4 __attribute__((ext_vector_type(4)));
typedef float f32x2 __attribute__((ext_vector_type(2)));
typedef unsigned u32x4 __attribute__((ext_vector_type(4)));
typedef unsigned u32x2 __attribute__((ext_vector_type(2)));

constexpr int BATCH = 2, SEQ = 8192, TOK = BATCH * SEQ, DM = 1024, DFF = 2816, NLAYER = 2, INW = 12288;
constexpr float NORM_EPS = 1e-6f;

__device__ __forceinline__ unsigned f2bf(float f) { unsigned u = __builtin_bit_cast(unsigned, f); return (u + 0x7fffu + ((u >> 16) & 1u)) >> 16; }
__device__ __forceinline__ float bf2f(unsigned b) { return __builtin_bit_cast(float, b << 16); }
__device__ __forceinline__ unsigned pk2(float lo, float hi) { return f2bf(lo) | (f2bf(hi) << 16); }
__device__ __forceinline__ float bflo(unsigned w) { return __builtin_bit_cast(float, w << 16); }
__device__ __forceinline__ float bfhi(unsigned w) { return __builtin_bit_cast(float, w & 0xffff0000u); }
__device__ __forceinline__ float sigm(float x) { return __builtin_amdgcn_rcpf(1.f + __expf(-x)); }
__device__ __forceinline__ float siluf(float x) { return x * __builtin_amdgcn_rcpf(1.f + __expf(-x)); }
__device__ __forceinline__ float gelu_tanh(float x) { const float y = 0.7978845608028654f * (x + 0.044715f * x * x * x); const float t = 1.f - 2.f * __builtin_amdgcn_rcpf(1.f + __expf(2.f * y)); return 0.5f * x * (1.f + t); }
__device__ __forceinline__ float wave_sum(float v) {
#pragma unroll
    for (int o = 1; o < 64; o <<= 1) v += __shfl_xor(v, o);
    return v;
}
#define LDS_WAIT() asm volatile("s_waitcnt lgkmcnt(0)" ::: "memory")

namespace pg8 {
#define PG8_LAS __attribute__((address_space(3)))
constexpr int BM = 256, BK = 64, HALF = 128, HTB = HALF * BK * 2  , STAGE_BYTES = 8 * HTB, NXCD = 8, WGM = 8;

__host__ __device__ __forceinline__ int lds_byte(int r, int c) { const int st = (r >> 4) * 2 + (c >> 5), rr = r & 15, cc = c & 31, ob = rr * 64 + cc * 2; return st * 1024 + (ob ^ (((ob >> 9) & 1) << 5)); }
__host__ __device__ __forceinline__ void stage_rc(int b, int& R, int& C) { const int st = b / 1024, sb = b % 1024, swz = sb ^ (((sb >> 9) & 1) << 5); R = (st >> 1) * 16 + swz / 64; C = (st & 1) * 32 + (swz % 64) / 2; }
__host__ __device__ __forceinline__ int perm32(int rho) { const int n = rho >> 4, i = rho & 15; return 8 * (i >> 2) + 4 * n + (i & 3); }

struct Unit { int pm, pn, grp, aux; size_t aoff, boff; };
struct Gemm { const bf16_t* A; const bf16_t* Bt; int lda, ldb, K; };

struct StaticOrder {
    int nM, nN, nwg, G, c, lda, ldb;
    __device__ __forceinline__ void init(int M, int N, int G_, int c_, int lda_, int ldb_) { nM = M / BM; nN = N / BM; nwg = nM * nN; G = G_; c = c_; lda = lda_; ldb = ldb_; }
    __device__ __forceinline__ bool next(int i, Unit& u) const {
        const long L = (long)i * G + c; if (L >= nwg) return false;
        int wgid = (int)L; { const int q = nwg / NXCD, r = nwg % NXCD, xcd = wgid % NXCD, off = wgid / NXCD; wgid = (xcd < r ? xcd * (q + 1) : r * (q + 1) + (xcd - r) * q) + off; }
        const int nig = WGM * nN, gid = wgid / nig, fm = gid * WGM, gsz = (nM - fm) < WGM ? (nM - fm) : WGM;
        u.pm = fm + ((wgid % nig) % gsz); u.pn = (wgid % nig) / gsz; u.grp = 0; u.aux = 0;
        u.aoff = (size_t)u.pm * 256 * lda * 2; u.boff = (size_t)u.pn * 256 * ldb * 2; return true;
    }
    __device__ __forceinline__ void a_ready(const Unit&) const {}
    __device__ __forceinline__ void done(const Unit&) const {}
};
struct BranchOrder {
    StaticOrder so;
    __device__ __forceinline__ void init(int G_, int c_) { so.init(TOK, 1024, G_, c_, 512, 512); }
    __device__ __forceinline__ bool next(int i, Unit& u) const {
        const long L = (long)i * so.G + so.c; if (L >= 1024) return false;
        const int k = (int)(L >> 8); StaticOrder s2 = so; s2.G = 256; s2.c = (int)(L & 255);
        if (!s2.next(0, u)) return false;
        u.grp = k; u.aoff += (size_t)k * TOK * 512 * 2; u.boff += (size_t)k * 1024 * 512 * 2; return true;
    }
    __device__ __forceinline__ void a_ready(const Unit&) const {}
    __device__ __forceinline__ void done(const Unit&) const {}
};
struct S5eOrder {
    int G, c;
    __device__ __forceinline__ bool next(int i, Unit& u) const {
        const long L = (long)i * G + c; if (L >= 64) return false;
        const int g = (int)L >> 1, pm = (int)L & 1; u.pm = pm; u.pn = 0; u.grp = g; u.aux = 0;
        u.aoff = ((size_t)(g * 512 + pm * 256) * 640 + 128) * 2; u.boff = (size_t)g * 256 * 512 * 2; return true;
    }
    __device__ __forceinline__ void a_ready(const Unit&) const {}
    __device__ __forceinline__ void done(const Unit&) const {}
};
struct S5mOrder {
    int G, c;
    __device__ __forceinline__ bool next(int i, Unit& u) const {
        const long L = (long)i * G + c; if (L >= 128) return false;
        const int g = (int)L >> 2, pm = ((int)L >> 1) & 1, pn = (int)L & 1; u.pm = pm; u.pn = pn; u.grp = g; u.aux = 0;
        u.aoff = (size_t)(g * 512 + pm * 256) * 640 * 2; u.boff = (size_t)(g * 512 + pn * 256) * 640 * 2; return true;
    }
    __device__ __forceinline__ void a_ready(const Unit&) const {}
    __device__ __forceinline__ void done(const Unit&) const {}
};

struct VtOrder {
    int gi, idx;
    __device__ __forceinline__ bool next(int i, Unit& u) const {
        if (i > 0 || idx < 0) return false;
        const int sh = 2 * gi, pm = idx & 1, rest = idx >> 1, b = rest >> 5, r5 = rest & 31, pos0 = r5 * 256, res = pos0 >> (13 - sh), idx0 = pos0 & ((8192 >> sh) - 1), tok0 = (idx0 << sh) + res;
        u.pm = pm; u.pn = r5; u.grp = gi | (b << 2); u.aux = pos0;
        u.aoff = (size_t)(3072 + gi * 512 + pm * 256) * 1024 * 2; u.boff = (size_t)(b * SEQ + tok0) * 1024 * 2; return true;
    }
    __device__ __forceinline__ void a_ready(const Unit&) const {}
    __device__ __forceinline__ void done(const Unit&) const {}
};

typedef __bf16 bf16x2_t __attribute__((ext_vector_type(2)));
__device__ __forceinline__ unsigned cvt_pk_bf16(float lo, float hi) { const f32x2 v = {lo, hi}; const bf16x2_t b = __builtin_convertvector(v, bf16x2_t); return __builtin_bit_cast(unsigned, b); }
__device__ __forceinline__ u32x4 pack8(const f32x4& v0, const f32x4& v1) { u32x4 w; w.x = cvt_pk_bf16(v0[0], v0[1]); w.y = cvt_pk_bf16(v0[2], v0[3]); w.z = cvt_pk_bf16(v1[0], v1[1]); w.w = cvt_pk_bf16(v1[2], v1[3]); return w; }

template <int MODE> struct EpiGated {
    static constexpr bool PERM = true, AFTER_DRAIN = false;
    bf16_t* O; int ldo; const float* ssq;
    __device__ __forceinline__ void operator()(const f32x4 (&acc)[2][2][4][2], const Unit& u, int wr, int wc, int fr, int fq) const {
        const int row0 = u.pm * BM + wr * 64 + fr, col0 = u.pn * 128 + wc * 32 + 8 * fq;
#pragma unroll
        for (int ai = 0; ai < 2; ++ai)
#pragma unroll
            for (int m = 0; m < 4; ++m) { const int row = row0 + ai * HALF + m * 16; bf16_t* rowp = O + (size_t)row * ldo + col0;
                const float rs = ssq ? rsqrtf(ssq[row] * (1.f / DM) + NORM_EPS) : 1.f;
                f32x4 v[2];
#pragma unroll
                for (int n = 0; n < 2; ++n)
#pragma unroll
                    for (int j = 0; j < 4; ++j) { const float a = acc[ai][0][m][n][j] * rs, b = acc[ai][1][m][n][j] * rs; v[n][j] = (MODE == 0) ? siluf(a) * b : a * sigm(b); }
                *(u32x4*)rowp = pack8(v[0], v[1]); asm volatile("" ::: "memory"); }
    }
};
struct EpiResid {
    static constexpr bool PERM = false, AFTER_DRAIN = false;
    const float* base; float* out; float scale; bf16_t* xn; float* ssq;
    __device__ __forceinline__ void operator()(const f32x4 (&acc)[2][2][4][2], const Unit& u, int wr, int wc, int fr, int fq) const {
        const int row0 = u.pm * BM + wr * 64 + fr, col0 = u.pn * BM + wc * 32 + 4 * fq;
#pragma unroll
        for (int ai = 0; ai < 2; ++ai)
#pragma unroll
            for (int m = 0; m < 4; ++m) { const int row = row0 + ai * HALF + m * 16; const size_t off = (size_t)row * DM + col0; float ss = 0.f;
#pragma unroll
                for (int bj = 0; bj < 2; ++bj)
#pragma unroll
                    for (int n = 0; n < 2; ++n) { const size_t o = off + bj * HALF + n * 16; const f32x4 b = *(const f32x4*)(base + o); const f32x4 v = b + scale * acc[ai][bj][m][n];
                        *(f32x4*)(out + o) = v; ss += (v[0] * v[0] + v[1] * v[1]) + (v[2] * v[2] + v[3] * v[3]);
                        u32x2 w; w.x = cvt_pk_bf16(v[0], v[1]); w.y = cvt_pk_bf16(v[2], v[3]); *(u32x2*)(xn + o) = w; }
                ss += __shfl_xor(ss, 16); ss += __shfl_xor(ss, 32);
                if (fq == 0) atomicAdd(ssq + row, ss);
                asm volatile("" ::: "memory"); }
    }
};
struct EpiC1 {
    static constexpr bool PERM = true, AFTER_DRAIN = false;
    bf16_t* hq; bf16_t* s5A; bf16_t* convin; const float* ssq;
    __device__ __forceinline__ void operator()(const f32x4 (&acc)[2][2][4][2], const Unit& u, int wr, int wc, int fr, int fq) const {
        const int pn = u.pn, rowb = u.pm * BM + wr * 64 + fr, cl = wc * 32 + 8 * fq;
        bf16_t* p0; int sAI, sM1, sM0, sBJ;
        if (pn < 8) { p0 = hq + (size_t)(pn >> 1) * TOK * 512 + (size_t)rowb * 512 + (pn & 1) * 256 + cl; sAI = 128 * 512; sM1 = 32 * 512; sM0 = 16 * 512; sBJ = 128; }
        else if (pn < 10) { const int c5 = (pn - 8) * 256 + cl, g = c5 >> 4, ch = c5 & 15;
            p0 = s5A + ((size_t)(g * 512 + u.pm * 8 + 2 * wr) * 640 + 128 + fr * 16 + ch); sAI = 4 * 640; sM1 = 640; sM0 = 256; sBJ = 8 * 512 * 640; }
        else { p0 = convin + (size_t)rowb * 1024 + (pn - 10) * 256 + cl; sAI = 128 * 1024; sM1 = 32 * 1024; sM0 = 16 * 1024; sBJ = 128; }
#pragma unroll
        for (int ai = 0; ai < 2; ++ai)
#pragma unroll
            for (int m = 0; m < 4; ++m) { const float rs = rsqrtf(ssq[rowb + ai * HALF + m * 16] * (1.f / DM) + NORM_EPS);
#pragma unroll
                for (int bj = 0; bj < 2; ++bj)
                    *(u32x4*)(p0 + (size_t)(ai * sAI + (m >> 1) * sM1 + (m & 1) * sM0 + bj * sBJ)) = pack8(acc[ai][bj][m][0] * rs, acc[ai][bj][m][1] * rs);
                asm volatile("" ::: "memory"); }
    }
};
struct EpiQK {
    static constexpr bool PERM = true, AFTER_DRAIN = false;
    bf16_t* qkv; const float* ssq; const f32x2* rope;
    __device__ __forceinline__ void operator()(const f32x4 (&acc)[2][2][4][2], const Unit& u, int wr, int wc, int fr, int fq) const {
        const int which = u.pn / 6, hp = u.pn % 6, rowt = u.pm * BM, b = rowt >> 13, t0 = (rowt & 8191) + wr * 64 + fr;
        const float qs = which == 0 ? 0.08838834764831845f : 1.f;
#pragma unroll
        for (int ai = 0; ai < 2; ++ai)
#pragma unroll
            for (int m = 0; m < 4; ++m) { const int t = t0 + ai * HALF + m * 16; const float rs = rsqrtf(ssq[b * SEQ + t] * (1.f / DM) + NORM_EPS) * qs;
                f32x4 cs[4];
                if (wc == 0) { const f32x4* cp = (const f32x4*)(rope + (size_t)(b * SEQ + t) * 16 + 8 * (fq & 1));
#pragma unroll
                    for (int e = 0; e < 4; ++e) cs[e] = cp[e]; }
#pragma unroll
                for (int bj = 0; bj < 2; ++bj) { const int head = 2 * hp + bj, sh = 2 * (head >> 2), pos = ((t & ((1 << sh) - 1)) << (13 - sh)) + (t >> sh);
                    f32x4 v0 = acc[ai][bj][m][0] * rs, v1 = acc[ai][bj][m][1] * rs;
                    if (wc == 0) {
                        f32x4 p0, p1;
#pragma unroll
                        for (int j = 0; j < 4; ++j) { p0[j] = __shfl_xor(v0[j], 32); p1[j] = __shfl_xor(v1[j], 32); }
                        const float sg = fq < 2 ? -1.f : 1.f;
                        v0[0] = v0[0] * cs[0][0] + sg * p0[0] * cs[0][1]; v0[1] = v0[1] * cs[0][2] + sg * p0[1] * cs[0][3];
                        v0[2] = v0[2] * cs[1][0] + sg * p0[2] * cs[1][1]; v0[3] = v0[3] * cs[1][2] + sg * p0[3] * cs[1][3];
                        v1[0] = v1[0] * cs[2][0] + sg * p1[0] * cs[2][1]; v1[1] = v1[1] * cs[2][2] + sg * p1[1] * cs[2][3];
                        v1[2] = v1[2] * cs[3][0] + sg * p1[2] * cs[3][1]; v1[3] = v1[3] * cs[3][2] + sg * p1[3] * cs[3][3]; }
                    *(u32x4*)(qkv + ((size_t)(which * 24 + b * 12 + head) * SEQ + pos) * 128 + wc * 32 + 8 * fq) = pack8(v0, v1); }
                asm volatile("" ::: "memory"); }
    }
};
struct EpiVt {
    static constexpr bool PERM = true, AFTER_DRAIN = false;
    bf16_t* vt;
    __device__ __forceinline__ void operator()(const f32x4 (&acc)[2][2][4][2], const Unit& u, int wr, int wc, int fr, int fq) const {
        const int gi = u.grp & 3, b = u.grp >> 2;
        bf16_t* p0 = vt + ((size_t)(b * 12 + 4 * gi + 2 * u.pm) * 128 + wr * 64 + fr) * SEQ + u.aux + wc * 32 + 8 * fq;
#pragma unroll
        for (int ai = 0; ai < 2; ++ai)
#pragma unroll
            for (int m = 0; m < 4; ++m) {
#pragma unroll
                for (int bj = 0; bj < 2; ++bj)
                    *(u32x4*)(p0 + (size_t)(ai * HALF + m * 16) * SEQ + bj * HALF) = pack8(acc[ai][bj][m][0], acc[ai][bj][m][1]);
                asm volatile("" ::: "memory"); }
    }
};
struct EpiS5e {
    static constexpr bool PERM = false, AFTER_DRAIN = false;
    float* E;
    __device__ __forceinline__ void operator()(const f32x4 (&acc)[2][2][4][2], const Unit& u, int wr, int wc, int fr, int fq) const {
        const int row0 = u.pm * BM + wr * 64 + fr, col0 = wc * 32 + 4 * fq;
#pragma unroll
        for (int ai = 0; ai < 2; ++ai)
#pragma unroll
            for (int m = 0; m < 4; ++m) { float* rowp = E + (size_t)(u.grp * 512 + row0 + ai * HALF + m * 16) * 128 + col0;
#pragma unroll
                for (int n = 0; n < 2; ++n) *(f32x4*)(rowp + n * 16) = acc[ai][0][m][n]; }
    }
};
struct EpiS5m {
    static constexpr bool PERM = true, AFTER_DRAIN = false;
    const bf16_t* s5A; const float* dskip; bf16_t* Z;
    __device__ __forceinline__ void operator()(const f32x4 (&acc)[2][2][4][2], const Unit& u, int wr, int wc, int fr, int fq) const {
        const int g = u.grp, chunk0 = u.pm * BM + wr * 64 + fr, c0 = 8 * (fq & 1), t0 = u.pn * 16 + 2 * wc + (fq >> 1);
        const f32x4 d0 = *(const f32x4*)(dskip + g * 16 + c0), d1 = *(const f32x4*)(dskip + g * 16 + c0 + 4);
        const bf16_t* up = s5A + (size_t)(g * 512 + chunk0) * 640 + 128 + t0 * 16 + c0;
        bf16_t* zp = Z + (size_t)(chunk0 * 32 + t0) * 512 + g * 16 + c0;
#pragma unroll
        for (int ai = 0; ai < 2; ++ai)
#pragma unroll
            for (int m = 0; m < 4; ++m) {
#pragma unroll
                for (int bj = 0; bj < 2; ++bj) {
                    const u32x4 uu = *(const u32x4*)(up + (size_t)(ai * HALF + m * 16) * 640 + bj * 128);
                    f32x4 v0 = acc[ai][bj][m][0], v1 = acc[ai][bj][m][1];
                    v0[0] += d0[0] * bflo(uu.x); v0[1] += d0[1] * bfhi(uu.x); v0[2] += d0[2] * bflo(uu.y); v0[3] += d0[3] * bfhi(uu.y);
                    v1[0] += d1[0] * bflo(uu.z); v1[1] += d1[1] * bfhi(uu.z); v1[2] += d1[2] * bflo(uu.w); v1[3] += d1[3] * bfhi(uu.w);
#pragma unroll
                    for (int j = 0; j < 4; ++j) { v0[j] = gelu_tanh(v0[j]); v1[j] = gelu_tanh(v1[j]); }
                    *(u32x4*)(zp + (size_t)(ai * HALF + m * 16) * 32 * 512 + bj * 8 * 512) = pack8(v0, v1); }
                asm volatile("" ::: "memory"); }
    }
};
struct EpiBranch {
    static constexpr bool PERM = true, AFTER_DRAIN = false;
    bf16_t* Ball;
    __device__ __forceinline__ void operator()(const f32x4 (&acc)[2][2][4][2], const Unit& u, int wr, int wc, int fr, int fq) const {
        const int row0 = u.pm * BM + wr * 64 + fr, col0 = u.grp * 1024 + u.pn * BM + wc * 32 + 8 * fq;
#pragma unroll
        for (int ai = 0; ai < 2; ++ai)
#pragma unroll
            for (int m = 0; m < 4; ++m) { bf16_t* rowp = Ball + (size_t)(row0 + ai * HALF + m * 16) * 4096 + col0;
#pragma unroll
                for (int bj = 0; bj < 2; ++bj) *(u32x4*)(rowp + bj * HALF) = pack8(acc[ai][bj][m][0], acc[ai][bj][m][1]); }
    }
};
struct EpiGateMerge {
    static constexpr bool PERM = false, AFTER_DRAIN = false;
    const bf16_t* Ball; bf16_t* merged; const float* ssq;
    __device__ __forceinline__ void operator()(const f32x4 (&acc)[2][2][4][2], const Unit& u, int wr, int wc, int fr, int fq) const {
        const int row0 = u.pm * BM + wr * 64 + fr, mc = u.pn * 64 + wc * 16 + 4 * fq;
#pragma unroll
        for (int ai = 0; ai < 2; ++ai)
#pragma unroll
            for (int m = 0; m < 4; ++m) { const int row = row0 + ai * HALF + m * 16; const bf16_t* bp = Ball + (size_t)row * 4096 + mc;
                const float rs = rsqrtf(ssq[row] * (1.f / DM) + NORM_EPS);
                f32x4 s = {0.f, 0.f, 0.f, 0.f};
#pragma unroll
                for (int bj = 0; bj < 2; ++bj)
#pragma unroll
                    for (int n = 0; n < 2; ++n) { const u32x2 bv = *(const u32x2*)(bp + (2 * bj + n) * 1024); const f32x4 gt = acc[ai][bj][m][n] * rs;
                        s[0] += sigm(gt[0]) * bflo(bv.x); s[1] += sigm(gt[1]) * bfhi(bv.x); s[2] += sigm(gt[2]) * bflo(bv.y); s[3] += sigm(gt[3]) * bfhi(bv.y); }
                u32x2 w; w.x = cvt_pk_bf16(s[0], s[1]); w.y = cvt_pk_bf16(s[2], s[3]);
                *(u32x2*)(merged + (size_t)row * DM + mc) = w; }
    }
};

template <class Epi, class Sched, bool ALIGN_EPI = false, bool SP2 = false>
__device__ __forceinline__ void gemm_phase(PG8_LAS unsigned char* lds, const Gemm g, const Sched& S, const Epi& E, int tid_opaque) {
    const int tid = tid_opaque, wid = __builtin_amdgcn_readfirstlane(tid >> 6), lane = tid & 63, wr = wid >> 2, wc = wid & 3, fr = lane & 15, fq = lane >> 4;
    const int K = g.K, nt = K / BK, lda = g.lda, ldb = g.ldb;
    unsigned voffA[2], voffB[2];
#pragma unroll
    for (int i = 0; i < 2; ++i) { int R, C; stage_rc(tid * 16 + i * 8192, R, C); const int Rb = Epi::PERM ? ((R & ~31) + perm32(R & 31)) : R;
        voffA[i] = (unsigned)(R * lda + C) * 2u; voffB[i] = (unsigned)(Rb * ldb + C) * 2u; }
    const size_t kstep = (size_t)(BK * 2);
    const size_t hstepA = (size_t)HALF * lda * 2, hstepB = (size_t)HALF * ldb * 2;

    const unsigned ldsw = (unsigned)wid * 1024u;
    const int aoff = lds_byte(wr * 64 + fr, fq * 8), boff = lds_byte(wc * 32 + fr, fq * 8);
#define PG8_SA(b, h) (((b) * 2 + (h)) * HTB)
#define PG8_SB(b, h) ((4 + (b) * 2 + (h)) * HTB)
#define PG8_STAGE(bufoff, gbase, voff) do { _Pragma("unroll") for (int _i = 0; _i < 2; ++_i) \
        __builtin_amdgcn_global_load_lds((const unsigned*)((const char*)(gbase) + (voff)[_i]), (PG8_LAS unsigned*)(lds + (bufoff) + ldsw + _i * 8192), 16, 0, 0); } while (0)
#define PG8_LDA(dst, b, h) do { _Pragma("unroll") for (int m = 0; m < 4; ++m) _Pragma("unroll") for (int k = 0; k < 2; ++k) dst[m][k] = *(const PG8_LAS bf16x8*)(lds + PG8_SA(b, h) + aoff + m * 2048 + k * 1024); } while (0)
#define PG8_LDB(dst, b, h) do { _Pragma("unroll") for (int n = 0; n < 2; ++n) _Pragma("unroll") for (int k = 0; k < 2; ++k) dst[n][k] = *(const PG8_LAS bf16x8*)(lds + PG8_SB(b, h) + boff + n * 2048 + k * 1024); } while (0)
#define PG8_MMA(ai, bj, At, Bt) do { __builtin_amdgcn_s_setprio(1); _Pragma("unroll") for (int m = 0; m < 4; ++m) _Pragma("unroll") for (int n = 0; n < 2; ++n) _Pragma("unroll") for (int k = 0; k < 2; ++k) \
        acc[ai][bj][m][n] = __builtin_amdgcn_mfma_f32_16x16x32_bf16(Bt[n][k], At[m][k], acc[ai][bj][m][n], 0, 0, 0); __builtin_amdgcn_s_setprio(0); } while (0)
#define PG8_WAIT_V(n) asm volatile("s_waitcnt vmcnt(" #n ")" ::: "memory")
#define PG8_WAIT_L(n) asm volatile("s_waitcnt lgkmcnt(" #n ")" ::: "memory")
#define PG8_BAR __builtin_amdgcn_s_barrier()
#define PG8_SCHED __builtin_amdgcn_sched_barrier(0)
    Unit cur, nxt; int ui = 0;
    if (!S.next(0, cur)) return;
    f32x4 acc[2][2][4][2];
#pragma unroll
    for (int a = 0; a < 2; ++a)
#pragma unroll
        for (int b = 0; b < 2; ++b)
#pragma unroll
            for (int m = 0; m < 4; ++m)
#pragma unroll
                for (int n = 0; n < 2; ++n) acc[a][b][m][n] = (f32x4){0.f, 0.f, 0.f, 0.f};
    bf16x8 At[4][2], B0[2][2], B1[2][2];
    const char* cA = (const char*)g.A + cur.aoff; const char* cB = (const char*)g.Bt + cur.boff;
    S.a_ready(cur);
    if constexpr (SP2) {
        PG8_STAGE(PG8_SB(0, 0), cB, voffB); PG8_STAGE(PG8_SB(0, 1), cB + hstepB, voffB); PG8_STAGE(PG8_SA(0, 0), cA, voffA); PG8_STAGE(PG8_SA(0, 1), cA + hstepA, voffA);
        if (wr == 1) PG8_BAR;
        PG8_WAIT_V(2); PG8_BAR;
        PG8_STAGE(PG8_SB(1, 0), cB + kstep, voffB); PG8_STAGE(PG8_SA(1, 0), cA + kstep, voffA); PG8_STAGE(PG8_SB(1, 1), cB + hstepB + kstep, voffB);
        PG8_WAIT_V(6); PG8_BAR;
    } else {
        PG8_STAGE(PG8_SB(0, 0), cB, voffB); PG8_STAGE(PG8_SA(0, 0), cA, voffA); PG8_STAGE(PG8_SB(0, 1), cB + hstepB, voffB); PG8_STAGE(PG8_SA(0, 1), cA + hstepA, voffA);
        if (wr == 1) PG8_BAR;
        PG8_WAIT_V(4); PG8_BAR;
        PG8_STAGE(PG8_SB(1, 0), cB + kstep, voffB); PG8_STAGE(PG8_SA(1, 0), cA + kstep, voffA); PG8_STAGE(PG8_SB(1, 1), cB + hstepB + kstep, voffB);
        PG8_WAIT_V(6); PG8_BAR;
    }
    for (;;) {
        const bool has_next = S.next(ui + 1, nxt);
        const char* nA = has_next ? (const char*)g.A + nxt.aoff : cA; const char* nB = has_next ? (const char*)g.Bt + nxt.boff : cB;
        for (int t = 0; t < nt; t += 2) {
            const bool last = (t == nt - 2);
            const char* a1 = cA + (size_t)(t + 1) * kstep;
            const char* a2 = last ? nA : cA + (size_t)(t + 2) * kstep; const char* b2 = last ? nB : cB + (size_t)(t + 2) * kstep;
            const char* a3 = a2 + kstep; const char* b3 = b2 + kstep;
            if (last && has_next) S.a_ready(nxt);
            if constexpr (SP2) {
            PG8_LDB(B0, 0, 0); PG8_LDB(B1, 0, 1); PG8_SCHED; PG8_LDA(At, 0, 0); PG8_STAGE(PG8_SA(1, 1), a1 + hstepA, voffA);
            PG8_WAIT_V(8); PG8_WAIT_L(0); PG8_BAR; PG8_MMA(0, 0, At, B0); PG8_MMA(0, 1, At, B1); PG8_BAR; PG8_SCHED;
            PG8_LDA(At, 0, 1); PG8_STAGE(PG8_SB(0, 0), b2, voffB); PG8_STAGE(PG8_SB(0, 1), b2 + hstepB, voffB); PG8_STAGE(PG8_SA(0, 0), a2, voffA);
            PG8_WAIT_V(8); PG8_WAIT_L(0); PG8_BAR; PG8_MMA(1, 0, At, B0); PG8_MMA(1, 1, At, B1); PG8_BAR; PG8_SCHED;
            PG8_LDB(B0, 1, 0); PG8_LDB(B1, 1, 1); PG8_SCHED; PG8_LDA(At, 1, 0); PG8_STAGE(PG8_SA(0, 1), a2 + hstepA, voffA);
            PG8_WAIT_V(8); PG8_WAIT_L(0); PG8_BAR; PG8_MMA(0, 0, At, B0); PG8_MMA(0, 1, At, B1); PG8_BAR; PG8_SCHED;
            PG8_LDA(At, 1, 1); PG8_STAGE(PG8_SB(1, 0), b3, voffB); PG8_STAGE(PG8_SB(1, 1), b3 + hstepB, voffB); PG8_STAGE(PG8_SA(1, 0), a3, voffA);
            PG8_WAIT_V(8); PG8_WAIT_L(0); PG8_BAR; PG8_MMA(1, 0, At, B0); PG8_MMA(1, 1, At, B1); PG8_BAR; PG8_SCHED;
            } else {
            PG8_LDB(B0, 0, 0); PG8_SCHED; PG8_LDA(At, 0, 0); PG8_STAGE(PG8_SA(1, 1), a1 + hstepA, voffA);
            PG8_WAIT_L(8); PG8_BAR; PG8_WAIT_L(0); PG8_MMA(0, 0, At, B0); PG8_BAR; PG8_SCHED;
            PG8_LDB(B1, 0, 1); PG8_STAGE(PG8_SB(0, 0), b2, voffB);
            PG8_BAR; PG8_WAIT_L(0); PG8_MMA(0, 1, At, B1); PG8_BAR;
            PG8_LDA(At, 0, 1); PG8_STAGE(PG8_SA(0, 0), a2, voffA);
            PG8_BAR; PG8_WAIT_L(0); PG8_MMA(1, 0, At, B0); PG8_BAR; PG8_SCHED;
            PG8_STAGE(PG8_SB(0, 1), b2 + hstepB, voffB);
            PG8_WAIT_V(6); PG8_BAR; PG8_MMA(1, 1, At, B1); PG8_BAR;
            PG8_LDB(B0, 1, 0); PG8_SCHED; PG8_LDA(At, 1, 0); PG8_STAGE(PG8_SA(0, 1), a2 + hstepA, voffA);
            PG8_WAIT_L(8); PG8_BAR; PG8_WAIT_L(0); PG8_MMA(0, 0, At, B0); PG8_BAR; PG8_SCHED;
            PG8_LDB(B1, 1, 1); PG8_STAGE(PG8_SB(1, 0), b3, voffB);
            PG8_BAR; PG8_WAIT_L(0); PG8_MMA(0, 1, At, B1); PG8_BAR;
            PG8_LDA(At, 1, 1); PG8_STAGE(PG8_SA(1, 0), a3, voffA);
            PG8_BAR; PG8_WAIT_L(0); PG8_MMA(1, 0, At, B0); PG8_BAR; PG8_SCHED;
            PG8_STAGE(PG8_SB(1, 1), b3 + hstepB, voffB);
            PG8_WAIT_V(6); PG8_BAR; PG8_MMA(1, 1, At, B1); PG8_BAR;
            }
        }
        if constexpr (ALIGN_EPI) { if (wr == 0) PG8_BAR; }
        if constexpr (!Epi::AFTER_DRAIN) { int fr_ = fr, fq_ = fq; asm volatile("" : "+v"(fr_), "+v"(fq_)); E(acc, cur, wr, wc, fr_, fq_); S.done(cur); }
        if (!has_next) break;
#pragma unroll
        for (int a = 0; a < 2; ++a)
#pragma unroll
            for (int b = 0; b < 2; ++b)
#pragma unroll
                for (int m = 0; m < 4; ++m)
#pragma unroll
                    for (int n = 0; n < 2; ++n) acc[a][b][m][n] = (f32x4){0.f, 0.f, 0.f, 0.f};
        cur = nxt; cA = nA; cB = nB; ++ui;
        if constexpr (ALIGN_EPI) { if (wr == 1) PG8_BAR; }
    }
    PG8_WAIT_V(0);
    if constexpr (!ALIGN_EPI) { if (wr == 0) PG8_BAR; }
    PG8_BAR;
    if constexpr (Epi::AFTER_DRAIN) { E.fused(acc, cur, wr, wc, fr, fq, lds, wid, lane); S.done(cur); }
#undef PG8_SA
#undef PG8_SB
#undef PG8_STAGE
#undef PG8_LDA
#undef PG8_LDB
#undef PG8_MMA
#undef PG8_WAIT_V
#undef PG8_WAIT_L
#undef PG8_BAR
#undef PG8_SCHED
}

}

constexpr size_t MiB = 1u << 20;
constexpr size_t WS_CTL = 0;
constexpr size_t WS_SSQ = 64 * 1024;
constexpr size_t WS_ROPE = 1 * MiB;
constexpr size_t WS_LSE = 3 * MiB;
constexpr size_t WS_HGD = 4 * MiB;
constexpr size_t WS_A32 = WS_HGD + 768 * 1024;
constexpr size_t WS_S5E = 5 * MiB;
constexpr size_t WS_W = 13 * MiB;
constexpr size_t W_GU1 = WS_W, W_D1 = W_GU1 + 11 * MiB, W_GU2 = W_D1 + 11 * MiB / 2, W_D2 = W_GU2 + 11 * MiB;
constexpr size_t W_C1 = WS_W + 33 * MiB, W_C2 = W_C1 + 7 * MiB, W_GATE = W_C2 + 9 * MiB, W_BR = W_GATE + 8 * MiB, W_OUT = W_BR + 4 * MiB, W_GLU = W_OUT + 2 * MiB;
constexpr size_t W_S5M = W_GLU + 1 * MiB, W_S5E = W_S5M + 20 * MiB;
constexpr size_t WS_XN = 105 * MiB;
constexpr size_t WS_Y = 137 * MiB;
constexpr size_t WS_MERGED = 201 * MiB;
constexpr size_t WS_R = 233 * MiB;
constexpr size_t R_HQ = WS_R, R_S5A = WS_R + 64 * MiB, R_CONV = WS_R + 84 * MiB, R_HST = WS_R + 116 * MiB;
constexpr size_t R_QKV = WS_R, R_HBUF = WS_R, R_BALL = WS_R;
constexpr size_t WS_END = 381 * MiB;
static_assert(W_S5E + 8 * MiB <= WS_XN && W_D2 + 11 * MiB / 2 <= W_C1, "weight map");
constexpr size_t QKV_WHICH = (size_t)24 * SEQ * 128;

constexpr int LDS_BYTES = 163840;
constexpr int NWAVES = 8, NTHREADS = 512;
constexpr int XB_LDS_OFF = 163328;

struct Args { const float* in[30]; float* out; unsigned char* ws; int ph_lo, ph_hi; };

struct Ctx {
    LAS unsigned char* lds; int tid, lane, wave, G, bid, zo;
    const float* const* in; float* out; unsigned char* ws;
};
#define INP(c, k) ((c).in[(k) + (c).zo])

template <int MT, int NT, int KT>
__device__ __forceinline__ void wave_mma(f32x4 (&acc)[MT][NT], const LAS bf16_t* A, int lda, const LAS bf16_t* Bt, int ldb, int lane) {
    const int r = lane & 15, q = lane >> 4;
#pragma unroll
    for (int kk = 0; kk < KT; ++kk) {
        bf16x8 a[MT], b[NT];
#pragma unroll
        for (int mt = 0; mt < MT; ++mt) a[mt] = *(const LAS bf16x8*)(A + (mt * 16 + r) * lda + kk * 32 + q * 8);
#pragma unroll
        for (int nt = 0; nt < NT; ++nt) b[nt] = *(const LAS bf16x8*)(Bt + (nt * 16 + r) * ldb + kk * 32 + q * 8);
#pragma unroll
        for (int mt = 0; mt < MT; ++mt)
#pragma unroll
            for (int nt = 0; nt < NT; ++nt) acc[mt][nt] = __builtin_amdgcn_mfma_f32_16x16x32_bf16(a[mt], b[nt], acc[mt][nt], 0, 0, 0);
    }
}

__device__ __forceinline__ int rowmap(int kind, int n) {
    if (kind == 0) return n;
    if (kind == 1) return 256 * (n >> 7) + (n & 127);
    if (kind == 2) return 256 * (n >> 7) + 128 + (n & 127);
    const int k = n >> 10, mcol = n & 1023, pn = mcol >> 6, ml = mcol & 63, wc = ml >> 4, fq = (ml & 15) >> 2, i = ml & 3;
    return pn * 256 + 128 * (k >> 1) + 32 * wc + 16 * (k & 1) + 4 * fq + i;
}
__device__ __forceinline__ void transpose_item(const float* W, int ldw, int col0, int K, int Ncols, bf16_t* dst, const float* gain, int kind, LAS float* scr, int item, int lane) {
    const int nblk = Ncols / 32, kb = item / nblk, nb = item % nblk, k0 = 64 * kb, n0 = 32 * nb;
    float v[32];
#pragma unroll
    for (int i = 0; i < 32; ++i) v[i] = W[(size_t)(k0 + 2 * i + (lane >> 5)) * ldw + col0 + n0 + (lane & 31)];
    if (gain) {
#pragma unroll
        for (int i = 0; i < 32; ++i) v[i] *= gain[k0 + 2 * i + (lane >> 5)]; }
#pragma unroll
    for (int i = 0; i < 32; ++i) scr[(2 * i + (lane >> 5)) * 33 + (lane & 31)] = v[i];
    LDS_WAIT(); asm volatile("" ::: "memory");
    const int c = lane & 7;
#pragma unroll
    for (int j = 0; j < 4; ++j) { const int n = (lane >> 3) + 8 * j; const LAS float* s = scr + (8 * c) * 33 + n;
        u32x4 o; o.x = pk2(s[0 * 33], s[1 * 33]); o.y = pk2(s[2 * 33], s[3 * 33]); o.z = pk2(s[4 * 33], s[5 * 33]); o.w = pk2(s[6 * 33], s[7 * 33]);
        *(u32x4*)(dst + (size_t)rowmap(kind, n0 + n) * K + k0 + 8 * c) = o; }
    LDS_WAIT(); asm volatile("" ::: "memory");
}

__device__ __forceinline__ void s5_tables(const Ctx& c, int l, int g, int part) {
    LAS float* pwr = (LAS float*)c.lds; LAS float* pwi = pwr + 2112; LAS float* bbr = pwi + 2112; LAS float* bbi = bbr + 1024;
    LAS float* crT = bbi + 1024; LAS float* ciT = crT + 1024; LAS float* Kj = ciT + 1024;
    const int lg = l * 32 + g, tid = c.tid;
    const float* a_re = INP(c, 10) + lg * 64; const float* a_im = INP(c, 11) + lg * 64; const float* log_dt = INP(c, 12) + lg;
    const float* b_re = INP(c, 13) + (size_t)lg * 1024; const float* b_im = INP(c, 14) + (size_t)lg * 1024;
    const float* c_re = INP(c, 15) + (size_t)lg * 1024; const float* c_im = INP(c, 16) + (size_t)lg * 1024;
    if (tid < 64) {
        const int p = tid; const float dtf = expf(log_dt[0]), arf = a_re[p], aif = a_im[p], magf = expf(arf * dtf);
        const double ar = arf, ai = aif, abr = (double)(magf * cosf(aif * dtf)), abi = (double)(magf * sinf(aif * dtf)), den = ar * ar + ai * ai;
        const double zr = ((abr - 1.0) * ar + abi * ai) / den, zi = (abi * ar - (abr - 1.0) * ai) / den;
        double pr = 1.0, pi = 0.0;
        for (int j = 0; j <= 32; ++j) { pwr[p * 33 + j] = (float)pr; pwi[p * 33 + j] = (float)pi; const double nr = pr * abr - pi * abi, ni = pr * abi + pi * abr; pr = nr; pi = ni; }
        if (part == 0) { float* a32 = (float*)(c.ws + WS_A32) + (g * 64 + p) * 2; a32[0] = pwr[p * 33 + 32]; a32[1] = pwi[p * 33 + 32]; }
        for (int k = 0; k < 16; ++k) { const double br = b_re[p * 16 + k], bi = b_im[p * 16 + k]; bbr[p * 16 + k] = (float)(zr * br - zi * bi); bbi[p * 16 + k] = (float)(zr * bi + zi * br); }
    }
    for (int i = tid; i < 1024; i += NTHREADS) { const int cc = i >> 6, p = i & 63; crT[p * 16 + cc] = c_re[i]; ciT[p * 16 + cc] = c_im[i]; }
    __syncthreads();
    {
        const int j = tid >> 4, c2 = tid & 15; float acc[16];
#pragma unroll
        for (int cc = 0; cc < 16; ++cc) acc[cc] = 0.f;
        for (int p = 0; p < 64; ++p) { const float ar = pwr[p * 33 + j], ai = pwi[p * 33 + j], br = bbr[p * 16 + c2], bi = bbi[p * 16 + c2];
            const float xr = ar * br - ai * bi, xi = ar * bi + ai * br;
#pragma unroll
            for (int q4 = 0; q4 < 4; ++q4) { const f32x4 cr4 = *(const LAS f32x4*)(crT + p * 16 + 4 * q4), ci4 = *(const LAS f32x4*)(ciT + p * 16 + 4 * q4);
#pragma unroll
                for (int e = 0; e < 4; ++e) acc[4 * q4 + e] += cr4[e] * xr - ci4[e] * xi; } }
#pragma unroll
        for (int cc = 0; cc < 16; ++cc) Kj[j * 256 + cc * 16 + c2] = acc[cc];
    }
    __syncthreads();
    bf16_t* dm = (bf16_t*)(c.ws + W_S5M) + (size_t)g * 512 * 640;
    for (int ch = tid; ch < 64 * 80; ch += NTHREADS) { const int row = part * 64 + ch / 80, cch = ch % 80, t = row >> 4, cc = row & 15, col0 = cch * 8; float v[8];
        if (col0 < 64) {
#pragma unroll
            for (int e = 0; e < 8; ++e) { const int p = col0 + e; v[e] = crT[p * 16 + cc] * pwr[p * 33 + t + 1] - ciT[p * 16 + cc] * pwi[p * 33 + t + 1]; }
        } else if (col0 < 128) {
#pragma unroll
            for (int e = 0; e < 8; ++e) { const int p = col0 - 64 + e; v[e] = -(crT[p * 16 + cc] * pwi[p * 33 + t + 1] + ciT[p * 16 + cc] * pwr[p * 33 + t + 1]); }
        } else { const int s = (col0 - 128) >> 4, cb = (col0 - 128) & 15;
#pragma unroll
            for (int e = 0; e < 8; ++e) v[e] = (s <= t) ? Kj[(t - s) * 256 + cc * 16 + cb + e] : 0.f;
        }
        u32x4 o; o.x = pk2(v[0], v[1]); o.y = pk2(v[2], v[3]); o.z = pk2(v[4], v[5]); o.w = pk2(v[6], v[7]);
        *(u32x4*)(dm + (size_t)row * 640 + col0) = o; }
    bf16_t* de = (bf16_t*)(c.ws + W_S5E) + (size_t)g * 256 * 512;
    for (int ch = tid; ch < 32 * 64; ch += NTHREADS) { const int row = part * 32 + (ch >> 6), col0 = (ch & 63) * 8, s = col0 >> 4, cb = col0 & 15; float v[8];
#pragma unroll
        for (int e = 0; e < 8; ++e) {
            if (row < 64) { const int p = row; v[e] = pwr[p * 33 + 31 - s] * bbr[p * 16 + cb + e] - pwi[p * 33 + 31 - s] * bbi[p * 16 + cb + e]; }
            else if (row < 128) { const int p = row - 64; v[e] = pwr[p * 33 + 31 - s] * bbi[p * 16 + cb + e] + pwi[p * 33 + 31 - s] * bbr[p * 16 + cb + e]; }
            else v[e] = 0.f; }
        u32x4 o; o.x = pk2(v[0], v[1]); o.y = pk2(v[2], v[3]); o.z = pk2(v[4], v[5]); o.w = pk2(v[6], v[7]);
        *(u32x4*)(de + (size_t)row * 512 + col0) = o; }
    __syncthreads();
}

__device__ __forceinline__ void phase_wprep(const Ctx& c, int l) {
    for (int u = c.bid; u < 256; u += c.G) s5_tables(c, l, u >> 3, u & 7);
    if (l == 0) {
        const int* pos = (const int*)INP(c, 1); f32x2* rope = (f32x2*)(c.ws + WS_ROPE);
        for (int e = c.bid * NTHREADS + c.tid; e < TOK * 16; e += c.G * NTHREADS) { const int tok = e >> 4, i = e & 15;
            const float ang = (float)pos[tok] * exp2f(-1.1832230355827609f * (float)i); rope[e] = (f32x2){cosf(ang), sinf(ang)}; }
    }
    __syncthreads();
    LAS float* scr = (LAS float*)(c.lds + c.wave * 16384);
    const int gw = c.bid * NWAVES + c.wave, NGW = c.G * NWAVES;
    const float* n1 = INP(c, 2) + l * DM; const float* nm = INP(c, 6) + l * DM; const float* n2 = INP(c, 25) + l * DM;
    const float* wg1 = INP(c, 3) + (size_t)l * DM * DFF; const float* wu1 = INP(c, 4) + (size_t)l * DM * DFF; const float* wd1 = INP(c, 5) + (size_t)l * DFF * DM;
    const float* wg2 = INP(c, 26) + (size_t)l * DM * DFF; const float* wu2 = INP(c, 27) + (size_t)l * DM * DFF; const float* wd2 = INP(c, 28) + (size_t)l * DFF * DM;
    const float* win = INP(c, 7) + (size_t)l * DM * INW; const float* wbr = INP(c, 23) + (size_t)l * 4 * 512 * DM; const float* wout = INP(c, 24) + (size_t)l * DM * DM;
    const float* wglu = INP(c, 18) + (size_t)l * 512 * 1024;
    unsigned char* ws = c.ws;
    for (int it = gw; it < 16384; it += NGW) {
        int r = it;
        if (r < 1408) { transpose_item(wg1, DFF, 0, DM, DFF, (bf16_t*)(ws + W_GU1), n1, 1, scr, r, c.lane); continue; } r -= 1408;
        if (r < 1408) { transpose_item(wu1, DFF, 0, DM, DFF, (bf16_t*)(ws + W_GU1), n1, 2, scr, r, c.lane); continue; } r -= 1408;
        if (r < 1408) { transpose_item(wd1, DM, 0, DFF, DM, (bf16_t*)(ws + W_D1), nullptr, 0, scr, r, c.lane); continue; } r -= 1408;
        if (r < 1408) { transpose_item(wg2, DFF, 0, DM, DFF, (bf16_t*)(ws + W_GU2), n2, 1, scr, r, c.lane); continue; } r -= 1408;
        if (r < 1408) { transpose_item(wu2, DFF, 0, DM, DFF, (bf16_t*)(ws + W_GU2), n2, 2, scr, r, c.lane); continue; } r -= 1408;
        if (r < 1408) { transpose_item(wd2, DM, 0, DFF, DM, (bf16_t*)(ws + W_D2), nullptr, 0, scr, r, c.lane); continue; } r -= 1408;
        if (r < 1792) { transpose_item(win, INW, 0, DM, 3584, (bf16_t*)(ws + W_C1), nm, 0, scr, r, c.lane); continue; } r -= 1792;
        if (r < 2304) { transpose_item(win, INW, 3584, DM, 4608, (bf16_t*)(ws + W_C2), nm, 0, scr, r, c.lane); continue; } r -= 2304;
        if (r < 2048) { transpose_item(win, INW, 8192, DM, 4096, (bf16_t*)(ws + W_GATE), nm, 3, scr, r, c.lane); continue; } r -= 2048;
        if (r < 1024) { const int k = r >> 8; transpose_item(wbr + (size_t)k * 512 * DM, DM, 0, 512, DM, (bf16_t*)(ws + W_BR) + (size_t)k * 1024 * 512, nullptr, 0, scr, r & 255, c.lane); continue; } r -= 1024;
        if (r < 512) { transpose_item(wout, DM, 0, DM, DM, (bf16_t*)(ws + W_OUT), nullptr, 0, scr, r, c.lane); continue; } r -= 512;
        if (r < 128) { transpose_item(wglu, 1024, 0, 512, 512, (bf16_t*)(ws + W_GLU), nullptr, 1, scr, r, c.lane); continue; } r -= 128;
        transpose_item(wglu, 1024, 512, 512, 512, (bf16_t*)(ws + W_GLU), nullptr, 2, scr, r, c.lane);
    }
}

__device__ __forceinline__ void phase_norm_in(const Ctx& c, const float* x, bf16_t* xn, float* ssq) {
    const int gw = c.bid * NWAVES + c.wave, NGW = c.G * NWAVES;
    for (int row = gw; row < TOK; row += NGW) {
        const f32x4* xr = (const f32x4*)(x + (size_t)row * DM) + c.lane; f32x4 v[4]; float s = 0.f;
#pragma unroll
        for (int j = 0; j < 4; ++j) { v[j] = xr[64 * j]; s += (v[j][0] * v[j][0] + v[j][1] * v[j][1]) + (v[j][2] * v[j][2] + v[j][3] * v[j][3]); }
        s = wave_sum(s); if (c.lane == 0) ssq[row] = s;
        u32x2* o = (u32x2*)(xn + (size_t)row * DM) + c.lane;
#pragma unroll
        for (int j = 0; j < 4; ++j) { u32x2 w; w.x = pk2(v[j][0], v[j][1]); w.y = pk2(v[j][2], v[j][3]); o[64 * j] = w; }
    }
}
__device__ __forceinline__ void phase_final_norm(const Ctx& c, float* x, const float* gain, const float* ssq) {
    const int gw = c.bid * NWAVES + c.wave, NGW = c.G * NWAVES;
    for (int row = gw; row < TOK; row += NGW) {
        f32x4* xr = (f32x4*)(x + (size_t)row * DM) + c.lane; const float rs = rsqrtf(ssq[row] * (1.f / DM) + NORM_EPS);
#pragma unroll
        for (int j = 0; j < 4; ++j) { const f32x4 gn = ((const f32x4*)gain)[c.lane + 64 * j]; xr[64 * j] = xr[64 * j] * rs * gn; }
    }
}

constexpr int CV_OB = 62 * 512 * 4, CV_ST = CV_OB + 8 * 512 * 4;
static_assert(CV_ST + 64 <= XB_LDS_OFF, "conv LDS map");
__device__ __forceinline__ void phase_conv(const Ctx& c, int l) {
    LAS float* z = (LAS float*)c.lds; LAS float* ob = (LAS float*)(c.lds + CV_OB); LAS float* st = (LAS float*)(c.lds + CV_ST);
    const bf16_t* cin = (const bf16_t*)(c.ws + R_CONV); bf16_t* yc = (bf16_t*)(c.ws + WS_Y) + (size_t)2 * TOK * 512;
    const int ch = c.tid;
    const float* cw = INP(c, 19) + (size_t)l * 31 * 512; const float cb = INP(c, 20)[l * 512 + ch], lg = INP(c, 21)[l * 512 + ch], lb = INP(c, 22)[l * 512 + ch];
    float w[31];
#pragma unroll
    for (int j = 0; j < 31; ++j) w[j] = cw[j * 512 + ch];
    for (int unit = c.bid; unit < TOK / 32; unit += c.G) {
        const int b = unit >> 8, t0 = (unit & 255) * 32;
        {
            u32x4 av[8], bv[8];
#pragma unroll
            for (int i = 0; i < 8; ++i) { const int id = c.tid + NTHREADS * i, r = id >> 6, cc = id & 63, t = t0 - 30 + r;
                av[i] = (u32x4){0u, 0u, 0u, 0u}; bv[i] = av[i];
                if (r < 62 && t >= 0) { const bf16_t* rp = cin + (size_t)(b * SEQ + t) * 1024 + cc * 8; av[i] = *(const u32x4*)rp; bv[i] = *(const u32x4*)(rp + 512); } }
#pragma unroll
            for (int i = 0; i < 8; ++i) { const int id = c.tid + NTHREADS * i, r = id >> 6, cc = id & 63;
                if (r < 62) { const unsigned aw[4] = {av[i].x, av[i].y, av[i].z, av[i].w}, bw[4] = {bv[i].x, bv[i].y, bv[i].z, bv[i].w}; f32x4 z0, z1;
                    z0[0] = bflo(aw[0]) * sigm(bflo(bw[0])); z0[1] = bfhi(aw[0]) * sigm(bfhi(bw[0])); z0[2] = bflo(aw[1]) * sigm(bflo(bw[1])); z0[3] = bfhi(aw[1]) * sigm(bfhi(bw[1]));
                    z1[0] = bflo(aw[2]) * sigm(bflo(bw[2])); z1[1] = bfhi(aw[2]) * sigm(bfhi(bw[2])); z1[2] = bflo(aw[3]) * sigm(bflo(bw[3])); z1[3] = bfhi(aw[3]) * sigm(bfhi(bw[3]));
                    *(LAS f32x4*)(z + r * 512 + cc * 8) = z0; *(LAS f32x4*)(z + r * 512 + cc * 8 + 4) = z1; } }
        }
        __syncthreads();
#pragma unroll 1
        for (int blk = 0; blk < 4; ++blk) {
            float zr[38];
#pragma unroll
            for (int i = 0; i < 38; ++i) zr[i] = z[(blk * 8 + i) * 512 + ch];
            float o[8];
#pragma unroll
            for (int tt = 0; tt < 8; ++tt) { float a = cb;
#pragma unroll
                for (int j = 0; j < 31; ++j) a += w[j] * zr[tt + j];
                o[tt] = a; ob[tt * 512 + ch] = a; }
            __syncthreads();
            {
                float s1 = 0.f, s2 = 0.f;
#pragma unroll
                for (int j = 0; j < 8; ++j) { const float v = ob[c.wave * 512 + c.lane + 64 * j]; s1 += v; s2 += v * v; }
                s1 = wave_sum(s1); s2 = wave_sum(s2);
                const float mean = s1 * (1.f / 512.f), var = fmaxf(s2 * (1.f / 512.f) - mean * mean, 0.f);
                if (c.lane == 0) { st[c.wave * 2] = mean; st[c.wave * 2 + 1] = rsqrtf(var + NORM_EPS); }
            }
            __syncthreads();
#pragma unroll
            for (int tt = 0; tt < 8; ++tt) { const float y = (o[tt] - st[tt * 2]) * st[tt * 2 + 1] * lg + lb;
                yc[(size_t)(b * SEQ + t0 + blk * 8 + tt) * 512 + ch] = (bf16_t)f2bf(siluf(y)); }
        }
        __syncthreads();
    }
}
#define XB_TMO      128
#define XB_XCNT(j)  (256  + 64 * (j))
#define XB_XSUB(j)  (1280 + 64 * (j))
#define XB_XGEN(j)  (2304 + 64 * (j))
#define XB_TOP      3328
#define XB_TOPGEN   3392
#define XCD_BAR_WORDS 3456
#define XB_SPIN_CAP (1u << 18)

__device__ __forceinline__ unsigned xb_ld(unsigned* p)              { return __hip_atomic_load(p, __ATOMIC_RELAXED, __HIP_MEMORY_SCOPE_AGENT); }
__device__ __forceinline__ unsigned xb_add(unsigned* p, unsigned v) { return __hip_atomic_fetch_add(p, v, __ATOMIC_RELAXED, __HIP_MEMORY_SCOPE_AGENT); }
__device__ __forceinline__ unsigned xb_xcc_id() { return (unsigned)__builtin_amdgcn_s_getreg((3 << 11) | 20) & 0xFu; }
#define XB_SPIN(cond, bar) do { unsigned _sp = 0; while (cond) { __builtin_amdgcn_s_sleep(1); \
    if ((++_sp & 255u) == 0u) { if (xb_ld(&(bar)[XB_TMO])) break; if (_sp > XB_SPIN_CAP) { atomicAdd(&(bar)[XB_TMO], 1u); break; } } } } while (0)

struct XcdBarrier {
    unsigned* bar; unsigned x;
    volatile LAS unsigned* st;
};

__device__ __forceinline__ XcdBarrier xcd_barrier_post(unsigned* bar, volatile LAS unsigned* st) {
    XcdBarrier b; b.bar = bar; b.x = xb_xcc_id(); b.st = st;
    if (threadIdx.x == 0) (void)xb_add(&bar[XB_XCNT(b.x)], 1u);
    return b;
}
__device__ __forceinline__ void xcd_barrier_complete(unsigned* bar, unsigned x, unsigned& nloc, unsigned& nx) {
    const unsigned G = gridDim.x * gridDim.y * gridDim.z;
    unsigned sum, cnt, mine, sp = 0u;
    for (;;) {
        sum = 0u; cnt = 0u; mine = 0u;
#pragma unroll
        for (unsigned j = 0; j < 16; ++j) { const unsigned c = xb_ld(&bar[XB_XCNT(j)]); sum += c; cnt += (c > 0u) ? 1u : 0u; mine = (j == x) ? c : mine; }
        if (sum == G) break;
        __builtin_amdgcn_s_sleep(1);
        if ((++sp & 255u) == 0u) { if (xb_ld(&bar[XB_TMO])) break; if (sp > XB_SPIN_CAP) { atomicAdd(&bar[XB_TMO], 1u); break; } }
    }
    nloc = mine > 0u ? mine : 1u; nx = cnt > 0u ? cnt : 1u;
}

__device__ __forceinline__ void xcd_barrier(const XcdBarrier& b) {
    asm volatile("s_waitcnt vmcnt(0)" ::: "memory");
    __syncthreads();
    if (threadIdx.x == 0) {
        unsigned* bar = b.bar;
        __builtin_amdgcn_s_waitcnt(0);
        unsigned nloc = b.st[0], nx = b.st[1];
        if (nloc == 0u) { xcd_barrier_complete(bar, b.x, nloc, nx); b.st[0] = nloc; b.st[1] = nx; }
        const unsigned old = xb_add(&bar[XB_XSUB(b.x)], 1u);
        const unsigned gen = old / nloc;
        if (old + 1u == (gen + 1u) * nloc) {
            __builtin_amdgcn_fence(__ATOMIC_RELEASE, "agent");
            asm volatile("s_waitcnt vmcnt(0)" ::: "memory");
            const unsigned og = xb_add(&bar[XB_TOP], 1u);
            const unsigned tg = og / nx;
            if (og + 1u == (tg + 1u) * nx) xb_add(&bar[XB_TOPGEN], 1u);
            else XB_SPIN(xb_ld(&bar[XB_TOPGEN]) == tg, bar);
            __builtin_amdgcn_fence(__ATOMIC_ACQUIRE, "agent");
            xb_add(&bar[XB_XGEN(b.x)], 1u);
            asm volatile("s_waitcnt vmcnt(0)" ::: "memory");
        } else {
            XB_SPIN(xb_ld(&bar[XB_XGEN(b.x)]) == gen, bar);
            __builtin_amdgcn_fence(__ATOMIC_ACQUIRE, "agent");
            asm volatile("s_waitcnt vmcnt(0)" ::: "memory");
        }
    }
    __syncthreads();
}

__device__ __forceinline__ float hg_lb(const Ctx& c, int l, int col) {
    if (l == 0) return 0.f;
    const float z0 = INP(c, 8)[col], z1 = INP(c, 8)[512 + col], m = fmaxf(z0, z1), e0 = expf(z0 - m), e1 = expf(z1 - m);
    return e1 / (e0 + e1);
}
__device__ __forceinline__ unsigned short bf1(float x) { return (unsigned short)(pg8::cvt_pk_bf16(x, x) & 0xffffu); }
__device__ __forceinline__ void hg_stage_tile(const bf16_t* src, int row0, int h, LAS bf16_t* dst, int tid) {
#pragma unroll
    for (int i = 0; i < 2; ++i) { const int id = tid + NTHREADS * i, s = id >> 4, cc = id & 15;
        *(LAS u32x4*)(dst + s * 136 + cc * 8) = *(const u32x4*)(src + (size_t)(row0 + s) * 512 + h * 128 + cc * 8); }
}
__device__ __forceinline__ void hg_logf(const LAS bf16_t* fr, float lbv, int k, int rg, LAS float* bL, LAS float* seg, float (&kk)[16]) {
    float run = 0.f;
#pragma unroll
    for (int j = 0; j < 16; ++j) { const int s = rg * 16 + j; const float f = bf2f(fr[s * 136 + k]);
        const float ex = __expf(-f), sg = __builtin_amdgcn_rcpf(1.f + ex);
        const float lf = __logf(lbv + (1.f - lbv) * sg);
        kk[j] = (1.f - lbv) * ex * sg; run += lf; bL[s * 129 + k] = run; }
    seg[rg * 128 + k] = run;
}
__device__ __forceinline__ void hg_load_vT(const bf16_t* hv, int row0, int h, LAS bf16_t* vT, int wave, int lane) {
    u32x4 v[2];
#pragma unroll
    for (int i = 0; i < 2; ++i) v[i] = *(const u32x4*)(hv + (size_t)(row0 + lane) * 512 + h * 128 + (wave + 8 * i) * 8);
#pragma unroll
    for (int i = 0; i < 2; ++i) { const int cc = wave + 8 * i; const unsigned vw[4] = {v[i].x, v[i].y, v[i].z, v[i].w};
#pragma unroll
        for (int e = 0; e < 4; ++e) { vT[(cc * 8 + 2 * e) * 72 + lane] = (bf16_t)(vw[e] & 0xffffu); vT[(cc * 8 + 2 * e + 1) * 72 + lane] = (bf16_t)(vw[e] >> 16); } }
}
constexpr int HG1_KDT = 35072, HG1_VT = 53504, HG1_FR = 71936;
__device__ __forceinline__ void phase_hg1(const Ctx& c, int l) {
    LAS float* bL = (LAS float*)c.lds; LAS float* seg = bL + 64 * 129;
    LAS bf16_t* kdT = (LAS bf16_t*)(c.lds + HG1_KDT); LAS bf16_t* vT = (LAS bf16_t*)(c.lds + HG1_VT); LAS bf16_t* fr = (LAS bf16_t*)(c.lds + HG1_FR);
    const bf16_t* hf = (const bf16_t*)(c.ws + R_HQ) + (size_t)TOK * 512; const bf16_t* hv = hf + (size_t)TOK * 512;
    bf16_t* hst = (bf16_t*)(c.ws + R_HST); float* hgd = (float*)(c.ws + WS_HGD);
    const int k = c.tid & 127, rg = c.tid >> 7, r = c.lane & 15, q = c.lane >> 4;
    for (int unit = c.bid; unit < 1024; unit += c.G) {
        const int b = unit >> 9, n = (unit >> 2) & 127, h = unit & 3, row0 = b * SEQ + n * 64, col = h * 128 + k;
        const float lbv = hg_lb(c, l, col);
        float kk[16];
        hg_stage_tile(hf, row0, h, fr, c.tid);
        hg_load_vT(hv, row0, h, vT, c.wave, c.lane);
        __syncthreads();
        hg_logf(fr, lbv, k, rg, bL, seg, kk);
        __syncthreads();
        float pre = 0.f;
        for (int s = 0; s < rg; ++s) pre += seg[s * 128 + k];
        const float blast = (seg[k] + seg[128 + k]) + (seg[256 + k] + seg[384 + k]);
        unsigned w[8];
#pragma unroll
        for (int j = 0; j < 8; ++j) { const int s = rg * 16 + 2 * j;
            const float b0 = bL[s * 129 + k] + pre, b1 = bL[(s + 1) * 129 + k] + pre;
            w[j] = pg8::cvt_pk_bf16(kk[2 * j] * __expf(blast - b0), kk[2 * j + 1] * __expf(blast - b1)); }
        { LAS u32x4* d = (LAS u32x4*)(kdT + k * 72 + rg * 16); d[0] = (u32x4){w[0], w[1], w[2], w[3]}; d[1] = (u32x4){w[4], w[5], w[6], w[7]}; }
        if (rg == 0) hgd[unit * 128 + k] = __expf(blast);
        __syncthreads();
        f32x4 acc[1][8];
#pragma unroll
        for (int nt = 0; nt < 8; ++nt) acc[0][nt] = (f32x4){0.f, 0.f, 0.f, 0.f};
        wave_mma<1, 8, 2>(acc, vT + (16 * c.wave) * 72, 72, kdT, 72, c.lane);
        bf16_t* dst = hst + (size_t)unit * 16384;
#pragma unroll
        for (int nt = 0; nt < 8; ++nt)
#pragma unroll
            for (int j = 0; j < 4; ++j) dst[(16 * c.wave + 4 * q + j) * 128 + nt * 16 + r] = bf1(acc[0][nt][j]);
        __syncthreads();
    }
}
__device__ __forceinline__ void phase_hg2(const Ctx& c) {
    const bf16_t* hst = (const bf16_t*)(c.ws + R_HST); bf16_t* hss = (bf16_t*)(c.ws + R_CONV); const float* hgd = (const float*)(c.ws + WS_HGD);
    for (int idx = c.bid * NTHREADS + c.tid; idx < 65536; idx += c.G * NTHREADS) {
        const int bh = idx >> 13, e2 = idx & 8191, b = bh >> 2, h = bh & 3, kc = (e2 * 2) & 127;
        float s0 = 0.f, s1 = 0.f;
        for (int n0 = 0; n0 < 128; n0 += 32) {
            unsigned u[32]; f32x2 d[32];
#pragma unroll
            for (int i = 0; i < 32; ++i) { const int unit = (b * 128 + n0 + i) * 4 + h; u[i] = ((const unsigned*)(hst + (size_t)unit * 16384))[e2]; d[i] = *(const f32x2*)(hgd + unit * 128 + kc); }
#pragma unroll
            for (int i = 0; i < 32; ++i) { const int unit = (b * 128 + n0 + i) * 4 + h; ((unsigned*)(hss + (size_t)unit * 16384))[e2] = pk2(s0, s1);
                s0 = d[i][0] * s0 + bflo(u[i]); s1 = d[i][1] * s1 + bfhi(u[i]); }
        }
    }
}
constexpr int HG3_QD = 35072, HG3_ST = 52480, HG3_QT = 87296, HG3_KT = 104704, HG3_P = 122112, HG3_VT = 131328;
static_assert(HG3_VT + 128 * 72 * 2 <= LDS_BYTES, "hg3 LDS map");
__device__ __forceinline__ void phase_hg3(const Ctx& c, int l) {
    LAS float* bL = (LAS float*)c.lds; LAS float* seg = bL + 64 * 129;
    LAS bf16_t* qd = (LAS bf16_t*)(c.lds + HG3_QD); LAS bf16_t* ST = (LAS bf16_t*)(c.lds + HG3_ST); LAS bf16_t* qt = (LAS bf16_t*)(c.lds + HG3_QT);
    LAS bf16_t* kt = (LAS bf16_t*)(c.lds + HG3_KT); LAS bf16_t* P = (LAS bf16_t*)(c.lds + HG3_P); LAS bf16_t* vT = (LAS bf16_t*)(c.lds + HG3_VT);
    const bf16_t* hq = (const bf16_t*)(c.ws + R_HQ); const bf16_t* hf = hq + (size_t)TOK * 512; const bf16_t* hv = hf + (size_t)TOK * 512; const bf16_t* hg = hv + (size_t)TOK * 512;
    const bf16_t* hst = (const bf16_t*)(c.ws + R_CONV); bf16_t* ya = (bf16_t*)(c.ws + WS_Y);
    const float* gnorm = INP(c, 9) + l * 512;
    const int k = c.tid & 127, rg = c.tid >> 7, r = c.lane & 15, q = c.lane >> 4, w = c.wave;
    for (int unit = c.bid; unit < 1024; unit += c.G) {
        const int b = unit >> 9, n = (unit >> 2) & 127, h = unit & 3, row0 = b * SEQ + n * 64, col = h * 128 + k;
        const float lbv = hg_lb(c, l, col);
        float kk[16];
        hg_stage_tile(hf, row0, h, qt, c.tid);
        hg_stage_tile(hq, row0, h, kt, c.tid);
        hg_load_vT(hv, row0, h, vT, c.wave, c.lane);
#pragma unroll
        for (int i = 0; i < 4; ++i) { const int id = c.tid + NTHREADS * i, v = id >> 4, cc = id & 15;
            *(LAS u32x4*)(ST + v * 136 + cc * 8) = *(const u32x4*)(hst + (size_t)unit * 16384 + v * 128 + cc * 8); }
        __syncthreads();
        hg_logf(qt, lbv, k, rg, bL, seg, kk);
        __syncthreads();
        float pre = 0.f;
        for (int s = 0; s < rg; ++s) pre += seg[s * 128 + k];
        const float bref = bL[31 * 129 + k] + seg[k];
#pragma unroll
        for (int j = 0; j < 16; ++j) { const int s = rg * 16 + j; const float bv = bL[s * 129 + k] + pre;
            const float qf = siluf(bf2f(kt[s * 136 + k])) * 0.08838834764831845f;
            qd[s * 136 + k] = bf1(qf * __expf(bv));
            qt[s * 136 + k] = bf1(qf * __expf(fminf(bv - bref, 80.f)));
            kt[s * 136 + k] = bf1(kk[j] * __expf(fminf(bref - bv, 80.f))); }
        __syncthreads();
        {
            f32x4 a2[1][2] = {{(f32x4){0.f, 0.f, 0.f, 0.f}, (f32x4){0.f, 0.f, 0.f, 0.f}}};
            wave_mma<1, 2, 4>(a2, qt + (16 * (w >> 1)) * 136, 136, kt + (32 * (w & 1)) * 136, 136, c.lane);
#pragma unroll
            for (int nt = 0; nt < 2; ++nt)
#pragma unroll
                for (int j = 0; j < 4; ++j) { const int t = 16 * (w >> 1) + 4 * q + j, s = 32 * (w & 1) + nt * 16 + r; P[t * 72 + s] = bf1(s <= t ? a2[0][nt][j] : 0.f); }
        }
        __syncthreads();
        {
            f32x4 a4[1][4];
#pragma unroll
            for (int nt = 0; nt < 4; ++nt) a4[0][nt] = (f32x4){0.f, 0.f, 0.f, 0.f};
            wave_mma<1, 4, 4>(a4, qd + (16 * (w >> 1)) * 136, 136, ST + (64 * (w & 1)) * 136, 136, c.lane);
            wave_mma<1, 4, 2>(a4, P + (16 * (w >> 1)) * 72, 72, vT + (64 * (w & 1)) * 72, 72, c.lane);
#pragma unroll
            for (int nt = 0; nt < 4; ++nt)
#pragma unroll
                for (int j = 0; j < 4; ++j) bL[(16 * (w >> 1) + 4 * q + j) * 129 + 64 * (w & 1) + nt * 16 + r] = a4[0][nt][j];
        }
        __syncthreads();
        {
            const int t = c.tid >> 3, v0 = (c.tid & 7) * 16; float o[16]; float ss = 0.f;
#pragma unroll
            for (int e = 0; e < 16; ++e) { o[e] = bL[t * 129 + v0 + e]; ss += o[e] * o[e]; }
            ss += __shfl_xor(ss, 1); ss += __shfl_xor(ss, 2); ss += __shfl_xor(ss, 4);
            const float rs = 1.f / sqrtf(ss * (1.f / 128.f) + NORM_EPS);
            const bf16_t* gp = hg + (size_t)(row0 + t) * 512 + h * 128 + v0; const u32x4 g0 = *(const u32x4*)gp, g1 = *(const u32x4*)(gp + 8);
            const unsigned gw[8] = {g0.x, g0.y, g0.z, g0.w, g1.x, g1.y, g1.z, g1.w}; unsigned ow[8];
#pragma unroll
            for (int e = 0; e < 8; ++e) { const float ga = bflo(gw[e]), gb = bfhi(gw[e]);
                ow[e] = pg8::cvt_pk_bf16(o[2 * e] * rs * gnorm[h * 128 + v0 + 2 * e] * siluf(ga), o[2 * e + 1] * rs * gnorm[h * 128 + v0 + 2 * e + 1] * siluf(gb)); }
            bf16_t* yp = ya + (size_t)(row0 + t) * 512 + h * 128 + v0;
            *(u32x4*)yp = (u32x4){ow[0], ow[1], ow[2], ow[3]}; *(u32x4*)(yp + 8) = (u32x4){ow[4], ow[5], ow[6], ow[7]};
        }
        __syncthreads();
    }
}

__device__ __forceinline__ void phase_s5scan(const Ctx& c) {
    const int idx = c.bid * NTHREADS + c.tid;
    if (idx >= 4096) return;
    const int b = idx >> 11, g = (idx >> 6) & 31, p = idx & 63;
    const float* a32 = (const float*)(c.ws + WS_A32) + (g * 64 + p) * 2; const float ar = a32[0], ai = a32[1];
    bf16_t* s5A = (bf16_t*)(c.ws + R_S5A); const float* E = (const float*)(c.ws + WS_S5E);
    float xr = 0.f, xi = 0.f;
    for (int n0 = 0; n0 < 256; n0 += 32) {
        float er[32], ei[32];
#pragma unroll
        for (int i = 0; i < 32; ++i) { const size_t row = (size_t)g * 512 + b * 256 + n0 + i; er[i] = E[row * 128 + p]; ei[i] = E[row * 128 + 64 + p]; }
#pragma unroll
        for (int i = 0; i < 32; ++i) { const size_t row = (size_t)g * 512 + b * 256 + n0 + i; s5A[row * 640 + p] = (bf16_t)f2bf(xr); s5A[row * 640 + 64 + p] = (bf16_t)f2bf(xi);
            const float nr = ar * xr - ai * xi + er[i], ni = ar * xi + ai * xr + ei[i]; xr = nr; xi = ni; }
    }
}

constexpr int AT_VT = 256 * 136 * 2, AT_P = AT_VT + 128 * 264 * 2, AT_RS = AT_P + 8 * 16 * 72 * 2;
static_assert(AT_RS + 256 * 4 <= XB_LDS_OFF, "attention LDS map");
__device__ __forceinline__ void phase_attn(const Ctx& c, const float* ssq, bool dry) {
    LAS bf16_t* Ks = (LAS bf16_t*)c.lds; LAS bf16_t* Vts = (LAS bf16_t*)(c.lds + AT_VT); LAS bf16_t* Pw = (LAS bf16_t*)(c.lds + AT_P) + c.wave * (16 * 72); LAS float* rsL = (LAS float*)(c.lds + AT_RS);
    bf16_t* qkv = (bf16_t*)(c.ws + R_QKV); float* lse = (float*)(c.ws + WS_LSE);
    const int r = c.lane & 15, q4 = c.lane >> 4, w = c.wave;
    for (int unit = c.bid; unit < 1536; unit += c.G) {
        const int bh = unit >> 6, pos0 = (unit & 63) * 128, b = bh / 12, h = bh % 12, sh = 2 * (h >> 2), res = pos0 >> (13 - sh), i0 = pos0 & ((8192 >> sh) - 1);
        const bf16_t* qb = qkv + (size_t)bh * SEQ * 128; bf16_t* ob = dry ? (bf16_t*)(c.ws + WS_MERGED) + (size_t)(bh & 7) * SEQ * 128 : qkv + (size_t)bh * SEQ * 128; float* lso = dry ? (float*)(c.ws + WS_MERGED + 24 * MiB) : lse; const bf16_t* kb = qkv + QKV_WHICH + (size_t)bh * SEQ * 128; const bf16_t* vb = qkv + 2 * QKV_WHICH + (size_t)bh * SEQ * 128;
        bf16x8 qf[4];
#pragma unroll
        for (int kk = 0; kk < 4; ++kk) qf[kk] = *(const bf16x8*)(qb + (size_t)(pos0 + 16 * w + r) * 128 + kk * 32 + q4 * 8);
        {
            u32x4 kv[8], vv[8];
#pragma unroll
            for (int i = 0; i < 8; ++i) { const int id = c.tid + NTHREADS * i; kv[i] = *(const u32x4*)(kb + ((long)pos0 - 128 + (id >> 4)) * 128 + (id & 15) * 8); }
#pragma unroll
            for (int i = 0; i < 8; ++i) { const int id = c.tid + NTHREADS * i; vv[i] = *(const u32x4*)(vb + (long)(id >> 5) * SEQ + pos0 - 128 + (id & 31) * 8); }
#pragma unroll
            for (int i = 0; i < 8; ++i) { const int id = c.tid + NTHREADS * i; *(LAS u32x4*)(Ks + (id >> 4) * 136 + (id & 15) * 8) = kv[i]; }
#pragma unroll
            for (int i = 0; i < 8; ++i) { const int id = c.tid + NTHREADS * i; *(LAS u32x4*)(Vts + (id >> 5) * 264 + (id & 31) * 8) = vv[i]; }
            if (c.tid < 256) { const int j = i0 - 128 + c.tid; rsL[c.tid] = j >= 0 ? rsqrtf(ssq[b * SEQ + (j << sh) + res] * (1.f / DM) + NORM_EPS) : 0.f; }
        }
        __syncthreads();
        f32x4 s[16];
#pragma unroll
        for (int nt = 0; nt < 16; ++nt) s[nt] = (f32x4){0.f, 0.f, 0.f, 0.f};
#pragma unroll
        for (int kk = 0; kk < 4; ++kk)
#pragma unroll
            for (int nt = 0; nt < 16; ++nt) { const bf16x8 kf = *(const LAS bf16x8*)(Ks + (nt * 16 + r) * 136 + kk * 32 + q4 * 8); s[nt] = __builtin_amdgcn_mfma_f32_16x16x32_bf16(qf[kk], kf, s[nt], 0, 0, 0); }
        float mx[4];
#pragma unroll
        for (int j = 0; j < 4; ++j) { const int qi = 16 * w + 4 * q4 + j; float m = -1e30f;
#pragma unroll
            for (int nt = 0; nt < 16; ++nt) { const int kk = nt * 16 + r; const bool ok = (kk >= qi) && (kk <= qi + 128) && (i0 > 0 || kk >= 128); const float v = ok ? s[nt][j] : -1e30f; s[nt][j] = v; m = fmaxf(m, v); }
            m = fmaxf(m, __shfl_xor(m, 1)); m = fmaxf(m, __shfl_xor(m, 2)); m = fmaxf(m, __shfl_xor(m, 4)); m = fmaxf(m, __shfl_xor(m, 8)); mx[j] = m; }
        float ls[4] = {0.f, 0.f, 0.f, 0.f};
        f32x4 o[8];
#pragma unroll
        for (int dt = 0; dt < 8; ++dt) o[dt] = (f32x4){0.f, 0.f, 0.f, 0.f};
#pragma unroll
        for (int kq = 0; kq < 4; ++kq) {
#pragma unroll
            for (int n4 = 0; n4 < 4; ++n4) { const int nt = 4 * kq + n4; const float rk = rsL[nt * 16 + r];
#pragma unroll
                for (int j = 0; j < 4; ++j) { const float p = __expf(s[nt][j] - mx[j]); ls[j] += p; Pw[(4 * q4 + j) * 72 + n4 * 16 + r] = (bf16_t)(pg8::cvt_pk_bf16(p * rk, 0.f) & 0xffffu); } }
            asm volatile("s_waitcnt lgkmcnt(0)" ::: "memory");
#pragma unroll
            for (int k2 = 0; k2 < 2; ++k2) { const bf16x8 pf = *(const LAS bf16x8*)(Pw + r * 72 + k2 * 32 + q4 * 8);
#pragma unroll
                for (int dt = 0; dt < 8; ++dt) { const bf16x8 vf = *(const LAS bf16x8*)(Vts + (dt * 16 + r) * 264 + kq * 64 + k2 * 32 + q4 * 8); o[dt] = __builtin_amdgcn_mfma_f32_16x16x32_bf16(pf, vf, o[dt], 0, 0, 0); } }
            asm volatile("s_waitcnt lgkmcnt(0)" ::: "memory");
        }
#pragma unroll
        for (int j = 0; j < 4; ++j) { float l = ls[j]; l += __shfl_xor(l, 1); l += __shfl_xor(l, 2); l += __shfl_xor(l, 4); l += __shfl_xor(l, 8);
            const int row = pos0 + 16 * w + 4 * q4 + j; if (r == 0) lso[(size_t)bh * SEQ + row] = mx[j] + __logf(l);
            const float inv = 1.f / l;
#pragma unroll
            for (int dt = 0; dt < 8; ++dt) ob[(size_t)row * 128 + dt * 16 + r] = (bf16_t)(pg8::cvt_pk_bf16(o[dt][j] * inv, 0.f) & 0xffffu); }
        __syncthreads();
    }
}
__device__ __forceinline__ void phase_attn_merge(const Ctx& c) {
    const bf16_t* qkv = (const bf16_t*)(c.ws + R_QKV); const float* lse = (const float*)(c.ws + WS_LSE); bf16_t* yd = (bf16_t*)(c.ws + WS_Y) + (size_t)3 * TOK * 512;
    for (int id = c.bid * NTHREADS + c.tid; id < TOK * 64; id += c.G * NTHREADS) {
        const int row = id >> 6, hp = (id >> 4) & 3, cc = id & 15, b = row >> 13, t = row & 8191;
        float lw[3]; u32x4 ov[3];
#pragma unroll
        for (int g = 0; g < 3; ++g) { const int bh = b * 12 + g * 4 + hp, sh = 2 * g, pos = ((t & ((1 << sh) - 1)) << (13 - sh)) + (t >> sh);
            lw[g] = lse[(size_t)bh * SEQ + pos]; ov[g] = *(const u32x4*)(qkv + ((size_t)bh * SEQ + pos) * 128 + cc * 8); }
        const float m = fmaxf(lw[0], fmaxf(lw[1], lw[2])); float e[3], s = 0.f;
#pragma unroll
        for (int g = 0; g < 3; ++g) { e[g] = __expf(lw[g] - m); s += e[g]; }
        const float inv = 1.f / s; float o[8];
#pragma unroll
        for (int i = 0; i < 8; ++i) o[i] = 0.f;
#pragma unroll
        for (int g = 0; g < 3; ++g) { const float wg = e[g] * inv; const unsigned vw[4] = {ov[g].x, ov[g].y, ov[g].z, ov[g].w};
#pragma unroll
            for (int i = 0; i < 4; ++i) { o[2 * i] += wg * bflo(vw[i]); o[2 * i + 1] += wg * bfhi(vw[i]); } }
        *(u32x4*)(yd + (size_t)row * 512 + hp * 128 + cc * 8) = (u32x4){pk2(o[0], o[1]), pk2(o[2], o[3]), pk2(o[4], o[5]), pk2(o[6], o[7])};
    }
}

#ifndef MK_REP_ATT
#define MK_REP_ATT 0
#endif
#ifndef MK_REP
#define MK_REP -1
#endif
constexpr int PH_PER_LAYER = 15, PH_SEQ = PH_PER_LAYER + (MK_REP >= 0 ? 1 : 0), N_PHASES = NLAYER * PH_SEQ + 1;
#ifndef MK_MASK
#define MK_MASK 0xFFFFF
#endif
#ifndef MK_CG_SYNC
#define MK_CG_SYNC 0
#endif
#ifndef MK_SPLIT
#define MK_SPLIT 0
#endif

template <class Epi> __device__ __forceinline__ void run_gemm(const Ctx& c, const bf16_t* A, int lda, const bf16_t* Bt, int ldb, int K, int N, const Epi& E) {
    pg8::Gemm g{A, Bt, lda, ldb, K}; pg8::StaticOrder S; S.init(TOK, N, c.G, c.bid, lda, ldb);
    int t_ = c.tid; asm volatile("" : "+v"(t_));
    pg8::gemm_phase<Epi, pg8::StaticOrder, true, true>(c.lds, g, S, E, t_);
}

__global__ void __launch_bounds__(NTHREADS, 2) hgpm_fwd(Args args) {
    extern __shared__ __attribute__((aligned(16))) unsigned char lds_raw[];
    Ctx c; c.lds = (LAS unsigned char*)lds_raw; c.G = gridDim.x; c.bid = blockIdx.x; c.in = args.in;
    volatile LAS unsigned* xb_st = (volatile LAS unsigned*)(c.lds + XB_LDS_OFF);
    if (threadIdx.x < 4) xb_st[threadIdx.x] = 0u;
    __syncthreads();
    XcdBarrier bar = xcd_barrier_post((unsigned*)(args.ws + WS_CTL), xb_st);

    for (int ph = args.ph_lo; ph < args.ph_hi; ++ph) {
        const int l = ph / PH_SEQ, pi_ = ph % PH_SEQ, p = (MK_REP >= 0 && pi_ > MK_REP) ? pi_ - 1 : pi_;
        { int t_ = threadIdx.x; asm volatile("" : "+v"(t_)); c.tid = t_; c.lane = t_ & 63; c.wave = __builtin_amdgcn_readfirstlane(t_ >> 6); }
        { int z_ = 0; asm volatile("" : "+s"(z_)); c.zo = z_; c.ws = args.ws + z_; c.out = args.out + z_; }
        unsigned char* ws = c.ws;
        bf16_t* XN = (bf16_t*)(ws + WS_XN); bf16_t* Y = (bf16_t*)(ws + WS_Y); bf16_t* MERGED = (bf16_t*)(ws + WS_MERGED); bf16_t* Z = MERGED;
        bf16_t* HBUF = (bf16_t*)(ws + R_HBUF); bf16_t* BALL = (bf16_t*)(ws + R_BALL); bf16_t* S5A = (bf16_t*)(ws + R_S5A);
        float* SSQ = (float*)(ws + WS_SSQ);
        float* ssq_b = SSQ + (size_t)(3 * l) * TOK; float* ssq_c = ssq_b + TOK; float* ssq_d = ssq_c + TOK;
        const float* ssq_a = (l == 0) ? SSQ + (size_t)6 * TOK : SSQ + (size_t)(3 * l - 1) * TOK;
        if (ph == N_PHASES - 1) { phase_final_norm(c, c.out, INP(c, 29), SSQ + (size_t)(3 * NLAYER - 1) * TOK); }
        else switch (p) {
        case 0: phase_wprep(c, l); if (l == 0) phase_norm_in(c, INP(c, 0), XN, SSQ + (size_t)6 * TOK); break;
        case 1: run_gemm(c, XN, DM, (const bf16_t*)(ws + W_GU1), DM, DM, 2 * DFF, pg8::EpiGated<0>{HBUF, DFF, ssq_a}); break;
        case 13: run_gemm(c, XN, DM, (const bf16_t*)(ws + W_GU2), DM, DM, 2 * DFF, pg8::EpiGated<0>{HBUF, DFF, ssq_c}); break;
        case 2: run_gemm(c, HBUF, DFF, (const bf16_t*)(ws + W_D1), DFF, DFF, DM, pg8::EpiResid{l == 0 ? INP(c, 0) : c.out, c.out, 0.5f, XN, ssq_b}); break;
        case 14: run_gemm(c, HBUF, DFF, (const bf16_t*)(ws + W_D2), DFF, DFF, DM, pg8::EpiResid{c.out, c.out, 0.5f, XN, ssq_d}); break;
        case 3: run_gemm(c, XN, DM, (const bf16_t*)(ws + W_C1), DM, DM, 3584, pg8::EpiC1{(bf16_t*)(ws + R_HQ), S5A, (bf16_t*)(ws + R_CONV), ssq_b}); break;
        case 4: { pg8::Gemm g{S5A, (const bf16_t*)(ws + W_S5E), 640, 512, 512}; pg8::S5eOrder S{c.G, c.bid};
                  pg8::gemm_phase<pg8::EpiS5e, pg8::S5eOrder, true, true>(c.lds, g, S, pg8::EpiS5e{(float*)(ws + WS_S5E)}, c.tid);
                  phase_hg1(c, l); phase_conv(c, l); } break;
        case 5: phase_hg2(c); phase_s5scan(c); break;
        case 6: { pg8::Gemm g{S5A, (const bf16_t*)(ws + W_S5M), 640, 640, 640}; pg8::S5mOrder S{c.G, c.bid};
                  pg8::gemm_phase<pg8::EpiS5m, pg8::S5mOrder, true, true>(c.lds, g, S, pg8::EpiS5m{S5A, INP(c, 17) + l * 512, Z}, c.tid);
                  phase_hg3(c, l); } break;
        case 7:
                run_gemm(c, XN, DM, (const bf16_t*)(ws + W_C2), DM, DM, 3072, pg8::EpiQK{(bf16_t*)(ws + R_QKV), ssq_b, (const f32x2*)(ws + WS_ROPE)});
                for (int pass = 0; pass < 2; ++pass) {
                    const int gi = pass == 0 ? (c.bid >> 7) : 2, idx = pass == 0 ? (c.bid & 127) : (c.bid < 128 ? c.bid : -1);
                    pg8::Gemm g{(const bf16_t*)(ws + W_C2), XN, DM, DM << (2 * gi), DM}; pg8::VtOrder S{gi, idx};
                    int t_ = c.tid; asm volatile("" : "+v"(t_));
                    pg8::gemm_phase<pg8::EpiVt, pg8::VtOrder, true, true>(c.lds, g, S, pg8::EpiVt{(bf16_t*)(ws + R_QKV) + 2 * QKV_WHICH}, t_); }
                { pg8::Gemm g{Z, (const bf16_t*)(ws + W_GLU), 512, 512, 512}; pg8::StaticOrder S; S.init(TOK, 1024, 128, c.bid >= 128 ? c.bid - 128 : 256, 512, 512);
                  int t_ = c.tid; asm volatile("" : "+v"(t_));
                  pg8::gemm_phase<pg8::EpiGated<1>, pg8::StaticOrder, true, true>(c.lds, g, S, pg8::EpiGated<1>{Y + (size_t)TOK * 512, 512, nullptr}, t_); }
                break;
        case 8:
#if MK_REP_ATT
                phase_attn(c, ssq_b, true);
#endif
                phase_attn(c, ssq_b, false); break;
        case 9: phase_attn_merge(c); break;
        case 10: { pg8::Gemm g{Y, (const bf16_t*)(ws + W_BR), 512, 512, 512}; pg8::BranchOrder S; S.init(c.G, c.bid);
                   pg8::gemm_phase<pg8::EpiBranch, pg8::BranchOrder, true, true>(c.lds, g, S, pg8::EpiBranch{BALL}, c.tid); } break;
        case 11: run_gemm(c, XN, DM, (const bf16_t*)(ws + W_GATE), DM, DM, 4096, pg8::EpiGateMerge{BALL, MERGED, ssq_b}); break;
        case 12: run_gemm(c, MERGED, DM, (const bf16_t*)(ws + W_OUT), DM, DM, DM, pg8::EpiResid{c.out, c.out, 1.0f, XN, ssq_c}); break;
        }
        if (ph + 1 < args.ph_hi) {
#if MK_CG_SYNC
            __syncthreads(); cg::this_grid().sync();
#else
            xcd_barrier(bar);
#endif
        }
    }
}

extern "C" void kernel_launch(void* const* d_in, const int* in_sizes, int n_in, void* d_out, int out_size, void* d_ws, size_t ws_size, hipStream_t stream) {
    static int grid = 0;
    if (grid == 0) {
        if (n_in != 30 || in_sizes[0] != TOK * DM || out_size != TOK * DM || ws_size < WS_END) {
            fprintf(stderr, "kernel_launch: unexpected problem: n_in %d, in0 %d, out %d, ws %zu (need %zu)\n", n_in, n_in > 0 ? in_sizes[0] : -1, out_size, ws_size, (size_t)WS_END); grid = -1; return; }
        int dev = 0, cus = 0, per_cu = 0;
        if (hipGetDevice(&dev) != hipSuccess || hipDeviceGetAttribute(&cus, hipDeviceAttributeMultiprocessorCount, dev) != hipSuccess) { fprintf(stderr, "kernel_launch: device query failed\n"); grid = -1; return; }
        if (hipFuncSetAttribute((const void*)hgpm_fwd, hipFuncAttributeMaxDynamicSharedMemorySize, LDS_BYTES) != hipSuccess) { fprintf(stderr, "kernel_launch: hipFuncSetAttribute failed\n"); grid = -1; return; }
        if (hipOccupancyMaxActiveBlocksPerMultiprocessor(&per_cu, (const void*)hgpm_fwd, NTHREADS, LDS_BYTES) != hipSuccess || per_cu < 1) { fprintf(stderr, "kernel_launch: occupancy query says %d blocks per CU\n", per_cu); (void)hipGetLastError(); grid = -1; return; }
        grid = cus * 1;
    }
    if (grid < 0) return;
    (void)hipMemsetAsync((char*)d_ws + WS_CTL, 0, 1 * MiB, stream);
    Args a{};
    for (int i = 0; i < 30; ++i) a.in[i] = (const float*)d_in[i];
    a.out = (float*)d_out; a.ws = (unsigned char*)d_ws;
#if MK_SPLIT
    for (int ph = 0; ph < N_PHASES; ++ph) { a.ph_lo = ph; a.ph_hi = ph + 1; hipLaunchKernelGGL(hgpm_fwd, dim3(grid), dim3(NTHREADS), LDS_BYTES, stream, a); }
#else
    a.ph_lo = 0; a.ph_hi = N_PHASES;
    void* kargs[] = {&a};
    const hipError_t e = hipLaunchCooperativeKernel((const void*)hgpm_fwd, dim3(grid), dim3(NTHREADS), kargs, LDS_BYTES, stream);
    if (e != hipSuccess) fprintf(stderr, "kernel_launch: cooperative launch failed: %s (grid %d)\n", hipGetErrorString(e), grid);
#endif
}
```
